# Optimizing an MI355X kernel written in HIP

```python
import math
import jax, jax.numpy as jnp
from jax import lax
import numpy as np

D_MODEL = 1024
BATCH = 4
SEQ = 8192
DEPTH = 1
DEC_BATCH = 16
DEC_SEQ = 2048
PAST_LEN = 128

HEAD_DIM = 64
A_HEADS = 8
A_WIDTH = A_HEADS * HEAD_DIM
B_HEADS = 4
B_QK_WIDTH = 2 * B_HEADS * HEAD_DIM
B_WIDTH = B_HEADS * 2 * HEAD_DIM
D_MIX = A_WIDTH + B_WIDTH
IN_SPLITS = (A_WIDTH, A_WIDTH, A_WIDTH, A_WIDTH, B_QK_WIDTH, B_QK_WIDTH, B_WIDTH, B_WIDTH)
D_IN_PROJ = A_WIDTH * 4 + B_QK_WIDTH * 2 + B_WIDTH * 2
DILATED_PATTERNS = ((128, 1), (512, 4), (2048, 16))
BAND_BLOCK = 64
DENSE_Q_BLOCK = 128
ROPE_THETA = 500000.0
ROPE_DIM = HEAD_DIM // 4
NORM_EPS = 1e-6
MASK_VALUE = -1e30

kernel_name = "hybrid_dilated_diff_encoder"


def rmsnorm(x, g):
    xf = x.astype(jnp.float32)
    var = jnp.mean(xf * xf, axis=-1, keepdims=True)
    return (xf * lax.rsqrt(var + NORM_EPS) * g.astype(jnp.float32)).astype(x.dtype)


def rope_partial(x, pos):
    half = ROPE_DIM // 2
    inv = ROPE_THETA ** (-jnp.arange(half, dtype=jnp.float32) / half)
    ang = pos.astype(jnp.float32)[:, None] * inv[None, :]
    cos = jnp.cos(ang)[:, None, :]
    sin = jnp.sin(ang)[:, None, :]
    xr = x[..., :ROPE_DIM].astype(jnp.float32)
    x1, x2 = xr[..., :half], xr[..., half:]
    rot = jnp.concatenate([x1 * cos - x2 * sin, x2 * cos + x1 * sin], axis=-1)
    return jnp.concatenate([rot.astype(x.dtype), x[..., ROPE_DIM:]], axis=-1)


def dilated_window_attention(q, k, v, window, dil):
    bn, s, h, dh = q.shape
    half = window // (2 * dil)
    L = s // dil
    nb = -(-L // BAND_BLOCK)
    lp = nb * BAND_BLOCK
    kb_len = BAND_BLOCK + 2 * half

    def split(t):
        return t.reshape(bn, L, dil, h, dh).transpose(0, 2, 1, 3, 4)

    qs = jnp.pad(split(q), ((0, 0), (0, 0), (0, lp - L), (0, 0), (0, 0)))
    qs = qs.reshape(bn, dil, nb, BAND_BLOCK, h, dh)
    kpad = ((0, 0), (0, 0), (half, lp - L + half), (0, 0), (0, 0))
    idx = jnp.arange(nb)[:, None] * BAND_BLOCK + jnp.arange(kb_len)[None, :]
    ks = jnp.take(jnp.pad(split(k), kpad), idx, axis=2)
    vs = jnp.take(jnp.pad(split(v), kpad), idx, axis=2)

    sc = jnp.einsum('brnqhd,brnkhd->brnhqk', qs, ks).astype(jnp.float32) * (dh ** -0.5)
    qi = jnp.arange(nb)[:, None] * BAND_BLOCK + jnp.arange(BAND_BLOCK)[None, :]
    ki = idx - half
    rel = ki[:, None, :] - qi[:, :, None]
    valid = (jnp.abs(rel) <= half) & (ki[:, None, :] >= 0) & (ki[:, None, :] < L)
    sc = jnp.where(valid[:, None], sc, MASK_VALUE)
    lse = jax.nn.logsumexp(sc, axis=-1)
    p = jnp.exp(sc - lse[..., None])
    o = jnp.einsum('brnhqk,brnkhd->brnqhd', p.astype(v.dtype), vs)
    o = o.reshape(bn, dil, lp, h, dh)[:, :, :L].transpose(0, 2, 1, 3, 4).reshape(bn, s, h, dh)
    lse = lse.transpose(0, 1, 2, 4, 3).reshape(bn, dil, lp, h)[:, :, :L]
    lse = lse.transpose(0, 2, 1, 3).reshape(bn, s, h)
    return o, lse


def dilated_mixture(q, k, v):
    outs, lses = [], []
    for window, dil in DILATED_PATTERNS:
        o, lse = dilated_window_attention(q, k, v, window, dil)
        outs.append(o)
        lses.append(lse)
    w = jax.nn.softmax(jnp.stack(lses, axis=0), axis=0)
    o = jnp.sum(w[..., None] * jnp.stack(outs, axis=0).astype(jnp.float32), axis=0)
    return o.astype(q.dtype)


def diff_attention(q, k, v, lam, g_sub, lam_init):
    bn, s, h, _, dh = q.shape
    nq = s // DENSE_Q_BLOCK
    qb = q.reshape(bn, nq, DENSE_Q_BLOCK, h, 2, dh).transpose(1, 0, 2, 3, 4, 5)
    scale = dh ** -0.5

    def block(qblk):
        sc = jnp.einsum('bqhmd,bkhmd->bhmqk', qblk, k).astype(jnp.float32) * scale
        p = jax.nn.softmax(sc, axis=-1)
        a = p[:, :, 0] - lam * p[:, :, 1]
        return jnp.einsum('bhqk,bkhe->bqhe', a.astype(v.dtype), v)

    o = lax.map(block, qb)
    o = o.transpose(1, 0, 2, 3, 4).reshape(bn, s, h, 2 * dh)
    return rmsnorm(o, g_sub) * (1.0 - lam_init)


def encoder_layer(x, c, w_in, w_out, g_pre, g_post, w_ada, b_ada,
                  lam_q1, lam_k1, lam_q2, lam_k2, g_sub, lam_init):
    bn, s, _ = x.shape
    pos = jnp.arange(s)
    mod = jax.nn.silu(c) @ w_ada + b_ada
    shift, scale, gate = jnp.split(mod, 3, axis=-1)
    h = rmsnorm(x, g_pre) * (1.0 + scale[:, None, :]) + shift[:, None, :]
    proj = h @ w_in
    parts, off = [], 0
    for wdt in IN_SPLITS:
        parts.append(proj[..., off:off + wdt])
        off += wdt
    qa, ka, va, ga, qb, kb, vb, gb = parts

    qa = rope_partial(qa.reshape(bn, s, A_HEADS, HEAD_DIM), pos)
    ka = rope_partial(ka.reshape(bn, s, A_HEADS, HEAD_DIM), pos)
    va = va.reshape(bn, s, A_HEADS, HEAD_DIM)
    ya = dilated_mixture(qa, ka, va).reshape(bn, s, A_WIDTH) * jax.nn.silu(ga)

    qb = rope_partial(qb.reshape(bn, s, 2 * B_HEADS, HEAD_DIM), pos).reshape(bn, s, B_HEADS, 2, HEAD_DIM)
    kb = rope_partial(kb.reshape(bn, s, 2 * B_HEADS, HEAD_DIM), pos).reshape(bn, s, B_HEADS, 2, HEAD_DIM)
    vb = vb.reshape(bn, s, B_HEADS, 2 * HEAD_DIM)
    lam = (jnp.exp(jnp.sum(lam_q1.astype(jnp.float32) * lam_k1.astype(jnp.float32)))
           - jnp.exp(jnp.sum(lam_q2.astype(jnp.float32) * lam_k2.astype(jnp.float32))) + lam_init)
    yb = diff_attention(qb, kb, vb, lam, g_sub, lam_init).reshape(bn, s, B_WIDTH) * jax.nn.silu(gb)

    y = jnp.concatenate([ya, yb], axis=-1) @ w_out
    return x + gate[:, None, :] * rmsnorm(y, g_post)


def setup_inputs(seed: int = 0) -> dict:
    key = jax.random.key(seed)
    ks = jax.random.split(key, 16)
    f32 = jnp.float32
    return {
        "x_prompt": jax.random.normal(ks[0], (BATCH, SEQ, D_MODEL), f32),
        "x_sample": jax.random.normal(ks[1], (DEC_BATCH, DEC_SEQ, D_MODEL), f32),
        "c_prompt": jax.random.normal(ks[2], (BATCH, D_MODEL), f32),
        "c_sample": jax.random.normal(ks[3], (DEC_BATCH, D_MODEL), f32),
        "w_in": jax.random.normal(ks[4], (DEPTH, D_MODEL, D_IN_PROJ), f32) * D_MODEL ** -0.5,
        "w_out": jax.random.normal(ks[5], (DEPTH, D_MIX, D_MODEL), f32) * D_MIX ** -0.5,
        "g_pre": 1.0 + 0.02 * jax.random.normal(ks[6], (DEPTH, D_MODEL), f32),
        "g_post": 1.0 + 0.02 * jax.random.normal(ks[7], (DEPTH, D_MODEL), f32),
        "w_ada": jax.random.normal(ks[8], (DEPTH, D_MODEL, 3 * D_MODEL), f32) * (0.5 * D_MODEL ** -0.5),
        "b_ada": 0.01 * jax.random.normal(ks[9], (DEPTH, 3 * D_MODEL), f32),
        "lam_q1": 0.1 * jax.random.normal(ks[10], (DEPTH, HEAD_DIM), f32),
        "lam_k1": 0.1 * jax.random.normal(ks[11], (DEPTH, HEAD_DIM), f32),
        "lam_q2": 0.1 * jax.random.normal(ks[12], (DEPTH, HEAD_DIM), f32),
        "lam_k2": 0.1 * jax.random.normal(ks[13], (DEPTH, HEAD_DIM), f32),
        "g_sub": 1.0 + 0.02 * jax.random.normal(ks[14], (DEPTH, 2 * HEAD_DIM), f32),
    }


def reference(x_prompt, x_sample, c_prompt, c_sample, w_in, w_out, g_pre, g_post,
              w_ada, b_ada, lam_q1, lam_k1, lam_q2, lam_k2, g_sub):
    y_prompt = x_prompt
    y_sample = x_sample
    for l in range(DEPTH):
        lam_init = 0.8 - 0.6 * math.exp(-0.3 * l)
        y_prompt = encoder_layer(y_prompt, c_prompt, w_in[l], w_out[l], g_pre[l], g_post[l],
                                 w_ada[l], b_ada[l], lam_q1[l], lam_k1[l], lam_q2[l], lam_k2[l],
                                 g_sub[l], lam_init)
        y_sample = encoder_layer(y_sample, c_sample, w_in[l], w_out[l], g_pre[l], g_post[l],
                                 w_ada[l], b_ada[l], lam_q1[l], lam_k1[l], lam_q2[l], lam_k2[l],
                                 g_sub[l], lam_init)
    return (y_prompt, y_sample)
```

```cpp
#include <hip/hip_runtime.h>
#include <hip/hip_cooperative_groups.h>
#include <cstdio>
#include <cstdint>
namespace cg = cooperative_groups;
constexpr float QK_C2 = 0.125f * 1.4426950408889634f;
namespace pg8 {
#define PG8_LAS __attribute__((address_space(3)))
typedef unsigned short bf16_t;
typedef short bf16x8 __attribute__((ext_vector_type(8)));
typedef float f32x4 __attribute__((ext_vector_type(4)));
typedef unsigned u32x4 __attribute__((ext_vector_type(4)));
constexpr int BM = 256, BK = 64, HALF = 128, HTB = HALF * BK * 2  , STAGE_BYTES = 8 * HTB, NXCD = 8, WGM = 8;

__host__ __device__ __forceinline__ int lds_byte(int r, int c) { const int st = (r >> 4) * 2 + (c >> 5), rr = r & 15, cc = c & 31, ob = rr * 64 + cc * 2; return st * 1024 + (ob ^ (((ob >> 9) & 1) << 5)); }
__host__ __device__ __forceinline__ void stage_rc(int b, int& R, int& C) { const int st = b / 1024, sb = b % 1024, swz = sb ^ (((sb >> 9) & 1) << 5); R = (st >> 1) * 16 + swz / 64; C = (st & 1) * 32 + (swz % 64) / 2; }
__host__ __device__ __forceinline__ int perm32(int rho) { const int n = rho >> 4, i = rho & 15; return 8 * (i >> 2) + 4 * n + (i & 3); }

struct Unit { int pm, pn; };
struct Gemm { const bf16_t* A; const bf16_t* Bt; int M, N, K; };

struct StaticOrder {
    int nM, nN, nwg, G, c;
    __host__ __device__ void init(int M, int N, int G_, int c_) { nM = M / BM; nN = N / BM; nwg = nM * nN; G = G_; c = c_; }
    __host__ __device__ bool next(int i, Unit& u) const {
        const long L = (long)i * G + c; if (L >= nwg) return false;
        int wgid = (int)L; { const int q = nwg / NXCD, r = nwg % NXCD, xcd = wgid % NXCD, off = wgid / NXCD; wgid = (xcd < r ? xcd * (q + 1) : r * (q + 1) + (xcd - r) * q) + off; }
        const int nig = WGM * nN, gid = wgid / nig, fm = gid * WGM, gsz = (nM - fm) < WGM ? (nM - fm) : WGM;
        u.pm = fm + ((wgid % nig) % gsz); u.pn = (wgid % nig) / gsz; return true;
    }
    __device__ __forceinline__ void a_ready(const Unit&) const {}
    __device__ __forceinline__ void done(const Unit&) const {}
};

__device__ __forceinline__ unsigned cvt_pk_bf16(float lo, float hi) { unsigned r; asm volatile("v_cvt_pk_bf16_f32 %0, %1, %2" : "=v"(r) : "v"(lo), "v"(hi)); return r; }
struct EpiProj {
    static constexpr bool PERM = true, AFTER_DRAIN = false;
    bf16_t* O; int ldc; const float* rope;
    __device__ __forceinline__ void operator()(const f32x4 (&acc)[2][2][4][2], const Unit& u, int wr, int wc, int fr, int fq) const {
        const int row0 = u.pm * BM + wr * 64 + fr;
        const bool tile_rope = (u.pn & 4) == 0;
        const bool lane_rope = tile_rope && ((wc & 1) == 0) && (fq < 2);
        const float sc = ((u.pn & 6) == 0) ? QK_C2 : 1.f;
        const float sgn = (fq == 0) ? -1.f : 1.f;
        const int col0 = u.pn * BM + wc * 32 + 8 * fq;
#pragma unroll
        for (int ai = 0; ai < 2; ++ai)
#pragma unroll
            for (int m = 0; m < 4; ++m) {
                const int row = row0 + ai * HALF + m * 16;
                const int pos = row < 32768 ? (row & 8191) : (row & 2047);
                f32x4 cs[4];
                if (tile_rope) {
#pragma unroll
                    for (int q = 0; q < 4; ++q) cs[q] = *(const f32x4*)(rope + (size_t)pos * 16 + q * 4);
                }
                bf16_t* rowp = O + (size_t)row * ldc + col0;
#pragma unroll
                for (int bj = 0; bj < 2; ++bj) {
                    f32x4 v0 = acc[ai][bj][m][0], v1 = acc[ai][bj][m][1];
                    if (tile_rope) {
                        f32x4 p0, p1;
#pragma unroll
                        for (int j = 0; j < 4; ++j) { p0[j] = __shfl_xor(v0[j], 16); p1[j] = __shfl_xor(v1[j], 16); }
                        if (lane_rope) {
                            v0[0] = v0[0] * cs[0][0] + sgn * p0[0] * cs[0][1]; v0[1] = v0[1] * cs[0][2] + sgn * p0[1] * cs[0][3];
                            v0[2] = v0[2] * cs[1][0] + sgn * p0[2] * cs[1][1]; v0[3] = v0[3] * cs[1][2] + sgn * p0[3] * cs[1][3];
                            v1[0] = v1[0] * cs[2][0] + sgn * p1[0] * cs[2][1]; v1[1] = v1[1] * cs[2][2] + sgn * p1[1] * cs[2][3];
                            v1[2] = v1[2] * cs[3][0] + sgn * p1[2] * cs[3][1]; v1[3] = v1[3] * cs[3][2] + sgn * p1[3] * cs[3][3];
                        }
                    }
                    v0 = v0 * sc; v1 = v1 * sc;
                    u32x4 w; w.x = cvt_pk_bf16(v0[0], v0[1]); w.y = cvt_pk_bf16(v0[2], v0[3]); w.z = cvt_pk_bf16(v1[0], v1[1]); w.w = cvt_pk_bf16(v1[2], v1[3]);
                    *(u32x4*)(rowp + bj * HALF) = w;
                }
            }
    }
};
struct EpiY {
    static constexpr bool PERM = true, AFTER_DRAIN = false;
    bf16_t* O; int ldc; float* ssq;
    __device__ __forceinline__ void operator()(const f32x4 (&acc)[2][2][4][2], const Unit& u, int wr, int wc, int fr, int fq) const {
        const int row0 = u.pm * BM + wr * 64 + fr;
        const int col0 = u.pn * BM + wc * 32 + 8 * fq;
#pragma unroll
        for (int ai = 0; ai < 2; ++ai)
#pragma unroll
            for (int m = 0; m < 4; ++m) {
                const int row = row0 + ai * HALF + m * 16;
                bf16_t* rowp = O + (size_t)row * ldc + col0;
                float s = 0.f;
#pragma unroll
                for (int bj = 0; bj < 2; ++bj) {
                    const f32x4 v0 = acc[ai][bj][m][0], v1 = acc[ai][bj][m][1];
                    s += (v0[0] * v0[0] + v0[1] * v0[1]) + (v0[2] * v0[2] + v0[3] * v0[3]) + (v1[0] * v1[0] + v1[1] * v1[1]) + (v1[2] * v1[2] + v1[3] * v1[3]);
                    u32x4 w; w.x = cvt_pk_bf16(v0[0], v0[1]); w.y = cvt_pk_bf16(v0[2], v0[3]); w.z = cvt_pk_bf16(v1[0], v1[1]); w.w = cvt_pk_bf16(v1[2], v1[3]);
                    *(u32x4*)(rowp + bj * HALF) = w;
                }
                s += __shfl_xor(s, 16); s += __shfl_xor(s, 32);
                if (fq == 0) ssq[(size_t)row * 16 + u.pn * 4 + wc] = s;
            }
    }
};
template <class Epi, class Sched, bool ALIGN_EPI = false, bool SP2 = false>
__device__ __forceinline__ void gemm_phase(PG8_LAS unsigned char* lds, const Gemm g, const Sched& S, const Epi& E) {
    const int tid = threadIdx.x, wid = __builtin_amdgcn_readfirstlane(tid >> 6), lane = tid & 63, wr = wid >> 2, wc = wid & 3, fr = lane & 15, fq = lane >> 4;
    const int K = g.K, nt = K / BK;
    unsigned voffA[2], voffB[2];
#pragma unroll
    for (int i = 0; i < 2; ++i) { int R, C; stage_rc(tid * 16 + i * 8192, R, C); const int Rb = Epi::PERM ? ((R & ~31) + perm32(R & 31)) : R;
        voffA[i] = (unsigned)(R * K + C) * 2u; voffB[i] = (unsigned)(Rb * K + C) * 2u; }
    const size_t kstep = (size_t)(BK * 2);
    const size_t hstep = (size_t)HALF * K * 2;
    const size_t tstep = 2 * hstep;
    const unsigned ldsw = (unsigned)wid * 1024u;
    const int aoff = lds_byte(wr * 64 + fr, fq * 8), boff = lds_byte(wc * 32 + fr, fq * 8);
#define PG8_SA(b, h) (((b) * 2 + (h)) * HTB)
#define PG8_SB(b, h) ((4 + (b) * 2 + (h)) * HTB)
#define PG8_STAGE(bufoff, gbase, voff) do { _Pragma("unroll") for (int _i = 0; _i < 2; ++_i) \
        __builtin_amdgcn_global_load_lds((const unsigned*)((const char*)(gbase) + (voff)[_i]), (PG8_LAS unsigned*)(lds + (bufoff) + ldsw + _i * 8192), 16, 0, 0); } while (0)
#define PG8_LDA(dst, b, h) do { _Pragma("unroll") for (int m = 0; m < 4; ++m) _Pragma("unroll") for (int k = 0; k < 2; ++k) dst[m][k] = *(const PG8_LAS bf16x8*)(lds + PG8_SA(b, h) + aoff + m * 2048 + k * 1024); } while (0)
#define PG8_LDB(dst, b, h) do { _Pragma("unroll") for (int n = 0; n < 2; ++n) _Pragma("unroll") for (int k = 0; k < 2; ++k) dst[n][k] = *(const PG8_LAS bf16x8*)(lds + PG8_SB(b, h) + boff + n * 2048 + k * 1024); } while (0)
#define PG8_MMA(ai, bj, At, Bt) do { __builtin_amdgcn_s_setprio(1); _Pragma("unroll") for (int m = 0; m < 4; ++m) _Pragma("unroll") for (int n = 0; n < 2; ++n) _Pragma("unroll") for (int k = 0; k < 2; ++k) \
        acc[ai][bj][m][n] = __builtin_amdgcn_mfma_f32_16x16x32_bf16(Bt[n][k], At[m][k], acc[ai][bj][m][n], 0, 0, 0); __builtin_amdgcn_s_setprio(0); } while (0)
#define PG8_WAIT_V(n) asm volatile("s_waitcnt vmcnt(" #n ")" ::: "memory")
#define PG8_WAIT_L(n) asm volatile("s_waitcnt lgkmcnt(" #n ")" ::: "memory")
#define PG8_BAR __builtin_amdgcn_s_barrier()
#define PG8_SCHED __builtin_amdgcn_sched_barrier(0)
    Unit cur, nxt; int ui = 0;
    if (!S.next(0, cur)) return;
    f32x4 acc[2][2][4][2];
#pragma unroll
    for (int a = 0; a < 2; ++a)
#pragma unroll
        for (int b = 0; b < 2; ++b)
#pragma unroll
            for (int m = 0; m < 4; ++m)
#pragma unroll
                for (int n = 0; n < 2; ++n) acc[a][b][m][n] = (f32x4){0.f, 0.f, 0.f, 0.f};
    bf16x8 At[4][2], B0[2][2], B1[2][2];
    const char* cA = (const char*)g.A + (size_t)cur.pm * tstep; const char* cB = (const char*)g.Bt + (size_t)cur.pn * tstep;
    S.a_ready(cur);
    if constexpr (SP2) {
        PG8_STAGE(PG8_SB(0, 0), cB, voffB); PG8_STAGE(PG8_SB(0, 1), cB + hstep, voffB); PG8_STAGE(PG8_SA(0, 0), cA, voffA); PG8_STAGE(PG8_SA(0, 1), cA + hstep, voffA);
        if (wr == 1) PG8_BAR;
        PG8_WAIT_V(2); PG8_BAR;
        PG8_STAGE(PG8_SB(1, 0), cB + kstep, voffB); PG8_STAGE(PG8_SA(1, 0), cA + kstep, voffA); PG8_STAGE(PG8_SB(1, 1), cB + hstep + kstep, voffB);
        PG8_WAIT_V(6); PG8_BAR;
    } else {
        PG8_STAGE(PG8_SB(0, 0), cB, voffB); PG8_STAGE(PG8_SA(0, 0), cA, voffA); PG8_STAGE(PG8_SB(0, 1), cB + hstep, voffB); PG8_STAGE(PG8_SA(0, 1), cA + hstep, voffA);
        if (wr == 1) PG8_BAR;
        PG8_WAIT_V(4); PG8_BAR;
        PG8_STAGE(PG8_SB(1, 0), cB + kstep, voffB); PG8_STAGE(PG8_SA(1, 0), cA + kstep, voffA); PG8_STAGE(PG8_SB(1, 1), cB + hstep + kstep, voffB);
        PG8_WAIT_V(6); PG8_BAR;
    }
    for (;;) {
        const bool has_next = S.next(ui + 1, nxt);
        const char* nA = has_next ? (const char*)g.A + (size_t)nxt.pm * tstep : cA; const char* nB = has_next ? (const char*)g.Bt + (size_t)nxt.pn * tstep : cB;
        for (int t = 0; t < nt; t += 2) {
            const bool last = (t == nt - 2);
            const char* a1 = cA + (size_t)(t + 1) * kstep;
            const char* a2 = last ? nA : cA + (size_t)(t + 2) * kstep; const char* b2 = last ? nB : cB + (size_t)(t + 2) * kstep;
            const char* a3 = a2 + kstep; const char* b3 = b2 + kstep;
            if (last && has_next) S.a_ready(nxt);
            if constexpr (SP2) {
            PG8_LDB(B0, 0, 0); PG8_LDB(B1, 0, 1); PG8_SCHED; PG8_LDA(At, 0, 0); PG8_STAGE(PG8_SA(1, 1), a1 + hstep, voffA);
            PG8_WAIT_V(8); PG8_WAIT_L(0); PG8_BAR; PG8_MMA(0, 0, At, B0); PG8_MMA(0, 1, At, B1); PG8_BAR; PG8_SCHED;
            PG8_LDA(At, 0, 1); PG8_STAGE(PG8_SB(0, 0), b2, voffB); PG8_STAGE(PG8_SB(0, 1), b2 + hstep, voffB); PG8_STAGE(PG8_SA(0, 0), a2, voffA);
            PG8_WAIT_V(8); PG8_WAIT_L(0); PG8_BAR; PG8_MMA(1, 0, At, B0); PG8_MMA(1, 1, At, B1); PG8_BAR; PG8_SCHED;
            PG8_LDB(B0, 1, 0); PG8_LDB(B1, 1, 1); PG8_SCHED; PG8_LDA(At, 1, 0); PG8_STAGE(PG8_SA(0, 1), a2 + hstep, voffA);
            PG8_WAIT_V(8); PG8_WAIT_L(0); PG8_BAR; PG8_MMA(0, 0, At, B0); PG8_MMA(0, 1, At, B1); PG8_BAR; PG8_SCHED;
            PG8_LDA(At, 1, 1); PG8_STAGE(PG8_SB(1, 0), b3, voffB); PG8_STAGE(PG8_SB(1, 1), b3 + hstep, voffB); PG8_STAGE(PG8_SA(1, 0), a3, voffA);
            PG8_WAIT_V(8); PG8_WAIT_L(0); PG8_BAR; PG8_MMA(1, 0, At, B0); PG8_MMA(1, 1, At, B1); PG8_BAR; PG8_SCHED;
            } else {
            PG8_LDB(B0, 0, 0); PG8_SCHED; PG8_LDA(At, 0, 0); PG8_STAGE(PG8_SA(1, 1), a1 + hstep, voffA);
            PG8_WAIT_L(8); PG8_BAR; PG8_WAIT_L(0); PG8_MMA(0, 0, At, B0); PG8_BAR; PG8_SCHED;
            PG8_LDB(B1, 0, 1); PG8_STAGE(PG8_SB(0, 0), b2, voffB);
            PG8_BAR; PG8_WAIT_L(0); PG8_MMA(0, 1, At, B1); PG8_BAR;
            PG8_LDA(At, 0, 1); PG8_STAGE(PG8_SA(0, 0), a2, voffA);
            PG8_BAR; PG8_WAIT_L(0); PG8_MMA(1, 0, At, B0); PG8_BAR; PG8_SCHED;
            PG8_STAGE(PG8_SB(0, 1), b2 + hstep, voffB);
            PG8_WAIT_V(6); PG8_BAR; PG8_MMA(1, 1, At, B1); PG8_BAR;
            PG8_LDB(B0, 1, 0); PG8_SCHED; PG8_LDA(At, 1, 0); PG8_STAGE(PG8_SA(0, 1), a2 + hstep, voffA);
            PG8_WAIT_L(8); PG8_BAR; PG8_WAIT_L(0); PG8_MMA(0, 0, At, B0); PG8_BAR; PG8_SCHED;
            PG8_LDB(B1, 1, 1); PG8_STAGE(PG8_SB(1, 0), b3, voffB);
            PG8_BAR; PG8_WAIT_L(0); PG8_MMA(0, 1, At, B1); PG8_BAR;
            PG8_LDA(At, 1, 1); PG8_STAGE(PG8_SA(1, 0), a3, voffA);
            PG8_BAR; PG8_WAIT_L(0); PG8_MMA(1, 0, At, B0); PG8_BAR; PG8_SCHED;
            PG8_STAGE(PG8_SB(1, 1), b3 + hstep, voffB);
            PG8_WAIT_V(6); PG8_BAR; PG8_MMA(1, 1, At, B1); PG8_BAR;
            }
        }
        if constexpr (ALIGN_EPI) { if (wr == 0) PG8_BAR; }
        if constexpr (!Epi::AFTER_DRAIN) { E(acc, cur, wr, wc, fr, fq); S.done(cur); }
        if (!has_next) break;
#pragma unroll
        for (int a = 0; a < 2; ++a)
#pragma unroll
            for (int b = 0; b < 2; ++b)
#pragma unroll
                for (int m = 0; m < 4; ++m)
#pragma unroll
                    for (int n = 0; n < 2; ++n) acc[a][b][m][n] = (f32x4){0.f, 0.f, 0.f, 0.f};
        cur = nxt; cA = nA; cB = nB; ++ui;
        if constexpr (ALIGN_EPI) { if (wr == 1) PG8_BAR; }
    }
    PG8_WAIT_V(0);
    if constexpr (!ALIGN_EPI) { if (wr == 0) PG8_BAR; }
    PG8_BAR;
    if constexpr (Epi::AFTER_DRAIN) { E.fused(acc, cur, wr, wc, fr, fq, lds, wid, lane); S.done(cur); }
#undef PG8_SA
#undef PG8_SB
#undef PG8_STAGE
#undef PG8_LDA
#undef PG8_LDB
#undef PG8_MMA
#undef PG8_WAIT_V
#undef PG8_WAIT_L
#undef PG8_BAR
#undef PG8_SCHED
}
}
#define LAS __attribute__((address_space(3)))
namespace att {
typedef unsigned short bf16;
typedef short bf16x8 __attribute__((ext_vector_type(8)));
typedef short s16x4 __attribute__((ext_vector_type(4)));
typedef short v4i16_t __attribute__((ext_vector_type(4)));
typedef float f32x16 __attribute__((ext_vector_type(16)));
typedef unsigned u32x4 __attribute__((ext_vector_type(4)));
typedef float f32x2_t __attribute__((ext_vector_type(2)));
typedef __bf16 bf16x2_t __attribute__((ext_vector_type(2)));
typedef LAS const char* lds_cptr;
constexpr int PITCH = 4096;
constexpr int YP = 1024;
__device__ __forceinline__ int fresh_tid() { int t = threadIdx.x; asm volatile("" : "+v"(t)); return t; }
__device__ __forceinline__ int crow(int r, int hi) { return (r & 3) + 8 * (r >> 2) + 4 * hi; }
__device__ __forceinline__ void glds16(const void* gsrc, unsigned lds_dst) { unsigned keep;
  asm volatile("s_mov_b32 %0, m0\n\ts_mov_b32 m0, %2\n\ts_nop 0\n\tglobal_load_lds_dwordx4 %1, off\n\ts_mov_b32 m0, %0" : "=&s"(keep) : "v"(gsrc), "s"(lds_dst) : "memory"); }
__device__ __forceinline__ unsigned cvtpk_s(float lo, float hi) { f32x2_t v = {lo, hi}; bf16x2_t b = __builtin_convertvector(v, bf16x2_t); return __builtin_bit_cast(unsigned, b); }
__device__ __forceinline__ s16x4 vtr(lds_cptr p) { return __builtin_bit_cast(s16x4, __builtin_amdgcn_ds_read_tr16_b64_v4i16((LAS v4i16_t*)p)); }
__device__ __forceinline__ float bf2f(bf16 v) { return __uint_as_float(((unsigned)v) << 16); }
__device__ __forceinline__ bf16 f2bf(float f) { unsigned u = __float_as_uint(f); return (bf16)((u + 0x7fffu + ((u >> 16) & 1u)) >> 16); }
__device__ __forceinline__ float swap_max(float m) { auto rr = __builtin_amdgcn_permlane32_swap(__float_as_uint(m), __float_as_uint(m), false, false); return fmaxf(__uint_as_float(rr[0]), __uint_as_float(rr[1])); }
__device__ __forceinline__ float swap_sum(float m) { auto rr = __builtin_amdgcn_permlane32_swap(__float_as_uint(m), __float_as_uint(m), false, false); return __uint_as_float(rr[0]) + __uint_as_float(rr[1]); }
__device__ __forceinline__ float fadd_s(float a, float b) { float r; asm("v_add_f32_e32 %0, %1, %2" : "=v"(r) : "v"(a), "v"(b)); return r; }
__device__ __forceinline__ float silu(float g) { return g / (1.f + __expf(-g)); }
#define ATT_WAIT_BAR(N) asm volatile("s_waitcnt vmcnt(" #N ") lgkmcnt(0)\n\ts_barrier" ::: "memory")
#define ATT_PACK(P, B) (u32x4){cvtpk_s(P[B], P[B + 1]), cvtpk_s(P[B + 2], P[B + 3]), cvtpk_s(P[B + 4], P[B + 5]), cvtpk_s(P[B + 6], P[B + 7])}
#define ATT_VFR(lo, hi) (bf16x8){lo[0], lo[1], lo[2], lo[3], hi[0], hi[1], hi[2], hi[3]}

constexpr int D_SLOT = 32768, D_NSLOT = 4, D_WSF = D_SLOT * D_NSLOT;
#define ATT_MX3(a, b, c) __builtin_fmaxf(__builtin_fmaxf((a), (b)), (c))
__device__ __forceinline__ void diff_unit(const bf16* __restrict__ P, bf16* __restrict__ Y, long rowbase, int S, int h, int qt, LAS char* shm, float lam, const float* __restrict__ g_sub) {
  const int tid = fresh_tid(), lane = tid & 63, r32 = lane & 31, hi = lane >> 5; const int wid = __builtin_amdgcn_readfirstlane(tid >> 6);
  const int map = wid >> 2, wq = wid & 3;
  const long qrow0 = rowbase + (long)qt * 128 + wq * 32;
  const bf16* Qw = P + qrow0 * PITCH + 2048 + (2 * h + map) * 64;
  const bf16* Kb = P + rowbase * PITCH + 2560 + (2 * h) * 64;
  const bf16* Vb = P + rowbase * PITCH + 3072 + h * 128;
  const unsigned lds0 = (unsigned)(uintptr_t)shm;
  LAS float* wsf = (LAS float*)(shm + D_WSF) + wid * 64;
  const bf16* ksrc0 = Kb + map * 64 + (long)lane * PITCH + (2 * wq) * 8;
  const bf16* ksrc1 = ksrc0 + 8;
  const unsigned kdst0 = map * 8192 + (2 * wq) * 1024, kdst1 = kdst0 + 1024;
  const int vp0 = 2 * wid, vp1 = 2 * wid + 1;
  const bf16* vsrc0 = Vb + (long)(16 * (vp0 & 3) + (lane >> 2)) * PITCH + 32 * (vp0 >> 2) + 8 * (lane & 3);
  const bf16* vsrc1 = Vb + (long)(16 * (vp1 & 3) + (lane >> 2)) * PITCH + 32 * (vp1 >> 2) + 8 * (lane & 3);
  const unsigned vdst0 = 16384 + vp0 * 1024, vdst1 = 16384 + vp1 * 1024;
#define D_DMA(t, slot) do { const long toff_ = (long)(t) * 64 * PITCH; const unsigned sb_ = lds0 + (slot); \
    glds16(ksrc0 + toff_, (unsigned)__builtin_amdgcn_readfirstlane(sb_ + kdst0)); glds16(ksrc1 + toff_, (unsigned)__builtin_amdgcn_readfirstlane(sb_ + kdst1)); \
    glds16(vsrc0 + toff_, (unsigned)__builtin_amdgcn_readfirstlane(sb_ + vdst0)); glds16(vsrc1 + toff_, (unsigned)__builtin_amdgcn_readfirstlane(sb_ + vdst1)); } while (0)
  const int NT = S / 64;
  asm volatile("s_waitcnt vmcnt(0)" ::: "memory");
  bf16x8 qr[4];
#pragma unroll
  for (int d0 = 0; d0 < 4; ++d0) qr[d0] = *reinterpret_cast<const bf16x8*>(&Qw[(long)r32 * PITCH + d0 * 16 + hi * 8]);
  asm volatile("" ::: "memory");
  D_DMA(0, 0); D_DMA(1, D_SLOT); D_DMA(2, 2 * D_SLOT);
  float m = 0.f, l = 0.f;
  f32x16 o[4];
#pragma unroll
  for (int d0 = 0; d0 < 4; ++d0) o[d0] = f32x16{};
  f32x16 negm = f32x16{}; asm volatile("" : "+v"(negm));
  const lds_cptr shm3 = (lds_cptr)shm;
  const lds_cptr kp0 = shm3 + map * 8192 + hi * 1024 + r32 * 16;
  const lds_cptr vp = shm3 + 16384 + ((lane >> 4) & 1) * 32 + (lane & 3) * 8 + (4 * hi + ((lane & 15) >> 2)) * 64;
  bf16x8 pa0, pa1, pa2, pa3;
  pa0 = pa1 = pa2 = pa3 = bf16x8{};
#define D_KLD(SL_) do { const lds_cptr kp = kp0 + (SL_); \
    _Pragma("unroll") for (int d0 = 0; d0 < 4; ++d0) { kf[2 * d0] = *(const LAS bf16x8*)(kp + d0 * 2048); kf[2 * d0 + 1] = *(const LAS bf16x8*)(kp + d0 * 2048 + 512); } } while (0)
#define D_QKSM(T_, SL_) do { \
    f32x16 p0, p1; \
    p0 = __builtin_amdgcn_mfma_f32_32x32x16_bf16(kf[0], qr[0], negm, 0, 0, 0); p1 = __builtin_amdgcn_mfma_f32_32x32x16_bf16(kf[1], qr[0], negm, 0, 0, 0); \
    _Pragma("unroll") for (int d0 = 1; d0 < 4; ++d0) { \
      p0 = __builtin_amdgcn_mfma_f32_32x32x16_bf16(kf[2 * d0], qr[d0], p0, 0, 0, 0); p1 = __builtin_amdgcn_mfma_f32_32x32x16_bf16(kf[2 * d0 + 1], qr[d0], p1, 0, 0, 0); } \
    float ra = ATT_MX3(p0[0], p0[1], p1[0]), rb = ATT_MX3(p0[2], p0[3], p1[1]); ra = ATT_MX3(ra, p1[2], p1[3]); \
    _Pragma("unroll") for (int r = 4; r < 16; r += 4) { ra = ATT_MX3(ra, p0[r], p0[r + 1]); rb = ATT_MX3(rb, p0[r + 2], p0[r + 3]); ra = ATT_MX3(ra, p1[r], p1[r + 1]); rb = ATT_MX3(rb, p1[r + 2], p1[r + 3]); } \
    const float rm = swap_max(fmaxf(ra, rb)); \
    if ((T_) == 0 || __any(rm > 6.f)) { \
      const float dl = ((T_) == 0) ? rm : fmaxf(rm, 0.f); m += dl; \
      _Pragma("unroll") for (int r = 0; r < 16; ++r) { p0[r] -= dl; p1[r] -= dl; } \
      _Pragma("unroll") for (int r = 0; r < 16; ++r) negm[r] = -m; \
      asm volatile("" : "+v"(negm)); \
      const float f = __builtin_amdgcn_exp2f(-dl); l *= f; \
      if (hi == 0) wsf[r32] = f; \
      _Pragma("unroll") for (int r = 0; r < 16; ++r) { const float fr_ = wsf[crow(r, hi)]; \
        _Pragma("unroll") for (int d0 = 0; d0 < 4; ++d0) o[d0][r] *= fr_; } \
    } \
    float sacc = 0.f, sacd = 0.f; \
    _Pragma("unroll") for (int r = 0; r < 16; ++r) { p0[r] = __builtin_amdgcn_exp2f(p0[r]); p1[r] = __builtin_amdgcn_exp2f(p1[r]); sacc = fadd_s(sacc, p0[r]); sacd = fadd_s(sacd, p1[r]); } \
    l += sacc + sacd; \
    pa0 = __builtin_bit_cast(bf16x8, ATT_PACK(p0, 0)); pa1 = __builtin_bit_cast(bf16x8, ATT_PACK(p0, 8)); \
    pa2 = __builtin_bit_cast(bf16x8, ATT_PACK(p1, 0)); pa3 = __builtin_bit_cast(bf16x8, ATT_PACK(p1, 8)); } while (0)
#define D_PV(SL_) do { const lds_cptr vq = vp + (SL_); \
    _Pragma("unroll") for (int d0 = 0; d0 < 4; ++d0) { s16x4 lo[4], hh[4]; \
      _Pragma("unroll") for (int ks = 0; ks < 4; ++ks) { lo[ks] = vtr(vq + d0 * 4096 + ks * 1024); hh[ks] = vtr(vq + d0 * 4096 + ks * 1024 + 512); } \
      o[d0] = __builtin_amdgcn_mfma_f32_32x32x16_bf16(pa0, ATT_VFR(lo[0], hh[0]), o[d0], 0, 0, 0); \
      o[d0] = __builtin_amdgcn_mfma_f32_32x32x16_bf16(pa1, ATT_VFR(lo[1], hh[1]), o[d0], 0, 0, 0); \
      o[d0] = __builtin_amdgcn_mfma_f32_32x32x16_bf16(pa2, ATT_VFR(lo[2], hh[2]), o[d0], 0, 0, 0); \
      o[d0] = __builtin_amdgcn_mfma_f32_32x32x16_bf16(pa3, ATT_VFR(lo[3], hh[3]), o[d0], 0, 0, 0); } } while (0)
  ATT_WAIT_BAR(8);
  bf16x8 kf[8];
  if (map == 1) asm volatile("s_barrier" ::: "memory");
  for (int t = 0; t < NT; ++t) {
    const int cur = (t & 3) * D_SLOT;
    D_KLD(cur);
    D_QKSM(t, cur);
    __builtin_amdgcn_sched_barrier(0);
    if (t + 2 < NT) { ATT_WAIT_BAR(4); } else { ATT_WAIT_BAR(0); }
    __builtin_amdgcn_sched_barrier(0);
    if (t + 3 < NT) D_DMA(t + 3, ((t + 3) & 3) * D_SLOT);
    D_PV(cur);
    __builtin_amdgcn_sched_barrier(0);
    asm volatile("s_waitcnt lgkmcnt(0)\n\ts_barrier" ::: "memory");
    __builtin_amdgcn_sched_barrier(0);
  }
  if (map == 0) asm volatile("s_barrier" ::: "memory");
#undef D_DMA
#undef D_KLD
#undef D_QKSM
#undef D_PV
  l = swap_sum(l);
  { const int te = fresh_tid(); const int lane = te & 63, r32 = lane & 31, hi = lane >> 5;
  LAS float* wsf = (LAS float*)(shm + D_WSF) + wid * 64;
  if (hi == 0) wsf[32 + r32] = (map == 1 ? lam : 1.f) / l;
  float inv[16];
#pragma unroll
  for (int r = 0; r < 16; ++r) inv[r] = wsf[32 + crow(r, hi)];
  ATT_WAIT_BAR(0);
  LAS float* X = (LAS float*)shm + wq * 4096;
  if (map == 1) {
#pragma unroll
    for (int d0 = 0; d0 < 4; ++d0)
#pragma unroll
      for (int r = 0; r < 16; ++r) X[(d0 * 16 + r) * 64 + lane] = o[d0][r] * inv[r];
  }
  ATT_WAIT_BAR(0);
  if (map == 0) {
    const bf16* Gw = P + qrow0 * PITCH + 3584 + h * 128;
    bf16* Yw = Y + qrow0 * YP + 512 + h * 128;
    float gs[4];
#pragma unroll
    for (int d0 = 0; d0 < 4; ++d0) gs[d0] = g_sub[d0 * 32 + r32] * 0.8f;
#pragma unroll
    for (int r = 0; r < 16; ++r) {
      float v[4]; float ss = 0.f;
#pragma unroll
      for (int d0 = 0; d0 < 4; ++d0) { v[d0] = o[d0][r] * inv[r] - X[(d0 * 16 + r) * 64 + lane]; ss += v[d0] * v[d0]; }
      ss += __shfl_xor(ss, 1); ss += __shfl_xor(ss, 2); ss += __shfl_xor(ss, 4); ss += __shfl_xor(ss, 8); ss += __shfl_xor(ss, 16);
      const float rstd = rsqrtf(ss * (1.f / 128.f) + 1e-6f);
      const int q = crow(r, hi);
#pragma unroll
      for (int d0 = 0; d0 < 4; ++d0) { const float g = bf2f(Gw[(long)q * PITCH + d0 * 32 + r32]);
        Yw[(long)q * YP + d0 * 32 + r32] = f2bf(v[d0] * rstd * gs[d0] * silu(g)); }
    }
  }
  }
  ATT_WAIT_BAR(0);
}

template <int DIL, int NBLK, int QSTEP>
__device__ __forceinline__ void dil_pattern(const bf16* __restrict__ Kb, const bf16* __restrict__ Vb, int S, int i0, int resid, const bf16x8 (&qr)[4], float& m, float& l, f32x16 (&o)[2],
                                            LAS char* vl, LAS float* wsf, int lane, int r32, int hi) {
  const int L = S / DIL;
  const int qidx = i0 + QSTEP * r32;
  const lds_cptr vq = (lds_cptr)vl + ((lane >> 4) & 1) * 32 + (lane & 3) * 8 + (4 * hi + ((lane & 15) >> 2)) * 64;
  const int lrow = lane >> 3, lch = lane & 7;
  LAS char* kw = vl + 4096 + lch * 512 + ((lrow ^ lch) * 16);
  LAS char* vw = vl + (lch >> 2) * 2048 + (lrow & 7) * 64 + (lch & 3) * 16;
  const lds_cptr kr_ = (lds_cptr)vl + 4096;
  int kb_lo = (64 - i0) >> 5; kb_lo = kb_lo < 0 ? 0 : kb_lo;
  int kb_hi = (L + 64 - i0 + 31) >> 5; kb_hi = kb_hi > NBLK ? NBLK : kb_hi;
  u32x4 kr[4], vr[4];
#define DIL_LOAD(KB_) do { const int kbase_ = i0 - 64 + 32 * (KB_); \
    _Pragma("unroll") for (int i = 0; i < 4; ++i) { int kx_ = kbase_ + 8 * i + lrow; kx_ = kx_ < 0 ? 0 : (kx_ >= L ? L - 1 : kx_); \
      const long ro_ = (long)(resid + DIL * kx_) * PITCH + lch * 8; \
      kr[i] = *reinterpret_cast<const u32x4*>(Kb + ro_); vr[i] = *reinterpret_cast<const u32x4*>(Vb + ro_); } } while (0)
  DIL_LOAD(kb_lo);
  for (int kb = kb_lo; kb < kb_hi; ++kb) {
    const int kbase = i0 - 64 + 32 * kb;
#pragma unroll
    for (int i = 0; i < 4; ++i) { *(LAS u32x4*)(kw + i * 128) = kr[i]; *(LAS u32x4*)(vw + (i >> 1) * 1024 + (i & 1) * 512) = vr[i]; }
    { const int kn = (kb + 1 < kb_hi) ? kb + 1 : kb; DIL_LOAD(kn); }
    f32x16 p0 = f32x16{};
#pragma unroll
    for (int d0 = 0; d0 < 4; ++d0) { const int ch = 2 * d0 + hi;
      const bf16x8 kfr = *(const LAS bf16x8*)(kr_ + ch * 512 + ((r32 ^ ch) * 16));
      p0 = __builtin_amdgcn_mfma_f32_32x32x16_bf16(kfr, qr[d0], p0, 0, 0, 0); }
    float rm = -1e30f;
#pragma unroll
    for (int rr = 0; rr < 16; ++rr) { const int kidx = kbase + crow(rr, hi); const int rel = kidx - qidx;
      const bool ok = ((unsigned)(rel + 64) <= 128u) && ((unsigned)kidx < (unsigned)L);
      p0[rr] = ok ? p0[rr] : -1e30f; rm = fmaxf(rm, p0[rr]); }
    rm = swap_max(rm);
    if (__any(rm > m + 6.f)) {
      const float mn = fmaxf(m, rm); const float f = __builtin_amdgcn_exp2f(m - mn); m = mn; l *= f;
      if (hi == 0) wsf[r32] = f;
#pragma unroll
      for (int rr = 0; rr < 16; ++rr) { const float fr_ = wsf[crow(rr, hi)]; o[0][rr] *= fr_; o[1][rr] *= fr_; }
    }
    float sacc = 0.f;
#pragma unroll
    for (int rr = 0; rr < 16; ++rr) { p0[rr] = __builtin_amdgcn_exp2f(p0[rr] - m); sacc += p0[rr]; }
    l += sacc;
    const bf16x8 pa0 = __builtin_bit_cast(bf16x8, ATT_PACK(p0, 0)), pa1 = __builtin_bit_cast(bf16x8, ATT_PACK(p0, 8));
#pragma unroll
    for (int d0 = 0; d0 < 2; ++d0) {
      const s16x4 lo0 = vtr(vq + d0 * 2048), hi0 = vtr(vq + d0 * 2048 + 512), lo1 = vtr(vq + d0 * 2048 + 1024), hi1 = vtr(vq + d0 * 2048 + 1536);
      o[d0] = __builtin_amdgcn_mfma_f32_32x32x16_bf16(pa0, ATT_VFR(lo0, hi0), o[d0], 0, 0, 0);
      o[d0] = __builtin_amdgcn_mfma_f32_32x32x16_bf16(pa1, ATT_VFR(lo1, hi1), o[d0], 0, 0, 0);
    }
  }
#undef DIL_LOAD
}
__device__ __forceinline__ void dil_item_a(const bf16* __restrict__ P, long rowbase, int S, int h, int c, int r, LAS char* vl, LAS float* wsf, LAS bf16* OA, LAS float* ML) {
  const int lane = fresh_tid() & 63, r32 = lane & 31, hi = lane >> 5;
  const bf16* Qb = P + rowbase * PITCH + h * 64;
  const bf16* Kb = Qb + 512; const bf16* Vb = Qb + 1024;
  const int tq0 = 512 * c + r;
  bf16x8 qr[4];
#pragma unroll
  for (int d0 = 0; d0 < 4; ++d0) qr[d0] = *reinterpret_cast<const bf16x8*>(Qb + (long)(tq0 + 16 * r32) * PITCH + d0 * 16 + hi * 8);
  float m = -1e30f, l = 0.f; f32x16 o[2]; o[0] = f32x16{}; o[1] = f32x16{};
  dil_pattern<16, 5, 1>(Kb, Vb, S, 32 * c, r, qr, m, l, o, vl, wsf, lane, r32, hi);
  dil_pattern<4, 8, 4>(Kb, Vb, S, 128 * c + (r >> 2), r & 3, qr, m, l, o, vl, wsf, lane, r32, hi);
  l = swap_sum(l);
  if (hi == 0) { wsf[32 + r32] = 1.f / l; ML[(r + 16 * r32) * 2] = m; ML[(r + 16 * r32) * 2 + 1] = l; }
#pragma unroll
  for (int rr = 0; rr < 16; ++rr) { const float iv = wsf[32 + crow(rr, hi)]; const int tl = r + 16 * crow(rr, hi);
#pragma unroll
    for (int d0 = 0; d0 < 2; ++d0) OA[tl * 64 + d0 * 32 + r32] = f2bf(o[d0][rr] * iv); }
}
__device__ __forceinline__ void dil_item_b(const bf16* __restrict__ P, bf16* __restrict__ Y, long rowbase, int S, int h, int c, int j, LAS char* vl, LAS float* wsf, const LAS bf16* OA, const LAS float* ML) {
  const int lane = fresh_tid() & 63, r32 = lane & 31, hi = lane >> 5;
  const bf16* Qb = P + rowbase * PITCH + h * 64;
  const bf16* Kb = Qb + 512; const bf16* Vb = Qb + 1024; const bf16* Gb = Qb + 1536;
  const int tq0 = 512 * c + 32 * j;
  bf16x8 qr[4];
#pragma unroll
  for (int d0 = 0; d0 < 4; ++d0) qr[d0] = *reinterpret_cast<const bf16x8*>(Qb + (long)(tq0 + r32) * PITCH + d0 * 16 + hi * 8);
  float m = -1e30f, l = 0.f; f32x16 o[2]; o[0] = f32x16{}; o[1] = f32x16{};
  dil_pattern<1, 5, 1>(Kb, Vb, S, tq0, 0, qr, m, l, o, vl, wsf, lane, r32, hi);
  l = swap_sum(l);
  if (hi == 0) {
    const float ma = ML[(32 * j + r32) * 2], la = ML[(32 * j + r32) * 2 + 1];
    const float mm = fmaxf(ma, m), wa = la * __builtin_amdgcn_exp2f(ma - mm), wb = __builtin_amdgcn_exp2f(m - mm);
    const float rden = 1.f / (wa + l * wb);
    wsf[r32] = wa * rden; wsf[32 + r32] = wb * rden; }
  bf16* Yb = Y + rowbase * YP + h * 64;
#pragma unroll
  for (int rr = 0; rr < 16; ++rr) { const int q = crow(rr, hi); const float fa = wsf[q], fb = wsf[32 + q]; const long tok = tq0 + q;
#pragma unroll
    for (int d0 = 0; d0 < 2; ++d0) { const float g = bf2f(Gb[tok * PITCH + d0 * 32 + r32]); const float oa = bf2f(OA[(32 * j + q) * 64 + d0 * 32 + r32]);
      Yb[tok * YP + d0 * 32 + r32] = f2bf((oa * fa + o[d0][rr] * fb) * silu(g)); } }
}
}
typedef unsigned short bf16;
typedef float f32x4g __attribute__((ext_vector_type(4)));
typedef unsigned v4u __attribute__((ext_vector_type(4)));
constexpr int NTOK = 65536, DMODEL = 1024, DPROJ = 4096, NBATCH = 20, NPROMPT_ROWS = 32768;
constexpr size_t MiB = 1u << 20;
constexpr size_t WS_PROJ = 0, WS_Y = 0, WS_SSQ = 128 * MiB, WS_GATE = 132 * MiB, WS_NEED = 512 * MiB;
constexpr size_t DO_H = 0, DO_WIN = 128 * MiB, DO_WOUT = 136 * MiB, DO_MOD = 138 * MiB, DO_ROPE = 139 * MiB, DO_MISC = 140 * MiB;
constexpr int LDS_BYTES = 147456;
struct Params { const float* in[15]; float* out; unsigned char* ws; int mask; int pad; };

__device__ __forceinline__ unsigned f2bf_u(float f) { unsigned u = __builtin_bit_cast(unsigned, f); return (u + 0x7fffu + ((u >> 16) & 1u)) >> 16; }
__device__ __forceinline__ unsigned pk2(float lo, float hi) { return f2bf_u(lo) | (f2bf_u(hi) << 16); }
__device__ __forceinline__ float wave_sum(float v) {
#pragma unroll
    for (int o = 1; o < 64; o <<= 1) v += __shfl_xor(v, o);
    return v;
}
__device__ __forceinline__ void transpose_item(const float* W, int K, int N, bf16* WT, LAS float* scr, int item, int lane) {
    const int nblk = N / 32, kb = item / nblk, nb = item % nblk, k0 = 64 * kb, n0 = 32 * nb;
#pragma unroll 8
    for (int i = 0; i < 32; ++i) { const int kk = 2 * i + (lane >> 5); scr[kk * 33 + (lane & 31)] = W[(size_t)(k0 + kk) * N + n0 + (lane & 31)]; }
    asm volatile("s_waitcnt lgkmcnt(0)" ::: "memory");
    const int c = lane & 7;
#pragma unroll
    for (int j = 0; j < 4; ++j) { const int n = (lane >> 3) + 8 * j; const LAS float* s = scr + (8 * c) * 33 + n;
        v4u o; o.x = pk2(s[0 * 33], s[1 * 33]); o.y = pk2(s[2 * 33], s[3 * 33]); o.z = pk2(s[4 * 33], s[5 * 33]); o.w = pk2(s[6 * 33], s[7 * 33]);
        *(v4u*)(WT + (size_t)(n0 + n) * K + k0 + 8 * c) = o; }
    asm volatile("s_waitcnt lgkmcnt(0)" ::: "memory");
}
__device__ __forceinline__ const float* xrow_ptr(const Params& p, int row) { return row < NPROMPT_ROWS ? p.in[0] + (size_t)row * DMODEL : p.in[1] + (size_t)(row - NPROMPT_ROWS) * DMODEL; }
__device__ __forceinline__ int row_batch(int row) { return row < NPROMPT_ROWS ? (row >> 13) : 4 + ((row - NPROMPT_ROWS) >> 11); }

__global__ void __launch_bounds__(512, 2) mega_fwd(Params p) {
    extern __shared__ __attribute__((aligned(16))) unsigned char lds_raw[];
    LAS unsigned char* lds = (LAS unsigned char*)lds_raw;
    cg::grid_group grid = cg::this_grid();
    const int tid = threadIdx.x, lane = tid & 63, wave = __builtin_amdgcn_readfirstlane(tid >> 6);
    const int G = gridDim.x, bx = blockIdx.x;
    const int vcu = (G % 8 == 0) ? (bx % 8) * (G / 8) + bx / 8 : bx;
    unsigned char* dob = (unsigned char*)p.out;
    bf16* H = (bf16*)(dob + DO_H); bf16* WIN = (bf16*)(dob + DO_WIN); bf16* WOUT = (bf16*)(dob + DO_WOUT);
    float* MOD = (float*)(dob + DO_MOD); float* ROPE = (float*)(dob + DO_ROPE); float* MISC = (float*)(dob + DO_MISC);
    bf16* PROJ = (bf16*)(p.ws + WS_PROJ); bf16* YB = (bf16*)(p.ws + WS_Y); float* SSQ = (float*)(p.ws + WS_SSQ); float* GATE = (float*)(p.ws + WS_GATE);
    const int gw = vcu * 8 + wave, NGW = G * 8;

    if (p.mask & 1) {
        LAS float* scr = (LAS float*)(lds + wave * 16384);
        constexpr int I_IN = (DMODEL / 64) * (DPROJ / 32), I_OUT = (DMODEL / 64) * (DMODEL / 32);
        for (int it = gw; it < I_IN + I_OUT; it += NGW) {
            if (it < I_IN) transpose_item(p.in[4], DMODEL, DPROJ, WIN, scr, it, lane);
            else transpose_item(p.in[5], DMODEL, DMODEL, WOUT, scr, it - I_IN, lane);
        }
        for (int e = bx * 512 + tid; e < 8192 * 8; e += G * 512) {
            const int pos = e >> 3, i = e & 7;
            const float inv = exp2f(-(float)i * (1.0f / 8.0f) * 18.931568569324174f);
            const float ang = (float)pos * inv;
            const double ad = (double)ang; const double n = rint(ad * 0.15915494309189535); const float red = (float)(ad - n * 6.283185307179586);
            ROPE[2 * e] = cosf(red); ROPE[2 * e + 1] = sinf(red);
        }
        __syncthreads();
        if (bx < 192) {
            LAS float* sc = (LAS float*)lds;
            LAS float* red = (LAS float*)(lds + 81920);
            for (int i = tid; i < NBATCH * DMODEL; i += 512) { const int b = i >> 10, k = i & 1023; const float cv = b < 4 ? p.in[2][b * DMODEL + k] : p.in[3][(b - 4) * DMODEL + k]; sc[i] = cv / (1.f + __expf(-cv)); }
            __syncthreads();
            const int col = tid & 15, ks = tid >> 4, j = bx * 16 + col;
            float acc[NBATCH];
#pragma unroll
            for (int b = 0; b < NBATCH; ++b) acc[b] = 0.f;
            for (int k = ks; k < DMODEL; k += 32) { const float w = p.in[8][(size_t)k * 3072 + j];
#pragma unroll
                for (int b = 0; b < NBATCH; ++b) acc[b] += sc[b * DMODEL + k] * w; }
#pragma unroll
            for (int b = 0; b < NBATCH; ++b) red[(ks * NBATCH + b) * 16 + col] = acc[b];
            __syncthreads();
            if (tid < NBATCH * 16) { const int b = tid >> 4, cc = tid & 15; float s = 0.f;
                for (int k2 = 0; k2 < 32; ++k2) s += red[(k2 * NBATCH + b) * 16 + cc];
                MOD[b * 3072 + bx * 16 + cc] = s + p.in[9][bx * 16 + cc]; }
        }
        if (bx == G - 1 && wave == 0) {
            const float a = wave_sum(p.in[10][lane] * p.in[11][lane]), b2 = wave_sum(p.in[12][lane] * p.in[13][lane]);
            if (lane == 0) MISC[0] = expf(a) - expf(b2) + 0.2f;
        }
    }
    asm volatile("s_waitcnt vmcnt(0)" ::: "memory");
    grid.sync();
    if (p.mask & 2) { const int lane = att::fresh_tid() & 63;
    for (int row = gw; row < NTOK; row += NGW) {
        const f32x4g* xr = (const f32x4g*)xrow_ptr(p, row) + lane;
        const int b = row_batch(row);
        f32x4g v[4]; float s = 0.f;
#pragma unroll
        for (int j = 0; j < 4; ++j) { v[j] = xr[64 * j]; s += (v[j].x * v[j].x + v[j].y * v[j].y) + (v[j].z * v[j].z + v[j].w * v[j].w); }
        const float rstd = rsqrtf(wave_sum(s) * (1.f / DMODEL) + 1e-6f);
        unsigned long long* o8 = (unsigned long long*)(H + (size_t)row * DMODEL) + lane;
#pragma unroll
        for (int j = 0; j < 4; ++j) {
            const f32x4g g = ((const f32x4g*)p.in[6])[lane + 64 * j], sh = ((const f32x4g*)(MOD + b * 3072))[lane + 64 * j], sl = ((const f32x4g*)(MOD + b * 3072 + 1024))[lane + 64 * j];
            const f32x4g hv = v[j] * rstd * g * (sl + 1.f) + sh;
            o8[64 * j] = (unsigned long long)pk2(hv.x, hv.y) | ((unsigned long long)pk2(hv.z, hv.w) << 32);
        }
    } }
    asm volatile("s_waitcnt vmcnt(0)" ::: "memory");
    grid.sync();
#ifndef NO_P1
    if (p.mask & 4) {
        pg8::Gemm g{H, WIN, NTOK, DPROJ, DMODEL}; pg8::StaticOrder S; S.init(NTOK, DPROJ, G, bx);
        pg8::EpiProj E{PROJ, DPROJ, ROPE};
        pg8::gemm_phase<pg8::EpiProj, pg8::StaticOrder, true, true>(lds, g, S, E);
    }
#endif
    asm volatile("s_waitcnt vmcnt(0)" ::: "memory");
    grid.sync();
    {
        bf16* YM = H;
        const float lam = MISC[0];
#ifndef NO_DIFF
        if (p.mask & 8)
        for (int u = vcu; u < 2048; u += G) {
            int bh, qt, S; long rowbase;
            if (u < 1024) { bh = (u & 255) >> 4; qt = (u & 15) * 4 + (u >> 8); S = 8192; rowbase = (long)(bh >> 2) * 8192; }
            else { const int u2 = u - 1024; bh = (u2 & 255) >> 2; qt = (u2 & 3) * 4 + (u2 >> 8); S = 2048; rowbase = NPROMPT_ROWS + (long)(bh >> 2) * 2048; }
            att::diff_unit(PROJ, YM, rowbase, S, bh & 3, qt, (LAS char*)lds, lam, p.in[14]);
        }
#endif
#ifndef NO_DIL
        LAS char* vl = (LAS char*)lds + wave * 8448; LAS float* wsf = (LAS float*)(lds + wave * 8448 + 8192);
        LAS att::bf16* OA = (LAS att::bf16*)(lds + 67584); LAS float* ML = (LAS float*)(lds + 67584 + 65536);
        if (p.mask & 16)
        for (int u = vcu; u < 1024; u += G) {
            int b, h, c, S; long rowbase;
            if (u < 512) { const int id = (u & 255) * 2 + (u >> 8); c = id & 15; h = (id >> 4) & 7; b = id >> 7; S = 8192; rowbase = (long)b * 8192; }
            else { const int u2 = u - 512; const int id = (u2 & 255) * 2 + (u2 >> 8); c = id & 3; h = (id >> 2) & 7; b = id >> 5; S = 2048; rowbase = NPROMPT_ROWS + (long)b * 2048; }
            att::dil_item_a(PROJ, rowbase, S, h, c, wave, vl, wsf, OA, ML);
            att::dil_item_a(PROJ, rowbase, S, h, c, wave + 8, vl, wsf, OA, ML);
            __syncthreads();
            att::dil_item_b(PROJ, YM, rowbase, S, h, c, wave, vl, wsf, OA, ML);
            att::dil_item_b(PROJ, YM, rowbase, S, h, c, wave + 8, vl, wsf, OA, ML);
            __syncthreads();
        }
#endif
    }
    asm volatile("s_waitcnt vmcnt(0)" ::: "memory");
    grid.sync();
    if (p.mask & 32) {
        for (int i = bx * 512 + tid; i < NBATCH * DMODEL; i += G * 512) GATE[i] = MOD[(i >> 10) * 3072 + 2048 + (i & 1023)];
#ifndef NO_P3
        pg8::Gemm g{H, WOUT, NTOK, DMODEL, DMODEL}; pg8::StaticOrder S; S.init(NTOK, DMODEL, G, bx);
        pg8::EpiY E{YB, DMODEL, SSQ};
        pg8::gemm_phase<pg8::EpiY, pg8::StaticOrder, true, true>(lds, g, S, E);
#endif
    }
    asm volatile("s_waitcnt vmcnt(0)" ::: "memory");
    grid.sync();
    if (p.mask & 64) { const int lane = att::fresh_tid() & 63;
    for (int row = gw; row < NTOK; row += NGW) {
        const f32x4g* xr = (const f32x4g*)xrow_ptr(p, row) + lane;
        const int b = row_batch(row);
        const float ss = wave_sum(lane < 16 ? SSQ[(size_t)row * 16 + lane] : 0.f);
        const float rstd = rsqrtf(ss * (1.f / DMODEL) + 1e-6f);
        const unsigned long long* y8 = (const unsigned long long*)(YB + (size_t)row * DMODEL) + lane;
        f32x4g* orow = (f32x4g*)(p.out + (size_t)row * DMODEL) + lane;
#pragma unroll
        for (int j = 0; j < 4; ++j) {
            const unsigned long long yv = y8[64 * j];
            f32x4g y; y.x = __uint_as_float(((unsigned)yv) << 16); y.y = __uint_as_float(((unsigned)yv) & 0xffff0000u);
            y.z = __uint_as_float(((unsigned)(yv >> 32)) << 16); y.w = __uint_as_float(((unsigned)(yv >> 32)) & 0xffff0000u);
            const f32x4g gt = ((const f32x4g*)(GATE + b * DMODEL))[lane + 64 * j], gp = ((const f32x4g*)p.in[7])[lane + 64 * j];
            orow[64 * j] = xr[64 * j] + gt * (y * rstd) * gp;
        }
    } }
}

extern "C" void kernel_launch(void* const* d_in, const int* in_sizes, int n_in, void* d_out, int out_size, void* d_ws, size_t ws_size, hipStream_t stream) {
    static int grid = 0;
    if (grid == 0) {
        if (n_in != 15 || ws_size < WS_NEED || out_size != NTOK * DMODEL) { fprintf(stderr, "kernel_launch: unexpected shapes (n_in %d, ws %zu, out %d)\n", n_in, ws_size, out_size); grid = -1; return; }
        int dev = 0, cus = 0, per_cu = 0;
        hipGetDevice(&dev); hipDeviceGetAttribute(&cus, hipDeviceAttributeMultiprocessorCount, dev);
        hipFuncSetAttribute((const void*)mega_fwd, hipFuncAttributeMaxDynamicSharedMemorySize, LDS_BYTES);
        hipOccupancyMaxActiveBlocksPerMultiprocessor(&per_cu, (const void*)mega_fwd, 512, LDS_BYTES);
        (void)hipGetLastError();
        if (per_cu < 1) per_cu = 1;
        grid = cus;
    }
    if (grid < 0) return;
    Params p{};
    for (int i = 0; i < 15; ++i) p.in[i] = (const float*)d_in[i];
    p.out = (float*)d_out; p.ws = (unsigned char*)d_ws; p.mask = 127;
#ifdef PROBE_MASK
    { Params p2 = p; p2.mask = PROBE_MASK; void* args2[] = {&p2}; (void)hipLaunchCooperativeKernel((const void*)mega_fwd, dim3(grid), dim3(512), args2, LDS_BYTES, stream); }
#endif
    void* args[] = {&p};
    hipError_t e = hipLaunchCooperativeKernel((const void*)mega_fwd, dim3(grid), dim3(512), args, LDS_BYTES, stream);
    if (e != hipSuccess) fprintf(stderr, "cooperative launch failed: %s (grid %d)\n", hipGetErrorString(e), grid);
}
```

```cpp
#include <hip/hip_runtime.h>
#include <hip/hip_cooperative_groups.h>
#include <cstdio>
#include <cstdint>
namespace cg = cooperative_groups;
constexpr float QK_C2 = 0.125f * 1.4426950408889634f;
namespace pg8 {
#define PG8_LAS __attribute__((address_space(3)))
typedef unsigned short bf16_t;
typedef short bf16x8 __attribute__((ext_vector_type(8)));
typedef float f32x4 __attribute__((ext_vector_type(4)));
typedef unsigned u32x4 __attribute__((ext_vector_type(4)));
constexpr int BM = 256, BK = 64, HALF = 128, HTB = HALF * BK * 2  , STAGE_BYTES = 8 * HTB, NXCD = 8, WGM = 8;

__host__ __device__ __forceinline__ int lds_byte(int r, int c) { const int st = (r >> 4) * 2 + (c >> 5), rr = r & 15, cc = c & 31, ob = rr * 64 + cc * 2; return st * 1024 + (ob ^ (((ob >> 9) & 1) << 5)); }
__host__ __device__ __forceinline__ void stage_rc(int b, int& R, int& C) { const int st = b / 1024, sb = b % 1024, swz = sb ^ (((sb >> 9) & 1) << 5); R = (st >> 1) * 16 + swz / 64; C = (st & 1) * 32 + (swz % 64) / 2; }
__host__ __device__ __forceinline__ int perm32(int rho) { const int n = rho >> 4, i = rho & 15; return 8 * (i >> 2) + 4 * n + (i & 3); }

struct Unit { int pm, pn; };
struct Gemm { const bf16_t* A; const bf16_t* Bt; int M, N, K; };

struct StaticOrder {
    int nM, nN, nwg, G, c;
    __host__ __device__ void init(int M, int N, int G_, int c_) { nM = M / BM; nN = N / BM; nwg = nM * nN; G = G_; c = c_; }
    __host__ __device__ bool next(int i, Unit& u) const {
        const long L = (long)i * G + c; if (L >= nwg) return false;
        int wgid = (int)L; { const int q = nwg / NXCD, r = nwg % NXCD, xcd = wgid % NXCD, off = wgid / NXCD; wgid = (xcd < r ? xcd * (q + 1) : r * (q + 1) + (xcd - r) * q) + off; }
        const int nig = WGM * nN, gid = wgid / nig, fm = gid * WGM, gsz = (nM - fm) < WGM ? (nM - fm) : WGM;
        u.pm = fm + ((wgid % nig) % gsz); u.pn = (wgid % nig) / gsz; return true;
    }
    __device__ __forceinline__ void a_ready(const Unit&) const {}
    __device__ __forceinline__ void done(const Unit&) const {}
};

__device__ __forceinline__ unsigned cvt_pk_bf16(float lo, float hi) { unsigned r; asm volatile("v_cvt_pk_bf16_f32 %0, %1, %2" : "=v"(r) : "v"(lo), "v"(hi)); return r; }
struct EpiProj {
    static constexpr bool PERM = true, AFTER_DRAIN = false;
    bf16_t* O; int ldc; const float* rope;
    __device__ __forceinline__ void operator()(const f32x4 (&acc)[2][2][4][2], const Unit& u, int wr, int wc, int fr, int fq) const {
        const int row0 = u.pm * BM + wr * 64 + fr;
        const bool tile_rope = (u.pn & 4) == 0;
        const bool lane_rope = tile_rope && ((wc & 1) == 0) && (fq < 2);
        const float sc = ((u.pn & 6) == 0) ? QK_C2 : 1.f;
        const float sgn = (fq == 0) ? -1.f : 1.f;
        const int col0 = u.pn * BM + wc * 32 + 8 * fq;
#pragma unroll
        for (int ai = 0; ai < 2; ++ai)
#pragma unroll
            for (int m = 0; m < 4; ++m) {
                const int row = row0 + ai * HALF + m * 16;
                const int pos = row < 32768 ? (row & 8191) : (row & 2047);
                f32x4 cs[4];
                if (tile_rope) {
#pragma unroll
                    for (int q = 0; q < 4; ++q) cs[q] = *(const f32x4*)(rope + (size_t)pos * 16 + q * 4);
                }
                bf16_t* rowp = O + (size_t)row * ldc + col0;
#pragma unroll
                for (int bj = 0; bj < 2; ++bj) {
                    f32x4 v0 = acc[ai][bj][m][0], v1 = acc[ai][bj][m][1];
                    if (tile_rope) {
                        f32x4 p0, p1;
#pragma unroll
                        for (int j = 0; j < 4; ++j) { p0[j] = __shfl_xor(v0[j], 16); p1[j] = __shfl_xor(v1[j], 16); }
                        if (lane_rope) {
                            v0[0] = v0[0] * cs[0][0] + sgn * p0[0] * cs[0][1]; v0[1] = v0[1] * cs[0][2] + sgn * p0[1] * cs[0][3];
                            v0[2] = v0[2] * cs[1][0] + sgn * p0[2] * cs[1][1]; v0[3] = v0[3] * cs[1][2] + sgn * p0[3] * cs[1][3];
                            v1[0] = v1[0] * cs[2][0] + sgn * p1[0] * cs[2][1]; v1[1] = v1[1] * cs[2][2] + sgn * p1[1] * cs[2][3];
                            v1[2] = v1[2] * cs[3][0] + sgn * p1[2] * cs[3][1]; v1[3] = v1[3] * cs[3][2] + sgn * p1[3] * cs[3][3];
                        }
                    }
                    v0 = v0 * sc; v1 = v1 * sc;
                    u32x4 w; w.x = cvt_pk_bf16(v0[0], v0[1]); w.y = cvt_pk_bf16(v0[2], v0[3]); w.z = cvt_pk_bf16(v1[0], v1[1]); w.w = cvt_pk_bf16(v1[2], v1[3]);
                    *(u32x4*)(rowp + bj * HALF) = w;
                }
            }
    }
};
struct EpiY {
    static constexpr bool PERM = true, AFTER_DRAIN = false;
    bf16_t* O; int ldc; float* ssq;
    __device__ __forceinline__ void operator()(const f32x4 (&acc)[2][2][4][2], const Unit& u, int wr, int wc, int fr, int fq) const {
        const int row0 = u.pm * BM + wr * 64 + fr;
        const int col0 = u.pn * BM + wc * 32 + 8 * fq;
#pragma unroll
        for (int ai = 0; ai < 2; ++ai)
#pragma unroll
            for (int m = 0; m < 4; ++m) {
                const int row = row0 + ai * HALF + m * 16;
                bf16_t* rowp = O + (size_t)row * ldc + col0;
                float s = 0.f;
#pragma unroll
                for (int bj = 0; bj < 2; ++bj) {
                    const f32x4 v0 = acc[ai][bj][m][0], v1 = acc[ai][bj][m][1];
                    s += (v0[0] * v0[0] + v0[1] * v0[1]) + (v0[2] * v0[2] + v0[3] * v0[3]) + (v1[0] * v1[0] + v1[1] * v1[1]) + (v1[2] * v1[2] + v1[3] * v1[3]);
                    u32x4 w; w.x = cvt_pk_bf16(v0[0], v0[1]); w.y = cvt_pk_bf16(v0[2], v0[3]); w.z = cvt_pk_bf16(v1[0], v1[1]); w.w = cvt_pk_bf16(v1[2], v1[3]);
                    *(u32x4*)(rowp + bj * HALF) = w;
                }
                s += __shfl_xor(s, 16); s += __shfl_xor(s, 32);
                if (fq == 0) ssq[(size_t)row * 16 + u.pn * 4 + wc] = s;
            }
    }
};
template <class Epi, class Sched, bool ALIGN_EPI = false, bool SP2 = false>
__device__ __forceinline__ void gemm_phase(PG8_LAS unsigned char* lds, const Gemm g, const Sched& S, const Epi& E) {
    const int tid = threadIdx.x, wid = __builtin_amdgcn_readfirstlane(tid >> 6), lane = tid & 63, wr = wid >> 2, wc = wid & 3, fr = lane & 15, fq = lane >> 4;
    const int K = g.K, nt = K / BK;
    unsigned voffA[2], voffB[2];
#pragma unroll
    for (int i = 0; i < 2; ++i) { int R, C; stage_rc(tid * 16 + i * 8192, R, C); const int Rb = Epi::PERM ? ((R & ~31) + perm32(R & 31)) : R;
        voffA[i] = (unsigned)(R * K + C) * 2u; voffB[i] = (unsigned)(Rb * K + C) * 2u; }
    const size_t kstep = (size_t)(BK * 2);
    const size_t hstep = (size_t)HALF * K * 2;
    const size_t tstep = 2 * hstep;
    const unsigned ldsw = (unsigned)wid * 1024u;
    const int aoff = lds_byte(wr * 64 + fr, fq * 8), boff = lds_byte(wc * 32 + fr, fq * 8);
#define PG8_SA(b, h) (((b) * 2 + (h)) * HTB)
#define PG8_SB(b, h) ((4 + (b) * 2 + (h)) * HTB)
#define PG8_STAGE(bufoff, gbase, voff) do { _Pragma("unroll") for (int _i = 0; _i < 2; ++_i) \
        __builtin_amdgcn_global_load_lds((const unsigned*)((const char*)(gbase) + (voff)[_i]), (PG8_LAS unsigned*)(lds + (bufoff) + ldsw + _i * 8192), 16, 0, 0); } while (0)
#define PG8_LDA(dst, b, h) do { _Pragma("unroll") for (int m = 0; m < 4; ++m) _Pragma("unroll") for (int k = 0; k < 2; ++k) dst[m][k] = *(const PG8_LAS bf16x8*)(lds + PG8_SA(b, h) + aoff + m * 2048 + k * 1024); } while (0)
#define PG8_LDB(dst, b, h) do { _Pragma("unroll") for (int n = 0; n < 2; ++n) _Pragma("unroll") for (int k = 0; k < 2; ++k) dst[n][k] = *(const PG8_LAS bf16x8*)(lds + PG8_SB(b, h) + boff + n * 2048 + k * 1024); } while (0)
#define PG8_MMA(ai, bj, At, Bt) do { __builtin_amdgcn_s_setprio(1); _Pragma("unroll") for (int m = 0; m < 4; ++m) _Pragma("unroll") for (int n = 0; n < 2; ++n) _Pragma("unroll") for (int k = 0; k < 2; ++k) \
        acc[ai][bj][m][n] = __builtin_amdgcn_mfma_f32_16x16x32_bf16(Bt[n][k], At[m][k], acc[ai][bj][m][n], 0, 0, 0); __builtin_amdgcn_s_setprio(0); } while (0)
#define PG8_WAIT_V(n) asm volatile("s_waitcnt vmcnt(" #n ")" ::: "memory")
#define PG8_WAIT_L(n) asm volatile("s_waitcnt lgkmcnt(" #n ")" ::: "memory")
#define PG8_BAR __builtin_amdgcn_s_barrier()
#define PG8_SCHED __builtin_amdgcn_sched_barrier(0)
    Unit cur, nxt; int ui = 0;
    if (!S.next(0, cur)) return;
    f32x4 acc[2][2][4][2];
#pragma unroll
    for (int a = 0; a < 2; ++a)
#pragma unroll
        for (int b = 0; b < 2; ++b)
#pragma unroll
            for (int m = 0; m < 4; ++m)
#pragma unroll
                for (int n = 0; n < 2; ++n) acc[a][b][m][n] = (f32x4){0.f, 0.f, 0.f, 0.f};
    bf16x8 At[4][2], B0[2][2], B1[2][2];
    const char* cA = (const char*)g.A + (size_t)cur.pm * tstep; const char* cB = (const char*)g.Bt + (size_t)cur.pn * tstep;
    S.a_ready(cur);
    if constexpr (SP2) {
        PG8_STAGE(PG8_SB(0, 0), cB, voffB); PG8_STAGE(PG8_SB(0, 1), cB + hstep, voffB); PG8_STAGE(PG8_SA(0, 0), cA, voffA); PG8_STAGE(PG8_SA(0, 1), cA + hstep, voffA);
        if (wr == 1) PG8_BAR;
        PG8_WAIT_V(2); PG8_BAR;
        PG8_STAGE(PG8_SB(1, 0), cB + kstep, voffB); PG8_STAGE(PG8_SA(1, 0), cA + kstep, voffA); PG8_STAGE(PG8_SB(1, 1), cB + hstep + kstep, voffB);
        PG8_WAIT_V(6); PG8_BAR;
    } else {
        PG8_STAGE(PG8_SB(0, 0), cB, voffB); PG8_STAGE(PG8_SA(0, 0), cA, voffA); PG8_STAGE(PG8_SB(0, 1), cB + hstep, voffB); PG8_STAGE(PG8_SA(0, 1), cA + hstep, voffA);
        if (wr == 1) PG8_BAR;
        PG8_WAIT_V(4); PG8_BAR;
        PG8_STAGE(PG8_SB(1, 0), cB + kstep, voffB); PG8_STAGE(PG8_SA(1, 0), cA + kstep, voffA); PG8_STAGE(PG8_SB(1, 1), cB + hstep + kstep, voffB);
        PG8_WAIT_V(6); PG8_BAR;
    }
    for (;;) {
        const bool has_next = S.next(ui + 1, nxt);
        const char* nA = has_next ? (const char*)g.A + (size_t)nxt.pm * tstep : cA; const char* nB = has_next ? (const char*)g.Bt + (size_t)nxt.pn * tstep : cB;
        for (int t = 0; t < nt; t += 2) {
            const bool last = (t == nt - 2);
            const char* a1 = cA + (size_t)(t + 1) * kstep;
            const char* a2 = last ? nA : cA + (size_t)(t + 2) * kstep; const char* b2 = last ? nB : cB + (size_t)(t + 2) * kstep;
            const char* a3 = a2 + kstep; const char* b3 = b2 + kstep;
            if (last && has_next) S.a_ready(nxt);
            if constexpr (SP2) {
            PG8_LDB(B0, 0, 0); PG8_LDB(B1, 0, 1); PG8_SCHED; PG8_LDA(At, 0, 0); PG8_STAGE(PG8_SA(1, 1), a1 + hstep, voffA);
            PG8_WAIT_V(8); PG8_WAIT_L(0); PG8_BAR; PG8_MMA(0, 0, At, B0); PG8_MMA(0, 1, At, B1); PG8_BAR; PG8_SCHED;
            PG8_LDA(At, 0, 1); PG8_STAGE(PG8_SB(0, 0), b2, voffB); PG8_STAGE(PG8_SB(0, 1), b2 + hstep, voffB); PG8_STAGE(PG8_SA(0, 0), a2, voffA);
            PG8_WAIT_V(8); PG8_WAIT_L(0); PG8_BAR; PG8_MMA(1, 0, At, B0); PG8_MMA(1, 1, At, B1); PG8_BAR; PG8_SCHED;
            PG8_LDB(B0, 1, 0); PG8_LDB(B1, 1, 1); PG8_SCHED; PG8_LDA(At, 1, 0); PG8_STAGE(PG8_SA(0, 1), a2 + hstep, voffA);
            PG8_WAIT_V(8); PG8_WAIT_L(0); PG8_BAR; PG8_MMA(0, 0, At, B0); PG8_MMA(0, 1, At, B1); PG8_BAR; PG8_SCHED;
            PG8_LDA(At, 1, 1); PG8_STAGE(PG8_SB(1, 0), b3, voffB); PG8_STAGE(PG8_SB(1, 1), b3 + hstep, voffB); PG8_STAGE(PG8_SA(1, 0), a3, voffA);
            PG8_WAIT_V(8); PG8_WAIT_L(0); PG8_BAR; PG8_MMA(1, 0, At, B0); PG8_MMA(1, 1, At, B1); PG8_BAR; PG8_SCHED;
            } else {
            PG8_LDB(B0, 0, 0); PG8_SCHED; PG8_LDA(At, 0, 0); PG8_STAGE(PG8_SA(1, 1), a1 + hstep, voffA);
            PG8_WAIT_L(8); PG8_BAR; PG8_WAIT_L(0); PG8_MMA(0, 0, At, B0); PG8_BAR; PG8_SCHED;
            PG8_LDB(B1, 0, 1); PG8_STAGE(PG8_SB(0, 0), b2, voffB);
            PG8_BAR; PG8_WAIT_L(0); PG8_MMA(0, 1, At, B1); PG8_BAR;
            PG8_LDA(At, 0, 1); PG8_STAGE(PG8_SA(0, 0), a2, voffA);
            PG8_BAR; PG8_WAIT_L(0); PG8_MMA(1, 0, At, B0); PG8_BAR; PG8_SCHED;
            PG8_STAGE(PG8_SB(0, 1), b2 + hstep, voffB);
            PG8_WAIT_V(6); PG8_BAR; PG8_MMA(1, 1, At, B1); PG8_BAR;
            PG8_LDB(B0, 1, 0); PG8_SCHED; PG8_LDA(At, 1, 0); PG8_STAGE(PG8_SA(0, 1), a2 + hstep, voffA);
            PG8_WAIT_L(8); PG8_BAR; PG8_WAIT_L(0); PG8_MMA(0, 0, At, B0); PG8_BAR; PG8_SCHED;
            PG8_LDB(B1, 1, 1); PG8_STAGE(PG8_SB(1, 0), b3, voffB);
            PG8_BAR; PG8_WAIT_L(0); PG8_MMA(0, 1, At, B1); PG8_BAR;
            PG8_LDA(At, 1, 1); PG8_STAGE(PG8_SA(1, 0), a3, voffA);
            PG8_BAR; PG8_WAIT_L(0); PG8_MMA(1, 0, At, B0); PG8_BAR; PG8_SCHED;
            PG8_STAGE(PG8_SB(1, 1), b3 + hstep, voffB);
            PG8_WAIT_V(6); PG8_BAR; PG8_MMA(1, 1, At, B1); PG8_BAR;
            }
        }
        if constexpr (ALIGN_EPI) { if (wr == 0) PG8_BAR; }
        if constexpr (!Epi::AFTER_DRAIN) { E(acc, cur, wr, wc, fr, fq); S.done(cur); }
        if (!has_next) break;
#pragma unroll
        for (int a = 0; a < 2; ++a)
#pragma unroll
            for (int b = 0; b < 2; ++b)
#pragma unroll
                for (int m = 0; m < 4; ++m)
#pragma unroll
                    for (int n = 0; n < 2; ++n) acc[a][b][m][n] = (f32x4){0.f, 0.f, 0.f, 0.f};
        cur = nxt; cA = nA; cB = nB; ++ui;
        if constexpr (ALIGN_EPI) { if (wr == 1) PG8_BAR; }
    }
    PG8_WAIT_V(0);
    if constexpr (!ALIGN_EPI) { if (wr == 0) PG8_BAR; }
    PG8_BAR;
    if constexpr (Epi::AFTER_DRAIN) { E.fused(acc, cur, wr, wc, fr, fq, lds, wid, lane); S.done(cur); }
#undef PG8_SA
#undef PG8_SB
#undef PG8_STAGE
#undef PG8_LDA
#undef PG8_LDB
#undef PG8_MMA
#undef PG8_WAIT_V
#undef PG8_WAIT_L
#undef PG8_BAR
#undef PG8_SCHED
}
}
#define LAS __attribute__((address_space(3)))
namespace att {
typedef unsigned short bf16;
typedef short bf16x8 __attribute__((ext_vector_type(8)));
typedef short s16x4 __attribute__((ext_vector_type(4)));
typedef short v4i16_t __attribute__((ext_vector_type(4)));
typedef float f32x16 __attribute__((ext_vector_type(16)));
typedef unsigned u32x4 __attribute__((ext_vector_type(4)));
typedef float f32x2_t __attribute__((ext_vector_type(2)));
typedef __bf16 bf16x2_t __attribute__((ext_vector_type(2)));
typedef LAS const char* lds_cptr;
constexpr int PITCH = 4096;
constexpr int YP = 1024;
__device__ __forceinline__ int fresh_tid() { int t = threadIdx.x; asm volatile("" : "+v"(t)); return t; }
__device__ __forceinline__ int crow(int r, int hi) { return (r & 3) + 8 * (r >> 2) + 4 * hi; }
__device__ __forceinline__ void glds16(const void* gsrc, unsigned lds_dst) { unsigned keep;
  asm volatile("s_mov_b32 %0, m0\n\ts_mov_b32 m0, %2\n\ts_nop 0\n\tglobal_load_lds_dwordx4 %1, off\n\ts_mov_b32 m0, %0" : "=&s"(keep) : "v"(gsrc), "s"(lds_dst) : "memory"); }
__device__ __forceinline__ unsigned cvtpk_s(float lo, float hi) { f32x2_t v = {lo, hi}; bf16x2_t b = __builtin_convertvector(v, bf16x2_t); return __builtin_bit_cast(unsigned, b); }
__device__ __forceinline__ s16x4 vtr(lds_cptr p) { return __builtin_bit_cast(s16x4, __builtin_amdgcn_ds_read_tr16_b64_v4i16((LAS v4i16_t*)p)); }
__device__ __forceinline__ float bf2f(bf16 v) { return __uint_as_float(((unsigned)v) << 16); }
__device__ __forceinline__ bf16 f2bf(float f) { unsigned u = __float_as_uint(f); return (bf16)((u + 0x7fffu + ((u >> 16) & 1u)) >> 16); }
__device__ __forceinline__ float swap_max(float m) { auto rr = __builtin_amdgcn_permlane32_swap(__float_as_uint(m), __float_as_uint(m), false, false); return fmaxf(__uint_as_float(rr[0]), __uint_as_float(rr[1])); }
__device__ __forceinline__ float swap_sum(float m) { auto rr = __builtin_amdgcn_permlane32_swap(__float_as_uint(m), __float_as_uint(m), false, false); return __uint_as_float(rr[0]) + __uint_as_float(rr[1]); }
__device__ __forceinline__ float fadd_s(float a, float b) { float r; asm("v_add_f32_e32 %0, %1, %2" : "=v"(r) : "v"(a), "v"(b)); return r; }
__device__ __forceinline__ float silu(float g) { return g / (1.f + __expf(-g)); }
#define ATT_WAIT_BAR(N) asm volatile("s_waitcnt vmcnt(" #N ") lgkmcnt(0)\n\ts_barrier" ::: "memory")
#define ATT_PACK(P, B) (u32x4){cvtpk_s(P[B], P[B + 1]), cvtpk_s(P[B + 2], P[B + 3]), cvtpk_s(P[B + 4], P[B + 5]), cvtpk_s(P[B + 6], P[B + 7])}
#define ATT_VFR(lo, hi) (bf16x8){lo[0], lo[1], lo[2], lo[3], hi[0], hi[1], hi[2], hi[3]}

constexpr int D_SLOT = 32768, D_NSLOT = 4, D_WSF = D_SLOT * D_NSLOT;
#define ATT_MX3(a, b, c) __builtin_fmaxf(__builtin_fmaxf((a), (b)), (c))
__device__ __forceinline__ void diff_unit(const bf16* __restrict__ P, bf16* __restrict__ Y, long rowbase, int S, int h, int qt, LAS char* shm, float lam, const float* __restrict__ g_sub) {
  const int tid = fresh_tid(), lane = tid & 63, r32 = lane & 31, hi = lane >> 5; const int wid = __builtin_amdgcn_readfirstlane(tid >> 6);
  const int map = wid >> 2, wq = wid & 3;
  const long qrow0 = rowbase + (long)qt * 128 + wq * 32;
  const bf16* Qw = P + qrow0 * PITCH + 2048 + (2 * h + map) * 64;
  const bf16* Kb = P + rowbase * PITCH + 2560 + (2 * h) * 64;
  const bf16* Vb = P + rowbase * PITCH + 3072 + h * 128;
  const unsigned lds0 = (unsigned)(uintptr_t)shm;
  LAS float* wsf = (LAS float*)(shm + D_WSF) + wid * 64;
  const bf16* ksrc0 = Kb + map * 64 + (long)lane * PITCH + (2 * wq) * 8;
  const bf16* ksrc1 = ksrc0 + 8;
  const unsigned kdst0 = map * 8192 + (2 * wq) * 1024, kdst1 = kdst0 + 1024;
  const int vp0 = 2 * wid, vp1 = 2 * wid + 1;
  const bf16* vsrc0 = Vb + (long)(16 * (vp0 & 3) + (lane >> 2)) * PITCH + 32 * (vp0 >> 2) + 8 * (lane & 3);
  const bf16* vsrc1 = Vb + (long)(16 * (vp1 & 3) + (lane >> 2)) * PITCH + 32 * (vp1 >> 2) + 8 * (lane & 3);
  const unsigned vdst0 = 16384 + vp0 * 1024, vdst1 = 16384 + vp1 * 1024;
#define D_DMA(t, slot) do { const long toff_ = (long)(t) * 64 * PITCH; const unsigned sb_ = lds0 + (slot); \
    glds16(ksrc0 + toff_, (unsigned)__builtin_amdgcn_readfirstlane(sb_ + kdst0)); glds16(ksrc1 + toff_, (unsigned)__builtin_amdgcn_readfirstlane(sb_ + kdst1)); \
    glds16(vsrc0 + toff_, (unsigned)__builtin_amdgcn_readfirstlane(sb_ + vdst0)); glds16(vsrc1 + toff_, (unsigned)__builtin_amdgcn_readfirstlane(sb_ + vdst1)); } while (0)
  const int NT = S / 64;
  asm volatile("s_waitcnt vmcnt(0)" ::: "memory");
  bf16x8 qr[4];
#pragma unroll
  for (int d0 = 0; d0 < 4; ++d0) qr[d0] = *reinterpret_cast<const bf16x8*>(&Qw[(long)r32 * PITCH + d0 * 16 + hi * 8]);
  asm volatile("" ::: "memory");
  D_DMA(0, 0); D_DMA(1, D_SLOT); D_DMA(2, 2 * D_SLOT);
  float m = 0.f, l = 0.f;
  f32x16 o[4];
#pragma unroll
  for (int d0 = 0; d0 < 4; ++d0) o[d0] = f32x16{};
  f32x16 negm = f32x16{}; asm volatile("" : "+v"(negm));
  const lds_cptr shm3 = (lds_cptr)shm;
  const lds_cptr kp0 = shm3 + map * 8192 + hi * 1024 + r32 * 16;
  const lds_cptr vp = shm3 + 16384 + ((lane >> 4) & 1) * 32 + (lane & 3) * 8 + (4 * hi + ((lane & 15) >> 2)) * 64;
  bf16x8 pa0, pa1, pa2, pa3;
  pa0 = pa1 = pa2 = pa3 = bf16x8{};
#define D_KLD(SL_) do { const lds_cptr kp = kp0 + (SL_); \
    _Pragma("unroll") for (int d0 = 0; d0 < 4; ++d0) { kf[2 * d0] = *(const LAS bf16x8*)(kp + d0 * 2048); kf[2 * d0 + 1] = *(const LAS bf16x8*)(kp + d0 * 2048 + 512); } } while (0)
#define D_QKSM(T_, SL_) do { \
    f32x16 p0, p1; \
    p0 = __builtin_amdgcn_mfma_f32_32x32x16_bf16(kf[0], qr[0], negm, 0, 0, 0); p1 = __builtin_amdgcn_mfma_f32_32x32x16_bf16(kf[1], qr[0], negm, 0, 0, 0); \
    _Pragma("unroll") for (int d0 = 1; d0 < 4; ++d0) { \
      p0 = __builtin_amdgcn_mfma_f32_32x32x16_bf16(kf[2 * d0], qr[d0], p0, 0, 0, 0); p1 = __builtin_amdgcn_mfma_f32_32x32x16_bf16(kf[2 * d0 + 1], qr[d0], p1, 0, 0, 0); } \
    float ra = ATT_MX3(p0[0], p0[1], p1[0]), rb = ATT_MX3(p0[2], p0[3], p1[1]); ra = ATT_MX3(ra, p1[2], p1[3]); \
    _Pragma("unroll") for (int r = 4; r < 16; r += 4) { ra = ATT_MX3(ra, p0[r], p0[r + 1]); rb = ATT_MX3(rb, p0[r + 2], p0[r + 3]); ra = ATT_MX3(ra, p1[r], p1[r + 1]); rb = ATT_MX3(rb, p1[r + 2], p1[r + 3]); } \
    const float rm = swap_max(fmaxf(ra, rb)); \
    if ((T_) == 0 || __any(rm > 6.f)) { \
      const float dl = ((T_) == 0) ? rm : fmaxf(rm, 0.f); m += dl; \
      _Pragma("unroll") for (int r = 0; r < 16; ++r) { p0[r] -= dl; p1[r] -= dl; } \
      _Pragma("unroll") for (int r = 0; r < 16; ++r) negm[r] = -m; \
      asm volatile("" : "+v"(negm)); \
      const float f = __builtin_amdgcn_exp2f(-dl); l *= f; \
      if (hi == 0) wsf[r32] = f; \
      _Pragma("unroll") for (int r = 0; r < 16; ++r) { const float fr_ = wsf[crow(r, hi)]; \
        _Pragma("unroll") for (int d0 = 0; d0 < 4; ++d0) o[d0][r] *= fr_; } \
    } \
    float sacc = 0.f, sacd = 0.f; \
    _Pragma("unroll") for (int r = 0; r < 16; ++r) { p0[r] = __builtin_amdgcn_exp2f(p0[r]); p1[r] = __builtin_amdgcn_exp2f(p1[r]); sacc = fadd_s(sacc, p0[r]); sacd = fadd_s(sacd, p1[r]); } \
    l += sacc + sacd; \
    pa0 = __builtin_bit_cast(bf16x8, ATT_PACK(p0, 0)); pa1 = __builtin_bit_cast(bf16x8, ATT_PACK(p0, 8)); \
    pa2 = __builtin_bit_cast(bf16x8, ATT_PACK(p1, 0)); pa3 = __builtin_bit_cast(bf16x8, ATT_PACK(p1, 8)); } while (0)
#define D_PV(SL_) do { const lds_cptr vq = vp + (SL_); \
    _Pragma("unroll") for (int d0 = 0; d0 < 4; ++d0) { s16x4 lo[4], hh[4]; \
      _Pragma("unroll") for (int ks = 0; ks < 4; ++ks) { lo[ks] = vtr(vq + d0 * 4096 + ks * 1024); hh[ks] = vtr(vq + d0 * 4096 + ks * 1024 + 512); } \
      o[d0] = __builtin_amdgcn_mfma_f32_32x32x16_bf16(pa0, ATT_VFR(lo[0], hh[0]), o[d0], 0, 0, 0); \
      o[d0] = __builtin_amdgcn_mfma_f32_32x32x16_bf16(pa1, ATT_VFR(lo[1], hh[1]), o[d0], 0, 0, 0); \
      o[d0] = __builtin_amdgcn_mfma_f32_32x32x16_bf16(pa2, ATT_VFR(lo[2], hh[2]), o[d0], 0, 0, 0); \
      o[d0] = __builtin_amdgcn_mfma_f32_32x32x16_bf16(pa3, ATT_VFR(lo[3], hh[3]), o[d0], 0, 0, 0); } } while (0)
  ATT_WAIT_BAR(8);
  bf16x8 kf[8];
  if (map == 1) asm volatile("s_barrier" ::: "memory");
  for (int t = 0; t < NT; ++t) {
    const int cur = (t & 3) * D_SLOT;
    D_KLD(cur);
    D_QKSM(t, cur);
    __builtin_amdgcn_sched_barrier(0);
    if (t + 2 < NT) { ATT_WAIT_BAR(4); } else { ATT_WAIT_BAR(0); }
    __builtin_amdgcn_sched_barrier(0);
    if (t + 3 < NT) D_DMA(t + 3, ((t + 3) & 3) * D_SLOT);
    D_PV(cur);
    __builtin_amdgcn_sched_barrier(0);
    asm volatile("s_waitcnt lgkmcnt(0)\n\ts_barrier" ::: "memory");
    __builtin_amdgcn_sched_barrier(0);
  }
  if (map == 0) asm volatile("s_barrier" ::: "memory");
#undef D_DMA
#undef D_KLD
#undef D_QKSM
#undef D_PV
  l = swap_sum(l);
  { const int te = fresh_tid(); const int lane = te & 63, r32 = lane & 31, hi = lane >> 5;
  LAS float* wsf = (LAS float*)(shm + D_WSF) + wid * 64;
  if (hi == 0) wsf[32 + r32] = (map == 1 ? lam : 1.f) / l;
  float inv[16];
#pragma unroll
  for (int r = 0; r < 16; ++r) inv[r] = wsf[32 + crow(r, hi)];
  ATT_WAIT_BAR(0);
  LAS float* X = (LAS float*)shm + wq * 4096;
  if (map == 1) {
#pragma unroll
    for (int d0 = 0; d0 < 4; ++d0)
#pragma unroll
      for (int r = 0; r < 16; ++r) X[(d0 * 16 + r) * 64 + lane] = o[d0][r] * inv[r];
  }
  ATT_WAIT_BAR(0);
  if (map == 0) {
    const bf16* Gw = P + qrow0 * PITCH + 3584 + h * 128;
    bf16* Yw = Y + qrow0 * YP + 512 + h * 128;
    float gs[4];
#pragma unroll
    for (int d0 = 0; d0 < 4; ++d0) gs[d0] = g_sub[d0 * 32 + r32] * 0.8f;
#pragma unroll
    for (int r = 0; r < 16; ++r) {
      float v[4]; float ss = 0.f;
#pragma unroll
      for (int d0 = 0; d0 < 4; ++d0) { v[d0] = o[d0][r] * inv[r] - X[(d0 * 16 + r) * 64 + lane]; ss += v[d0] * v[d0]; }
      ss += __shfl_xor(ss, 1); ss += __shfl_xor(ss, 2); ss += __shfl_xor(ss, 4); ss += __shfl_xor(ss, 8); ss += __shfl_xor(ss, 16);
      const float rstd = rsqrtf(ss * (1.f / 128.f) + 1e-6f);
      const int q = crow(r, hi);
#pragma unroll
      for (int d0 = 0; d0 < 4; ++d0) { const float g = bf2f(Gw[(long)q * PITCH + d0 * 32 + r32]);
        Yw[(long)q * YP + d0 * 32 + r32] = f2bf(v[d0] * rstd * gs[d0] * silu(g)); }
    }
  }
  }
  ATT_WAIT_BAR(0);
}

template <int DIL, int NBLK, int QSTEP>
__device__ __forceinline__ void dil_pattern(const bf16* __restrict__ Kb, const bf16* __restrict__ Vb, int S, int i0, int resid, const bf16x8 (&qr)[4], float& m, float& l, f32x16 (&o)[2],
                                            LAS char* vl, LAS float* wsf, int lane, int r32, int hi) {
  const int L = S / DIL;
  const int qidx = i0 + QSTEP * r32;
  const lds_cptr vq = (lds_cptr)vl + ((lane >> 4) & 1) * 32 + (lane & 3) * 8 + (4 * hi + ((lane & 15) >> 2)) * 64;
  const int lrow = lane >> 3, lch = lane & 7;
  LAS char* kw = vl + 4096 + lch * 512 + ((lrow ^ lch) * 16);
  LAS char* vw = vl + (lch >> 2) * 2048 + (lrow & 7) * 64 + (lch & 3) * 16;
  const lds_cptr kr_ = (lds_cptr)vl + 4096;
  int kb_lo = (64 - i0) >> 5; kb_lo = kb_lo < 0 ? 0 : kb_lo;
  int kb_hi = (L + 64 - i0 + 31) >> 5; kb_hi = kb_hi > NBLK ? NBLK : kb_hi;
  u32x4 kr[4], vr[4];
#define DIL_LOAD(KB_) do { const int kbase_ = i0 - 64 + 32 * (KB_); \
    _Pragma("unroll") for (int i = 0; i < 4; ++i) { int kx_ = kbase_ + 8 * i + lrow; kx_ = kx_ < 0 ? 0 : (kx_ >= L ? L - 1 : kx_); \
      const long ro_ = (long)(resid + DIL * kx_) * PITCH + lch * 8; \
      kr[i] = *reinterpret_cast<const u32x4*>(Kb + ro_); vr[i] = *reinterpret_cast<const u32x4*>(Vb + ro_); } } while (0)
  DIL_LOAD(kb_lo);
  for (int kb = kb_lo; kb < kb_hi; ++kb) {
    const int kbase = i0 - 64 + 32 * kb;
#pragma unroll
    for (int i = 0; i < 4; ++i) { *(LAS u32x4*)(kw + i * 128) = kr[i]; *(LAS u32x4*)(vw + (i >> 1) * 1024 + (i & 1) * 512) = vr[i]; }
    { const int kn = (kb + 1 < kb_hi) ? kb + 1 : kb; DIL_LOAD(kn); }
    f32x16 p0 = f32x16{};
#pragma unroll
    for (int d0 = 0; d0 < 4; ++d0) { const int ch = 2 * d0 + hi;
      const bf16x8 kfr = *(const LAS bf16x8*)(kr_ + ch * 512 + ((r32 ^ ch) * 16));
      p0 = __builtin_amdgcn_mfma_f32_32x32x16_bf16(kfr, qr[d0], p0, 0, 0, 0); }
    float rm = -1e30f;
#pragma unroll
    for (int rr = 0; rr < 16; ++rr) { const int kidx = kbase + crow(rr, hi); const int rel = kidx - qidx;
      const bool ok = ((unsigned)(rel + 64) <= 128u) && ((unsigned)kidx < (unsigned)L);
      p0[rr] = ok ? p0[rr] : -1e30f; rm = fmaxf(rm, p0[rr]); }
    rm = swap_max(rm);
    if (__any(rm > m + 6.f)) {
      const float mn = fmaxf(m, rm); const float f = __builtin_amdgcn_exp2f(m - mn); m = mn; l *= f;
      if (hi == 0) wsf[r32] = f;
#pragma unroll
      for (int rr = 0; rr < 16; ++rr) { const float fr_ = wsf[crow(rr, hi)]; o[0][rr] *= fr_; o[1][rr] *= fr_; }
    }
    float sacc = 0.f;
#pragma unroll
    for (int rr = 0; rr < 16; ++rr) { p0[rr] = __builtin_amdgcn_exp2f(p0[rr] - m); sacc += p0[rr]; }
    l += sacc;
    const bf16x8 pa0 = __builtin_bit_cast(bf16x8, ATT_PACK(p0, 0)), pa1 = __builtin_bit_cast(bf16x8, ATT_PACK(p0, 8));
#pragma unroll
    for (int d0 = 0; d0 < 2; ++d0) {
      const s16x4 lo0 = vtr(vq + d0 * 2048), hi0 = vtr(vq + d0 * 2048 + 512), lo1 = vtr(vq + d0 * 2048 + 1024), hi1 = vtr(vq + d0 * 2048 + 1536);
      o[d0] = __builtin_amdgcn_mfma_f32_32x32x16_bf16(pa0, ATT_VFR(lo0, hi0), o[d0], 0, 0, 0);
      o[d0] = __builtin_amdgcn_mfma_f32_32x32x16_bf16(pa1, ATT_VFR(lo1, hi1), o[d0], 0, 0, 0);
    }
  }
#undef DIL_LOAD
}
__device__ __forceinline__ void dil_item_a(const bf16* __restrict__ P, long rowbase, int S, int h, int c, int r, LAS char* vl, LAS float* wsf, LAS bf16* OA, LAS float* ML) {
  const int lane = fresh_tid() & 63, r32 = lane & 31, hi = lane >> 5;
  const bf16* Qb = P + rowbase * PITCH + h * 64;
  const bf16* Kb = Qb + 512; const bf16* Vb = Qb + 1024;
  const int tq0 = 512 * c + r;
  bf16x8 qr[4];
#pragma unroll
  for (int d0 = 0; d0 < 4; ++d0) qr[d0] = *reinterpret_cast<const bf16x8*>(Qb + (long)(tq0 + 16 * r32) * PITCH + d0 * 16 + hi * 8);
  float m = -1e30f, l = 0.f; f32x16 o[2]; o[0] = f32x16{}; o[1] = f32x16{};
  dil_pattern<16, 5, 1>(Kb, Vb, S, 32 * c, r, qr, m, l, o, vl, wsf, lane, r32, hi);
  dil_pattern<4, 8, 4>(Kb, Vb, S, 128 * c + (r >> 2), r & 3, qr, m, l, o, vl, wsf, lane, r32, hi);
  l = swap_sum(l);
  if (hi == 0) { wsf[32 + r32] = 1.f / l; ML[(r + 16 * r32) * 2] = m; ML[(r + 16 * r32) * 2 + 1] = l; }
#pragma unroll
  for (int rr = 0; rr < 16; ++rr) { const float iv = wsf[32 + crow(rr, hi)]; const int tl = r + 16 * crow(rr, hi);
#pragma unroll
    for (int d0 = 0; d0 < 2; ++d0) OA[tl * 64 + d0 * 32 + r32] = f2bf(o[d0][rr] * iv); }
}
__device__ __forceinline__ void dil_item_b(const bf16* __restrict__ P, bf16* __restrict__ Y, long rowbase, int S, int h, int c, int j, LAS char* vl, LAS float* wsf, const LAS bf16* OA, const LAS float* ML) {
  const int lane = fresh_tid() & 63, r32 = lane & 31, hi = lane >> 5;
  const bf16* Qb = P + rowbase * PITCH + h * 64;
  const bf16* Kb = Qb + 512; const bf16* Vb = Qb + 1024; const bf16* Gb = Qb + 1536;
  const int tq0 = 512 * c + 32 * j;
  bf16x8 qr[4];
#pragma unroll
  for (int d0 = 0; d0 < 4; ++d0) qr[d0] = *reinterpret_cast<const bf16x8*>(Qb + (long)(tq0 + r32) * PITCH + d0 * 16 + hi * 8);
  float m = -1e30f, l = 0.f; f32x16 o[2]; o[0] = f32x16{}; o[1] = f32x16{};
  dil_pattern<1, 5, 1>(Kb, Vb, S, tq0, 0, qr, m, l, o, vl, wsf, lane, r32, hi);
  l = swap_sum(l);
  if (hi == 0) {
    const float ma = ML[(32 * j + r32) * 2], la = ML[(32 * j + r32) * 2 + 1];
    const float mm = fmaxf(ma, m), wa = la * __builtin_amdgcn_exp2f(ma - mm), wb = __builtin_amdgcn_exp2f(m - mm);
    const float rden = 1.f / (wa + l * wb);
    wsf[r32] = wa * rden; wsf[32 + r32] = wb * rden; }
  bf16* Yb = Y + rowbase * YP + h * 64;
#pragma unroll
  for (int rr = 0; rr < 16; ++rr) { const int q = crow(rr, hi); const float fa = wsf[q], fb = wsf[32 + q]; const long tok = tq0 + q;
#pragma unroll
    for (int d0 = 0; d0 < 2; ++d0) { const float g = bf2f(Gb[tok * PITCH + d0 * 32 + r32]); const float oa = bf2f(OA[(32 * j + q) * 64 + d0 * 32 + r32]);
      Yb[tok * YP + d0 * 32 + r32] = f2bf((oa * fa + o[d0][rr] * fb) * silu(g)); } }
}
}
typedef unsigned short bf16;
typedef float f32x4g __attribute__((ext_vector_type(4)));
typedef unsigned v4u __attribute__((ext_vector_type(4)));
constexpr int NTOK = 65536, DMODEL = 1024, DPROJ = 4096, NBATCH = 20, NPROMPT_ROWS = 32768;
constexpr size_t MiB = 1u << 20;
constexpr size_t WS_PROJ = 0, WS_Y = 0, WS_SSQ = 128 * MiB, WS_GATE = 132 * MiB, WS_NEED = 512 * MiB;
constexpr size_t DO_H = 0, DO_WIN = 128 * MiB, DO_WOUT = 136 * MiB, DO_MOD = 138 * MiB, DO_ROPE = 139 * MiB, DO_MISC = 140 * MiB;
constexpr int LDS_BYTES = 147456;
struct Params { const float* in[15]; float* out; unsigned char* ws; int mask; int pad; };

__device__ __forceinline__ unsigned f2bf_u(float f) { unsigned u = __builtin_bit_cast(unsigned, f); return (u + 0x7fffu + ((u >> 16) & 1u)) >> 16; }
__device__ __forceinline__ unsigned pk2(float lo, float hi) { return f2bf_u(lo) | (f2bf_u(hi) << 16); }
__device__ __forceinline__ float wave_sum(float v) {
#pragma unroll
    for (int o = 1; o < 64; o <<= 1) v += __shfl_xor(v, o);
    return v;
}
__device__ __forceinline__ void transpose_item(const float* W, int K, int N, bf16* WT, LAS float* scr, int item, int lane) {
    const int nblk = N / 32, kb = item / nblk, nb = item % nblk, k0 = 64 * kb, n0 = 32 * nb;
#pragma unroll 8
    for (int i = 0; i < 32; ++i) { const int kk = 2 * i + (lane >> 5); scr[kk * 33 + (lane & 31)] = W[(size_t)(k0 + kk) * N + n0 + (lane & 31)]; }
    asm volatile("s_waitcnt lgkmcnt(0)" ::: "memory");
    const int c = lane & 7;
#pragma unroll
    for (int j = 0; j < 4; ++j) { const int n = (lane >> 3) + 8 * j; const LAS float* s = scr + (8 * c) * 33 + n;
        v4u o; o.x = pk2(s[0 * 33], s[1 * 33]); o.y = pk2(s[2 * 33], s[3 * 33]); o.z = pk2(s[4 * 33], s[5 * 33]); o.w = pk2(s[6 * 33], s[7 * 33]);
        *(v4u*)(WT + (size_t)(n0 + n) * K + k0 + 8 * c) = o; }
    asm volatile("s_waitcnt lgkmcnt(0)" ::: "memory");
}
__device__ __forceinline__ const float* xrow_ptr(const Params& p, int row) { return row < NPROMPT_ROWS ? p.in[0] + (size_t)row * DMODEL : p.in[1] + (size_t)(row - NPROMPT_ROWS) * DMODEL; }
__device__ __forceinline__ int row_batch(int row) { return row < NPROMPT_ROWS ? (row >> 13) : 4 + ((row - NPROMPT_ROWS) >> 11); }

__global__ void __launch_bounds__(512, 2) mega_fwd(Params p) {
    extern __shared__ __attribute__((aligned(16))) unsigned char lds_raw[];
    LAS unsigned char* lds = (LAS unsigned char*)lds_raw;
    cg::grid_group grid = cg::this_grid();
    const int tid = threadIdx.x, lane = tid & 63, wave = __builtin_amdgcn_readfirstlane(tid >> 6);
    const int G = gridDim.x, bx = blockIdx.x;
    const int vcu = (G % 8 == 0) ? (bx % 8) * (G / 8) + bx / 8 : bx;
    unsigned char* dob = (unsigned char*)p.out;
    bf16* H = (bf16*)(dob + DO_H); bf16* WIN = (bf16*)(dob + DO_WIN); bf16* WOUT = (bf16*)(dob + DO_WOUT);
    float* MOD = (float*)(dob + DO_MOD); float* ROPE = (float*)(dob + DO_ROPE); float* MISC = (float*)(dob + DO_MISC);
    bf16* PROJ = (bf16*)(p.ws + WS_PROJ); bf16* YB = (bf16*)(p.ws + WS_Y); float* SSQ = (float*)(p.ws + WS_SSQ); float* GATE = (float*)(p.ws + WS_GATE);
    const int gw = vcu * 8 + wave, NGW = G * 8;

    if (p.mask & 1) {
        LAS float* scr = (LAS float*)(lds + wave * 16384);
        constexpr int I_IN = (DMODEL / 64) * (DPROJ / 32), I_OUT = (DMODEL / 64) * (DMODEL / 32);
        for (int it = gw; it < I_IN + I_OUT; it += NGW) {
            if (it < I_IN) transpose_item(p.in[4], DMODEL, DPROJ, WIN, scr, it, lane);
            else transpose_item(p.in[5], DMODEL, DMODEL, WOUT, scr, it - I_IN, lane);
        }
        for (int e = bx * 512 + tid; e < 8192 * 8; e += G * 512) {
            const int pos = e >> 3, i = e & 7;
            const float inv = exp2f(-(float)i * (1.0f / 8.0f) * 18.931568569324174f);
            const float ang = (float)pos * inv;
            const double ad = (double)ang; const double n = rint(ad * 0.15915494309189535); const float red = (float)(ad - n * 6.283185307179586);
            ROPE[2 * e] = cosf(red); ROPE[2 * e + 1] = sinf(red);
        }
        __syncthreads();
        if (bx < 192) {
            LAS float* sc = (LAS float*)lds;
            LAS float* red = (LAS float*)(lds + 81920);
            for (int i = tid; i < NBATCH * DMODEL; i += 512) { const int b = i >> 10, k = i & 1023; const float cv = b < 4 ? p.in[2][b * DMODEL + k] : p.in[3][(b - 4) * DMODEL + k]; sc[i] = cv / (1.f + __expf(-cv)); }
            __syncthreads();
            const int col = tid & 15, ks = tid >> 4, j = bx * 16 + col;
            float acc[NBATCH];
#pragma unroll
            for (int b = 0; b < NBATCH; ++b) acc[b] = 0.f;
            for (int k = ks; k < DMODEL; k += 32) { const float w = p.in[8][(size_t)k * 3072 + j];
#pragma unroll
                for (int b = 0; b < NBATCH; ++b) acc[b] += sc[b * DMODEL + k] * w; }
#pragma unroll
            for (int b = 0; b < NBATCH; ++b) red[(ks * NBATCH + b) * 16 + col] = acc[b];
            __syncthreads();
            if (tid < NBATCH * 16) { const int b = tid >> 4, cc = tid & 15; float s = 0.f;
                for (int k2 = 0; k2 < 32; ++k2) s += red[(k2 * NBATCH + b) * 16 + cc];
                MOD[b * 3072 + bx * 16 + cc] = s + p.in[9][bx * 16 + cc]; }
        }
        if (bx == G - 1 && wave == 0) {
            const float a = wave_sum(p.in[10][lane] * p.in[11][lane]), b2 = wave_sum(p.in[12][lane] * p.in[13][lane]);
            if (lane == 0) MISC[0] = expf(a) - expf(b2) + 0.2f;
        }
    }
    asm volatile("s_waitcnt vmcnt(0)\n\ts_nop 0" ::: "memory");
    grid.sync();
    if (p.mask & 2) { const int lane = att::fresh_tid() & 63;
    for (int row = gw; row < NTOK; row += NGW) {
        const f32x4g* xr = (const f32x4g*)xrow_ptr(p, row) + lane;
        const int b = row_batch(row);
        f32x4g v[4]; float s = 0.f;
#pragma unroll
        for (int j = 0; j < 4; ++j) { v[j] = xr[64 * j]; s += (v[j].x * v[j].x + v[j].y * v[j].y) + (v[j].z * v[j].z + v[j].w * v[j].w); }
        const float rstd = rsqrtf(wave_sum(s) * (1.f / DMODEL) + 1e-6f);
        unsigned long long* o8 = (unsigned long long*)(H + (size_t)row * DMODEL) + lane;
#pragma unroll
        for (int j = 0; j < 4; ++j) {
            const f32x4g g = ((const f32x4g*)p.in[6])[lane + 64 * j], sh = ((const f32x4g*)(MOD + b * 3072))[lane + 64 * j], sl = ((const f32x4g*)(MOD + b * 3072 + 1024))[lane + 64 * j];
            const f32x4g hv = v[j] * rstd * g * (sl + 1.f) + sh;
            o8[64 * j] = (unsigned long long)pk2(hv.x, hv.y) | ((unsigned long long)pk2(hv.z, hv.w) << 32);
        }
    } }
    asm volatile("s_waitcnt vmcnt(0)\n\ts_nop 0" ::: "memory");
    grid.sync();
#ifndef NO_P1
    if (p.mask & 4) {
        pg8::Gemm g{H, WIN, NTOK, DPROJ, DMODEL}; pg8::StaticOrder S; S.init(NTOK, DPROJ, G, bx);
        pg8::EpiProj E{PROJ, DPROJ, ROPE};
        pg8::gemm_phase<pg8::EpiProj, pg8::StaticOrder, true, true>(lds, g, S, E);
    }
#endif
    asm volatile("s_waitcnt vmcnt(0)\n\ts_nop 0" ::: "memory");
    grid.sync();
    {
        bf16* YM = H;
        const float lam = MISC[0];
#ifndef NO_DIFF
        if (p.mask & 8)
        for (int u = vcu; u < 2048; u += G) {
            int bh, qt, S; long rowbase;
            if (u < 1024) { bh = (u & 255) >> 4; qt = (u & 15) * 4 + (u >> 8); S = 8192; rowbase = (long)(bh >> 2) * 8192; }
            else { const int u2 = u - 1024; bh = (u2 & 255) >> 2; qt = (u2 & 3) * 4 + (u2 >> 8); S = 2048; rowbase = NPROMPT_ROWS + (long)(bh >> 2) * 2048; }
            att::diff_unit(PROJ, YM, rowbase, S, bh & 3, qt, (LAS char*)lds, lam, p.in[14]);
        }
#endif
#ifndef NO_DIL
        LAS char* vl = (LAS char*)lds + wave * 8448; LAS float* wsf = (LAS float*)(lds + wave * 8448 + 8192);
        LAS att::bf16* OA = (LAS att::bf16*)(lds + 67584); LAS float* ML = (LAS float*)(lds + 67584 + 65536);
        if (p.mask & 16)
        for (int u = vcu; u < 1024; u += G) {
            int b, h, c, S; long rowbase;
            if (u < 512) { const int id = (u & 255) * 2 + (u >> 8); c = id & 15; h = (id >> 4) & 7; b = id >> 7; S = 8192; rowbase = (long)b * 8192; }
            else { const int u2 = u - 512; const int id = (u2 & 255) * 2 + (u2 >> 8); c = id & 3; h = (id >> 2) & 7; b = id >> 5; S = 2048; rowbase = NPROMPT_ROWS + (long)b * 2048; }
            att::dil_item_a(PROJ, rowbase, S, h, c, wave, vl, wsf, OA, ML);
            att::dil_item_a(PROJ, rowbase, S, h, c, wave + 8, vl, wsf, OA, ML);
            __syncthreads();
            att::dil_item_b(PROJ, YM, rowbase, S, h, c, wave, vl, wsf, OA, ML);
            att::dil_item_b(PROJ, YM, rowbase, S, h, c, wave + 8, vl, wsf, OA, ML);
            __syncthreads();
        }
#endif
    }
    asm volatile("s_waitcnt vmcnt(0)\n\ts_nop 0" ::: "memory");
    grid.sync();
    if (p.mask & 32) {
        for (int i = bx * 512 + tid; i < NBATCH * DMODEL; i += G * 512) GATE[i] = MOD[(i >> 10) * 3072 + 2048 + (i & 1023)];
#ifndef NO_P3
        pg8::Gemm g{H, WOUT, NTOK, DMODEL, DMODEL}; pg8::StaticOrder S; S.init(NTOK, DMODEL, G, bx);
        pg8::EpiY E{YB, DMODEL, SSQ};
        pg8::gemm_phase<pg8::EpiY, pg8::StaticOrder, true, true>(lds, g, S, E);
#endif
    }
    asm volatile("s_waitcnt vmcnt(0)\n\ts_nop 0" ::: "memory");
    grid.sync();
    if (p.mask & 64) { const int lane = att::fresh_tid() & 63;
    for (int row = gw; row < NTOK; row += NGW) {
        const f32x4g* xr = (const f32x4g*)xrow_ptr(p, row) + lane;
        const int b = row_batch(row);
        const float ss = wave_sum(lane < 16 ? SSQ[(size_t)row * 16 + lane] : 0.f);
        const float rstd = rsqrtf(ss * (1.f / DMODEL) + 1e-6f);
        const unsigned long long* y8 = (const unsigned long long*)(YB + (size_t)row * DMODEL) + lane;
        f32x4g* orow = (f32x4g*)(p.out + (size_t)row * DMODEL) + lane;
#pragma unroll
        for (int j = 0; j < 4; ++j) {
            const unsigned long long yv = y8[64 * j];
            f32x4g y; y.x = __uint_as_float(((unsigned)yv) << 16); y.y = __uint_as_float(((unsigned)yv) & 0xffff0000u);
            y.z = __uint_as_float(((unsigned)(yv >> 32)) << 16); y.w = __uint_as_float(((unsigned)(yv >> 32)) & 0xffff0000u);
            const f32x4g gt = ((const f32x4g*)(GATE + b * DMODEL))[lane + 64 * j], gp = ((const f32x4g*)p.in[7])[lane + 64 * j];
            orow[64 * j] = xr[64 * j] + gt * (y * rstd) * gp;
        }
    } }
}

extern "C" void kernel_launch(void* const* d_in, const int* in_sizes, int n_in, void* d_out, int out_size, void* d_ws, size_t ws_size, hipStream_t stream) {
    static int grid = 0;
    if (grid == 0) {
        if (n_in != 15 || ws_size < WS_NEED || out_size != NTOK * DMODEL) { fprintf(stderr, "kernel_launch: unexpected shapes (n_in %d, ws %zu, out %d)\n", n_in, ws_size, out_size); grid = -1; return; }
        int dev = 0, cus = 0, per_cu = 0;
        hipGetDevice(&dev); hipDeviceGetAttribute(&cus, hipDeviceAttributeMultiprocessorCount, dev);
        hipFuncSetAttribute((const void*)mega_fwd, hipFuncAttributeMaxDynamicSharedMemorySize, LDS_BYTES);
        hipOccupancyMaxActiveBlocksPerMultiprocessor(&per_cu, (const void*)mega_fwd, 512, LDS_BYTES);
        (void)hipGetLastError();
        if (per_cu < 1) per_cu = 1;
        grid = cus;
    }
    if (grid < 0) return;
    Params p{};
    for (int i = 0; i < 15; ++i) p.in[i] = (const float*)d_in[i];
    p.out = (float*)d_out; p.ws = (unsigned char*)d_ws; p.mask = 127;
#ifdef PROBE_MASK
    { Params p2 = p; p2.mask = PROBE_MASK; void* args2[] = {&p2}; (void)hipLaunchCooperativeKernel((const void*)mega_fwd, dim3(grid), dim3(512), args2, LDS_BYTES, stream); }
#endif
    void* args[] = {&p};
    hipError_t e = hipLaunchCooperativeKernel((const void*)mega_fwd, dim3(grid), dim3(512), args, LDS_BYTES, stream);
    if (e != hipSuccess) fprintf(stderr, "cooperative launch failed: %s (grid %d)\n", hipGetErrorString(e), grid);
}
```

```cpp
#include <hip/hip_runtime.h>
#include <hip/hip_cooperative_groups.h>
#include <cstdio>
#include <cstdint>
namespace cg = cooperative_groups;
#define PAD_STR2(x) #x
#define PAD_STR(x) PAD_STR2(x)
#define PAD_P0A 0
#define PAD_P0B 0
#define PAD_P1 0
#define PAD_DIFF 0
#define PAD_DIL 0
#define PAD_P3 0
#define PAD_P4 0
constexpr float QK_C2 = 0.125f * 1.4426950408889634f;
namespace pg8 {
#define PG8_LAS __attribute__((address_space(3)))
typedef unsigned short bf16_t;
typedef short bf16x8 __attribute__((ext_vector_type(8)));
typedef float f32x4 __attribute__((ext_vector_type(4)));
typedef unsigned u32x4 __attribute__((ext_vector_type(4)));
constexpr int BM = 256, BK = 64, HALF = 128, HTB = HALF * BK * 2  , STAGE_BYTES = 8 * HTB, NXCD = 8, WGM = 8;

__host__ __device__ __forceinline__ int lds_byte(int r, int c) { const int st = (r >> 4) * 2 + (c >> 5), rr = r & 15, cc = c & 31, ob = rr * 64 + cc * 2; return st * 1024 + (ob ^ (((ob >> 9) & 1) << 5)); }
__host__ __device__ __forceinline__ void stage_rc(int b, int& R, int& C) { const int st = b / 1024, sb = b % 1024, swz = sb ^ (((sb >> 9) & 1) << 5); R = (st >> 1) * 16 + swz / 64; C = (st & 1) * 32 + (swz % 64) / 2; }
__host__ __device__ __forceinline__ int perm32(int rho) { const int n = rho >> 4, i = rho & 15; return 8 * (i >> 2) + 4 * n + (i & 3); }

struct Unit { int pm, pn; };
struct Gemm { const bf16_t* A; const bf16_t* Bt; int M, N, K; };

struct StaticOrder {
    int nM, nN, nwg, G, c;
    __host__ __device__ void init(int M, int N, int G_, int c_) { nM = M / BM; nN = N / BM; nwg = nM * nN; G = G_; c = c_; }
    __host__ __device__ bool next(int i, Unit& u) const {
        const long L = (long)i * G + c; if (L >= nwg) return false;
        int wgid = (int)L; { const int q = nwg / NXCD, r = nwg % NXCD, xcd = wgid % NXCD, off = wgid / NXCD; wgid = (xcd < r ? xcd * (q + 1) : r * (q + 1) + (xcd - r) * q) + off; }
        const int nig = WGM * nN, gid = wgid / nig, fm = gid * WGM, gsz = (nM - fm) < WGM ? (nM - fm) : WGM;
        u.pm = fm + ((wgid % nig) % gsz); u.pn = (wgid % nig) / gsz; return true;
    }
    __device__ __forceinline__ void a_ready(const Unit&) const {}
    __device__ __forceinline__ void done(const Unit&) const {}
};

__device__ __forceinline__ unsigned cvt_pk_bf16(float lo, float hi) { unsigned r; asm volatile("v_cvt_pk_bf16_f32 %0, %1, %2" : "=v"(r) : "v"(lo), "v"(hi)); return r; }
struct EpiProj {
    static constexpr bool PERM = true, AFTER_DRAIN = false;
    bf16_t* O; int ldc; const float* rope;
    __device__ __forceinline__ void operator()(const f32x4 (&acc)[2][2][4][2], const Unit& u, int wr, int wc, int fr, int fq) const {
        const int row0 = u.pm * BM + wr * 64 + fr;
        const bool tile_rope = (u.pn & 4) == 0;
        const bool lane_rope = tile_rope && ((wc & 1) == 0) && (fq < 2);
        const float sc = ((u.pn & 6) == 0) ? QK_C2 : 1.f;
        const float sgn = (fq == 0) ? -1.f : 1.f;
        const int col0 = wc * 32 + 8 * fq;
        bf16_t* const Op = O + (size_t)u.pn * ((size_t)65536 * 256);
#pragma unroll
        for (int ai = 0; ai < 2; ++ai)
#pragma unroll
            for (int m = 0; m < 4; ++m) {
                const int row = row0 + ai * HALF + m * 16;
                const int pos = row < 32768 ? (row & 8191) : (row & 2047);
                f32x4 cs[4];
                if (tile_rope) {
#pragma unroll
                    for (int q = 0; q < 4; ++q) cs[q] = *(const f32x4*)(rope + (size_t)pos * 16 + q * 4);
                }
                bf16_t* rowp = Op + (size_t)row * ldc + col0;
#pragma unroll
                for (int bj = 0; bj < 2; ++bj) {
                    f32x4 v0 = acc[ai][bj][m][0], v1 = acc[ai][bj][m][1];
                    if (tile_rope) {
                        f32x4 p0, p1;
#pragma unroll
                        for (int j = 0; j < 4; ++j) { p0[j] = __shfl_xor(v0[j], 16); p1[j] = __shfl_xor(v1[j], 16); }
                        if (lane_rope) {
                            v0[0] = v0[0] * cs[0][0] + sgn * p0[0] * cs[0][1]; v0[1] = v0[1] * cs[0][2] + sgn * p0[1] * cs[0][3];
                            v0[2] = v0[2] * cs[1][0] + sgn * p0[2] * cs[1][1]; v0[3] = v0[3] * cs[1][2] + sgn * p0[3] * cs[1][3];
                            v1[0] = v1[0] * cs[2][0] + sgn * p1[0] * cs[2][1]; v1[1] = v1[1] * cs[2][2] + sgn * p1[1] * cs[2][3];
                            v1[2] = v1[2] * cs[3][0] + sgn * p1[2] * cs[3][1]; v1[3] = v1[3] * cs[3][2] + sgn * p1[3] * cs[3][3];
                        }
                    }
                    v0 = v0 * sc; v1 = v1 * sc;
                    u32x4 w; w.x = cvt_pk_bf16(v0[0], v0[1]); w.y = cvt_pk_bf16(v0[2], v0[3]); w.z = cvt_pk_bf16(v1[0], v1[1]); w.w = cvt_pk_bf16(v1[2], v1[3]);
                    __builtin_nontemporal_store(w, (u32x4*)(rowp + bj * HALF));
                }
            }
    }
};
struct EpiY {
    static constexpr bool PERM = true, AFTER_DRAIN = false;
    bf16_t* O; int ldc; float* ssq;
    __device__ __forceinline__ void operator()(const f32x4 (&acc)[2][2][4][2], const Unit& u, int wr, int wc, int fr, int fq) const {
        const int row0 = u.pm * BM + wr * 64 + fr;
        const int col0 = u.pn * BM + wc * 32 + 8 * fq;
#pragma unroll
        for (int ai = 0; ai < 2; ++ai)
#pragma unroll
            for (int m = 0; m < 4; ++m) {
                const int row = row0 + ai * HALF + m * 16;
                bf16_t* rowp = O + (size_t)row * ldc + col0;
                float s = 0.f;
#pragma unroll
                for (int bj = 0; bj < 2; ++bj) {
                    const f32x4 v0 = acc[ai][bj][m][0], v1 = acc[ai][bj][m][1];
                    s += (v0[0] * v0[0] + v0[1] * v0[1]) + (v0[2] * v0[2] + v0[3] * v0[3]) + (v1[0] * v1[0] + v1[1] * v1[1]) + (v1[2] * v1[2] + v1[3] * v1[3]);
                    u32x4 w; w.x = cvt_pk_bf16(v0[0], v0[1]); w.y = cvt_pk_bf16(v0[2], v0[3]); w.z = cvt_pk_bf16(v1[0], v1[1]); w.w = cvt_pk_bf16(v1[2], v1[3]);
                    *(u32x4*)(rowp + bj * HALF) = w;
                }
                s += __shfl_xor(s, 16); s += __shfl_xor(s, 32);
                if (fq == 0) ssq[(size_t)row * 16 + u.pn * 4 + wc] = s;
            }
    }
};
template <class Epi, class Sched, bool ALIGN_EPI = false, bool SP2 = false>
__device__ __forceinline__ void gemm_phase(PG8_LAS unsigned char* lds, const Gemm g, const Sched& S, const Epi& E) {
    const int tid = threadIdx.x, wid = __builtin_amdgcn_readfirstlane(tid >> 6), lane = tid & 63, wr = wid >> 2, wc = wid & 3, fr = lane & 15, fq = lane >> 4;
    const int K = g.K, nt = K / BK;
    unsigned voffA[2], voffB[2];
#pragma unroll
    for (int i = 0; i < 2; ++i) { int R, C; stage_rc(tid * 16 + i * 8192, R, C); const int Rb = Epi::PERM ? ((R & ~31) + perm32(R & 31)) : R;
        voffA[i] = (unsigned)(R * K + C) * 2u; voffB[i] = (unsigned)(Rb * K + C) * 2u; }
    const size_t kstep = (size_t)(BK * 2);
    const size_t hstep = (size_t)HALF * K * 2;
    const size_t tstep = 2 * hstep;
    const unsigned ldsw = (unsigned)wid * 1024u;
    const int aoff = lds_byte(wr * 64 + fr, fq * 8), boff = lds_byte(wc * 32 + fr, fq * 8);
#define PG8_SA(b, h) (((b) * 2 + (h)) * HTB)
#define PG8_SB(b, h) ((4 + (b) * 2 + (h)) * HTB)
#define PG8_STAGE(bufoff, gbase, voff) do { _Pragma("unroll") for (int _i = 0; _i < 2; ++_i) \
        __builtin_amdgcn_global_load_lds((const unsigned*)((const char*)(gbase) + (voff)[_i]), (PG8_LAS unsigned*)(lds + (bufoff) + ldsw + _i * 8192), 16, 0, 0); } while (0)
#define PG8_LDA(dst, b, h) do { _Pragma("unroll") for (int m = 0; m < 4; ++m) _Pragma("unroll") for (int k = 0; k < 2; ++k) dst[m][k] = *(const PG8_LAS bf16x8*)(lds + PG8_SA(b, h) + aoff + m * 2048 + k * 1024); } while (0)
#define PG8_LDB(dst, b, h) do { _Pragma("unroll") for (int n = 0; n < 2; ++n) _Pragma("unroll") for (int k = 0; k < 2; ++k) dst[n][k] = *(const PG8_LAS bf16x8*)(lds + PG8_SB(b, h) + boff + n * 2048 + k * 1024); } while (0)
#define PG8_MMA(ai, bj, At, Bt) do { __builtin_amdgcn_s_setprio(1); _Pragma("unroll") for (int m = 0; m < 4; ++m) _Pragma("unroll") for (int n = 0; n < 2; ++n) _Pragma("unroll") for (int k = 0; k < 2; ++k) \
        acc[ai][bj][m][n] = __builtin_amdgcn_mfma_f32_16x16x32_bf16(Bt[n][k], At[m][k], acc[ai][bj][m][n], 0, 0, 0); __builtin_amdgcn_s_setprio(0); } while (0)
#define PG8_WAIT_V(n) asm volatile("s_waitcnt vmcnt(" #n ")" ::: "memory")
#define PG8_WAIT_L(n) asm volatile("s_waitcnt lgkmcnt(" #n ")" ::: "memory")
#define PG8_BAR __builtin_amdgcn_s_barrier()
#define PG8_SCHED __builtin_amdgcn_sched_barrier(0)
    Unit cur, nxt; int ui = 0;
    if (!S.next(0, cur)) return;
    f32x4 acc[2][2][4][2];
#pragma unroll
    for (int a = 0; a < 2; ++a)
#pragma unroll
        for (int b = 0; b < 2; ++b)
#pragma unroll
            for (int m = 0; m < 4; ++m)
#pragma unroll
                for (int n = 0; n < 2; ++n) acc[a][b][m][n] = (f32x4){0.f, 0.f, 0.f, 0.f};
    bf16x8 At[4][2], B0[2][2], B1[2][2];
    const char* cA = (const char*)g.A + (size_t)cur.pm * tstep; const char* cB = (const char*)g.Bt + (size_t)cur.pn * tstep;
    S.a_ready(cur);
    if constexpr (SP2) {
        PG8_STAGE(PG8_SB(0, 0), cB, voffB); PG8_STAGE(PG8_SB(0, 1), cB + hstep, voffB); PG8_STAGE(PG8_SA(0, 0), cA, voffA); PG8_STAGE(PG8_SA(0, 1), cA + hstep, voffA);
        if (wr == 1) PG8_BAR;
        PG8_WAIT_V(2); PG8_BAR;
        PG8_STAGE(PG8_SB(1, 0), cB + kstep, voffB); PG8_STAGE(PG8_SA(1, 0), cA + kstep, voffA); PG8_STAGE(PG8_SB(1, 1), cB + hstep + kstep, voffB);
        PG8_WAIT_V(6); PG8_BAR;
    } else {
        PG8_STAGE(PG8_SB(0, 0), cB, voffB); PG8_STAGE(PG8_SA(0, 0), cA, voffA); PG8_STAGE(PG8_SB(0, 1), cB + hstep, voffB); PG8_STAGE(PG8_SA(0, 1), cA + hstep, voffA);
        if (wr == 1) PG8_BAR;
        PG8_WAIT_V(4); PG8_BAR;
        PG8_STAGE(PG8_SB(1, 0), cB + kstep, voffB); PG8_STAGE(PG8_SA(1, 0), cA + kstep, voffA); PG8_STAGE(PG8_SB(1, 1), cB + hstep + kstep, voffB);
        PG8_WAIT_V(6); PG8_BAR;
    }
    for (;;) {
        const bool has_next = S.next(ui + 1, nxt);
        const char* nA = has_next ? (const char*)g.A + (size_t)nxt.pm * tstep : cA; const char* nB = has_next ? (const char*)g.Bt + (size_t)nxt.pn * tstep : cB;
        for (int t = 0; t < nt; t += 2) {
            const bool last = (t == nt - 2);
            const char* a1 = cA + (size_t)(t + 1) * kstep;
            const char* a2 = last ? nA : cA + (size_t)(t + 2) * kstep; const char* b2 = last ? nB : cB + (size_t)(t + 2) * kstep;
            const char* a3 = a2 + kstep; const char* b3 = b2 + kstep;
            if (last && has_next) S.a_ready(nxt);
            if constexpr (SP2) {
            PG8_LDB(B0, 0, 0); PG8_LDB(B1, 0, 1); PG8_SCHED; PG8_LDA(At, 0, 0); PG8_STAGE(PG8_SA(1, 1), a1 + hstep, voffA);
            PG8_WAIT_V(8); PG8_WAIT_L(0); PG8_BAR; PG8_MMA(0, 0, At, B0); PG8_MMA(0, 1, At, B1); PG8_BAR; PG8_SCHED;
            PG8_LDA(At, 0, 1); PG8_STAGE(PG8_SB(0, 0), b2, voffB); PG8_STAGE(PG8_SB(0, 1), b2 + hstep, voffB); PG8_STAGE(PG8_SA(0, 0), a2, voffA);
            PG8_WAIT_V(8); PG8_WAIT_L(0); PG8_BAR; PG8_MMA(1, 0, At, B0); PG8_MMA(1, 1, At, B1); PG8_BAR; PG8_SCHED;
            PG8_LDB(B0, 1, 0); PG8_LDB(B1, 1, 1); PG8_SCHED; PG8_LDA(At, 1, 0); PG8_STAGE(PG8_SA(0, 1), a2 + hstep, voffA);
            PG8_WAIT_V(8); PG8_WAIT_L(0); PG8_BAR; PG8_MMA(0, 0, At, B0); PG8_MMA(0, 1, At, B1); PG8_BAR; PG8_SCHED;
            PG8_LDA(At, 1, 1); PG8_STAGE(PG8_SB(1, 0), b3, voffB); PG8_STAGE(PG8_SB(1, 1), b3 + hstep, voffB); PG8_STAGE(PG8_SA(1, 0), a3, voffA);
            PG8_WAIT_V(8); PG8_WAIT_L(0); PG8_BAR; PG8_MMA(1, 0, At, B0); PG8_MMA(1, 1, At, B1); PG8_BAR; PG8_SCHED;
            } else {
            PG8_LDB(B0, 0, 0); PG8_SCHED; PG8_LDA(At, 0, 0); PG8_STAGE(PG8_SA(1, 1), a1 + hstep, voffA);
            PG8_WAIT_L(8); PG8_BAR; PG8_WAIT_L(0); PG8_MMA(0, 0, At, B0); PG8_BAR; PG8_SCHED;
            PG8_LDB(B1, 0, 1); PG8_STAGE(PG8_SB(0, 0), b2, voffB);
            PG8_BAR; PG8_WAIT_L(0); PG8_MMA(0, 1, At, B1); PG8_BAR;
            PG8_LDA(At, 0, 1); PG8_STAGE(PG8_SA(0, 0), a2, voffA);
            PG8_BAR; PG8_WAIT_L(0); PG8_MMA(1, 0, At, B0); PG8_BAR; PG8_SCHED;
            PG8_STAGE(PG8_SB(0, 1), b2 + hstep, voffB);
            PG8_WAIT_V(6); PG8_BAR; PG8_MMA(1, 1, At, B1); PG8_BAR;
            PG8_LDB(B0, 1, 0); PG8_SCHED; PG8_LDA(At, 1, 0); PG8_STAGE(PG8_SA(0, 1), a2 + hstep, voffA);
            PG8_WAIT_L(8); PG8_BAR; PG8_WAIT_L(0); PG8_MMA(0, 0, At, B0); PG8_BAR; PG8_SCHED;
            PG8_LDB(B1, 1, 1); PG8_STAGE(PG8_SB(1, 0), b3, voffB);
            PG8_BAR; PG8_WAIT_L(0); PG8_MMA(0, 1, At, B1); PG8_BAR;
            PG8_LDA(At, 1, 1); PG8_STAGE(PG8_SA(1, 0), a3, voffA);
            PG8_BAR; PG8_WAIT_L(0); PG8_MMA(1, 0, At, B0); PG8_BAR; PG8_SCHED;
            PG8_STAGE(PG8_SB(1, 1), b3 + hstep, voffB);
            PG8_WAIT_V(6); PG8_BAR; PG8_MMA(1, 1, At, B1); PG8_BAR;
            }
        }
        if constexpr (ALIGN_EPI) { if (wr == 0) PG8_BAR; }
        if constexpr (!Epi::AFTER_DRAIN) { E(acc, cur, wr, wc, fr, fq); S.done(cur); }
        if (!has_next) break;
#pragma unroll
        for (int a = 0; a < 2; ++a)
#pragma unroll
            for (int b = 0; b < 2; ++b)
#pragma unroll
                for (int m = 0; m < 4; ++m)
#pragma unroll
                    for (int n = 0; n < 2; ++n) acc[a][b][m][n] = (f32x4){0.f, 0.f, 0.f, 0.f};
        cur = nxt; cA = nA; cB = nB; ++ui;
        if constexpr (ALIGN_EPI) { if (wr == 1) PG8_BAR; }
    }
    PG8_WAIT_V(0);
    if constexpr (!ALIGN_EPI) { if (wr == 0) PG8_BAR; }
    PG8_BAR;
    if constexpr (Epi::AFTER_DRAIN) { E.fused(acc, cur, wr, wc, fr, fq, lds, wid, lane); S.done(cur); }
#undef PG8_SA
#undef PG8_SB
#undef PG8_STAGE
#undef PG8_LDA
#undef PG8_LDB
#undef PG8_MMA
#undef PG8_WAIT_V
#undef PG8_WAIT_L
#undef PG8_BAR
#undef PG8_SCHED
}
}
#define LAS __attribute__((address_space(3)))
namespace att {
typedef unsigned short bf16;
typedef short bf16x8 __attribute__((ext_vector_type(8)));
typedef short s16x4 __attribute__((ext_vector_type(4)));
typedef short v4i16_t __attribute__((ext_vector_type(4)));
typedef float f32x16 __attribute__((ext_vector_type(16)));
typedef unsigned u32x4 __attribute__((ext_vector_type(4)));
typedef float f32x2_t __attribute__((ext_vector_type(2)));
typedef __bf16 bf16x2_t __attribute__((ext_vector_type(2)));
typedef LAS const char* lds_cptr;
constexpr int PITCH = 256;
constexpr long PANEL = 65536L * 256;
__device__ __forceinline__ long pc(int col) { return (long)(col >> 8) * PANEL + (col & 255); }
constexpr int YP = 1024;
__device__ __forceinline__ int fresh_tid() { int t = threadIdx.x; asm volatile("" : "+v"(t)); return t; }
__device__ __forceinline__ int crow(int r, int hi) { return (r & 3) + 8 * (r >> 2) + 4 * hi; }
__device__ __forceinline__ void glds16(const void* gsrc, unsigned lds_dst) { unsigned keep;
  asm volatile("s_mov_b32 %0, m0\n\ts_mov_b32 m0, %2\n\ts_nop 0\n\tglobal_load_lds_dwordx4 %1, off\n\ts_mov_b32 m0, %0" : "=&s"(keep) : "v"(gsrc), "s"(lds_dst) : "memory"); }
__device__ __forceinline__ unsigned cvtpk_s(float lo, float hi) { f32x2_t v = {lo, hi}; bf16x2_t b = __builtin_convertvector(v, bf16x2_t); return __builtin_bit_cast(unsigned, b); }
__device__ __forceinline__ s16x4 vtr(lds_cptr p) { return __builtin_bit_cast(s16x4, __builtin_amdgcn_ds_read_tr16_b64_v4i16((LAS v4i16_t*)p)); }
__device__ __forceinline__ float bf2f(bf16 v) { return __uint_as_float(((unsigned)v) << 16); }
__device__ __forceinline__ bf16 f2bf(float f) { unsigned u = __float_as_uint(f); return (bf16)((u + 0x7fffu + ((u >> 16) & 1u)) >> 16); }
__device__ __forceinline__ float swap_max(float m) { auto rr = __builtin_amdgcn_permlane32_swap(__float_as_uint(m), __float_as_uint(m), false, false); return fmaxf(__uint_as_float(rr[0]), __uint_as_float(rr[1])); }
__device__ __forceinline__ float swap_sum(float m) { auto rr = __builtin_amdgcn_permlane32_swap(__float_as_uint(m), __float_as_uint(m), false, false); return __uint_as_float(rr[0]) + __uint_as_float(rr[1]); }
#define ATT_EXP2(A, B) asm("v_exp_f32_e32 %0, %0\n\tv_exp_f32_e32 %1, %1\n\ts_nop 0" : "+v"(A), "+v"(B))
#define ATT_EXP2_ADD2(A, B, SA, SB, PA, PB) asm("v_exp_f32_e32 %0, %0\n\tv_exp_f32_e32 %1, %1\n\tv_add_f32_e32 %2, %2, %4\n\tv_add_f32_e32 %3, %3, %5" : "+v"(A), "+v"(B), "+v"(SA), "+v"(SB) : "v"(PA), "v"(PB))
#define ATT_ADD2(SA, SB, PA, PB) asm("s_nop 0\n\tv_add_f32_e32 %0, %0, %2\n\tv_add_f32_e32 %1, %1, %3" : "+v"(SA), "+v"(SB) : "v"(PA), "v"(PB))
__device__ __forceinline__ float silu(float g) { return g / (1.f + __expf(-g)); }
#define ATT_WAIT_BAR(N) asm volatile("s_waitcnt vmcnt(" #N ") lgkmcnt(0)\n\ts_barrier" ::: "memory")
#define ATT_PACK(P, B) (u32x4){cvtpk_s(P[B], P[B + 1]), cvtpk_s(P[B + 2], P[B + 3]), cvtpk_s(P[B + 4], P[B + 5]), cvtpk_s(P[B + 6], P[B + 7])}
#define ATT_VFR(lo, hi) (bf16x8){lo[0], lo[1], lo[2], lo[3], hi[0], hi[1], hi[2], hi[3]}

constexpr int D_SLOT = 32768, D_NSLOT = 4, D_WSF = D_SLOT * D_NSLOT;
#define ATT_MX3(a, b, c) __builtin_fmaxf(__builtin_fmaxf((a), (b)), (c))
__device__ __forceinline__ void diff_unit(const bf16* __restrict__ P, bf16* __restrict__ Y, long rowbase, int S, int h, int qt, LAS char* shm, float lam, const float* __restrict__ g_sub) {
  const int tid = fresh_tid(), lane = tid & 63, r32 = lane & 31, hi = lane >> 5; const int wid = __builtin_amdgcn_readfirstlane(tid >> 6);
  const int map = wid >> 2, wq = wid & 3;
  const long qrow0 = rowbase + (long)qt * 128 + wq * 32;
  const bf16* Qw = P + pc(2048 + (2 * h + map) * 64) + qrow0 * PITCH;
  const bf16* Kb = P + pc(2560 + (2 * h + map) * 64) + rowbase * PITCH;
  const bf16* Vb = P + pc(3072 + h * 128) + rowbase * PITCH;
  const unsigned lds0 = (unsigned)(uintptr_t)shm;
  LAS float* wsf = (LAS float*)(shm + D_WSF) + wid * 64;
  const bf16* ksrc0 = Kb + (long)lane * PITCH + (2 * wq) * 8;
  const bf16* ksrc1 = ksrc0 + 8;
  const unsigned kdst0 = map * 8192 + (2 * wq) * 1024, kdst1 = kdst0 + 1024;
  const int vp0 = 2 * wid, vp1 = 2 * wid + 1;
  const bf16* vsrc0 = Vb + (long)(16 * (vp0 & 3) + (lane >> 2)) * PITCH + 32 * (vp0 >> 2) + 8 * (lane & 3);
  const bf16* vsrc1 = Vb + (long)(16 * (vp1 & 3) + (lane >> 2)) * PITCH + 32 * (vp1 >> 2) + 8 * (lane & 3);
  const unsigned vdst0 = 16384 + vp0 * 1024, vdst1 = 16384 + vp1 * 1024;
#define D_DMA(t, slot) do { const long toff_ = (long)(t) * 64 * PITCH; const unsigned sb_ = lds0 + (slot); \
    glds16(ksrc0 + toff_, (unsigned)__builtin_amdgcn_readfirstlane(sb_ + kdst0)); glds16(ksrc1 + toff_, (unsigned)__builtin_amdgcn_readfirstlane(sb_ + kdst1)); \
    glds16(vsrc0 + toff_, (unsigned)__builtin_amdgcn_readfirstlane(sb_ + vdst0)); glds16(vsrc1 + toff_, (unsigned)__builtin_amdgcn_readfirstlane(sb_ + vdst1)); } while (0)
  const int NT = S / 64;
  asm volatile("s_waitcnt vmcnt(0)" ::: "memory");
  bf16x8 qr[4];
#pragma unroll
  for (int d0 = 0; d0 < 4; ++d0) qr[d0] = *reinterpret_cast<const bf16x8*>(&Qw[(long)r32 * PITCH + d0 * 16 + hi * 8]);
  asm volatile("" ::: "memory");
  D_DMA(0, 0); D_DMA(1, D_SLOT); D_DMA(2, 2 * D_SLOT);
  float m = 0.f, l = 0.f;
  f32x16 o[4];
#pragma unroll
  for (int d0 = 0; d0 < 4; ++d0) o[d0] = f32x16{};
  f32x16 negm = f32x16{}; asm volatile("" : "+v"(negm));
  const lds_cptr shm3 = (lds_cptr)shm;
  const lds_cptr kp0 = shm3 + map * 8192 + hi * 1024 + r32 * 16;
  const lds_cptr vp = shm3 + 16384 + ((lane >> 4) & 1) * 32 + (lane & 3) * 8 + (4 * hi + ((lane & 15) >> 2)) * 64;
  bf16x8 pa0, pa1, pa2, pa3;
  pa0 = pa1 = pa2 = pa3 = bf16x8{};
#define D_KLD(SL_) do { const lds_cptr kp = kp0 + (SL_); \
    _Pragma("unroll") for (int d0 = 0; d0 < 4; ++d0) { kf[2 * d0] = *(const LAS bf16x8*)(kp + d0 * 2048); kf[2 * d0 + 1] = *(const LAS bf16x8*)(kp + d0 * 2048 + 512); } } while (0)
#define D_QKSM(T_, SL_) do { \
    f32x16 p0, p1; \
    p0 = __builtin_amdgcn_mfma_f32_32x32x16_bf16(kf[0], qr[0], negm, 0, 0, 0); p1 = __builtin_amdgcn_mfma_f32_32x32x16_bf16(kf[1], qr[0], negm, 0, 0, 0); \
    _Pragma("unroll") for (int d0 = 1; d0 < 4; ++d0) { \
      p0 = __builtin_amdgcn_mfma_f32_32x32x16_bf16(kf[2 * d0], qr[d0], p0, 0, 0, 0); p1 = __builtin_amdgcn_mfma_f32_32x32x16_bf16(kf[2 * d0 + 1], qr[d0], p1, 0, 0, 0); } \
    float ra = ATT_MX3(p0[0], p0[1], p1[0]), rb = ATT_MX3(p0[2], p0[3], p1[1]); ra = ATT_MX3(ra, p1[2], p1[3]); \
    _Pragma("unroll") for (int r = 4; r < 16; r += 4) { ra = ATT_MX3(ra, p0[r], p0[r + 1]); rb = ATT_MX3(rb, p0[r + 2], p0[r + 3]); ra = ATT_MX3(ra, p1[r], p1[r + 1]); rb = ATT_MX3(rb, p1[r + 2], p1[r + 3]); } \
    const float rm = swap_max(fmaxf(ra, rb)); \
    if ((T_) == 0 || __any(rm > 6.f)) { \
      const float dl = ((T_) == 0) ? rm : fmaxf(rm, 0.f); m += dl; \
      _Pragma("unroll") for (int r = 0; r < 16; ++r) { p0[r] -= dl; p1[r] -= dl; } \
      _Pragma("unroll") for (int r = 0; r < 16; ++r) negm[r] = -m; \
      asm volatile("" : "+v"(negm)); \
      const float f = __builtin_amdgcn_exp2f(-dl); l *= f; \
      if (hi == 0) wsf[r32] = f; \
      _Pragma("unroll") for (int r = 0; r < 16; ++r) { const float fr_ = wsf[crow(r, hi)]; \
        _Pragma("unroll") for (int d0 = 0; d0 < 4; ++d0) o[d0][r] *= fr_; } \
    } \
    float sacc = 0.f, sacd = 0.f; \
    ATT_EXP2(p0[0], p1[0]); \
    _Pragma("unroll") for (int r = 1; r < 16; ++r) ATT_EXP2_ADD2(p0[r], p1[r], sacc, sacd, p0[r - 1], p1[r - 1]); \
    ATT_ADD2(sacc, sacd, p0[15], p1[15]); \
    l += sacc + sacd; \
    pa0 = __builtin_bit_cast(bf16x8, ATT_PACK(p0, 0)); pa1 = __builtin_bit_cast(bf16x8, ATT_PACK(p0, 8)); \
    pa2 = __builtin_bit_cast(bf16x8, ATT_PACK(p1, 0)); pa3 = __builtin_bit_cast(bf16x8, ATT_PACK(p1, 8)); } while (0)
#define D_PV(SL_) do { const lds_cptr vq = vp + (SL_); \
    _Pragma("unroll") for (int d0 = 0; d0 < 4; ++d0) { s16x4 lo[4], hh[4]; \
      _Pragma("unroll") for (int ks = 0; ks < 4; ++ks) { lo[ks] = vtr(vq + d0 * 4096 + ks * 1024); hh[ks] = vtr(vq + d0 * 4096 + ks * 1024 + 512); } \
      o[d0] = __builtin_amdgcn_mfma_f32_32x32x16_bf16(pa0, ATT_VFR(lo[0], hh[0]), o[d0], 0, 0, 0); \
      o[d0] = __builtin_amdgcn_mfma_f32_32x32x16_bf16(pa1, ATT_VFR(lo[1], hh[1]), o[d0], 0, 0, 0); \
      o[d0] = __builtin_amdgcn_mfma_f32_32x32x16_bf16(pa2, ATT_VFR(lo[2], hh[2]), o[d0], 0, 0, 0); \
      o[d0] = __builtin_amdgcn_mfma_f32_32x32x16_bf16(pa3, ATT_VFR(lo[3], hh[3]), o[d0], 0, 0, 0); } } while (0)
  ATT_WAIT_BAR(8);
  bf16x8 kf[8];
  if (map == 1) asm volatile("s_barrier" ::: "memory");
  for (int t = 0; t < NT; ++t) {
    const int cur = (t & 3) * D_SLOT;
    D_KLD(cur);
    D_QKSM(t, cur);
    __builtin_amdgcn_sched_barrier(0);
    if (t + 2 < NT) { ATT_WAIT_BAR(4); } else { ATT_WAIT_BAR(0); }
    __builtin_amdgcn_sched_barrier(0);
    if (t + 3 < NT) D_DMA(t + 3, ((t + 3) & 3) * D_SLOT);
    D_PV(cur);
    __builtin_amdgcn_sched_barrier(0);
    asm volatile("s_waitcnt lgkmcnt(0)\n\ts_barrier" ::: "memory");
    __builtin_amdgcn_sched_barrier(0);
  }
  if (map == 0) asm volatile("s_barrier" ::: "memory");
#undef D_DMA
#undef D_KLD
#undef D_QKSM
#undef D_PV
  l = swap_sum(l);
  { const int te = fresh_tid(); const int lane = te & 63, r32 = lane & 31, hi = lane >> 5;
  LAS float* wsf = (LAS float*)(shm + D_WSF) + wid * 64;
  if (hi == 0) wsf[32 + r32] = (map == 1 ? lam : 1.f) / l;
  float inv[16];
#pragma unroll
  for (int r = 0; r < 16; ++r) inv[r] = wsf[32 + crow(r, hi)];
  ATT_WAIT_BAR(0);
  LAS float* X = (LAS float*)shm + wq * 4096;
  if (map == 1) {
#pragma unroll
    for (int d0 = 0; d0 < 4; ++d0)
#pragma unroll
      for (int r = 0; r < 16; ++r) X[(d0 * 16 + r) * 64 + lane] = o[d0][r] * inv[r];
  }
  ATT_WAIT_BAR(0);
  if (map == 0) {
    const bf16* Gw = P + pc(3584 + h * 128) + qrow0 * PITCH;
    bf16* Yw = Y + qrow0 * YP + 512 + h * 128;
    float gs[4];
#pragma unroll
    for (int d0 = 0; d0 < 4; ++d0) gs[d0] = g_sub[d0 * 32 + r32] * 0.8f;
#pragma unroll
    for (int r = 0; r < 16; ++r) {
      float v[4]; float ss = 0.f;
#pragma unroll
      for (int d0 = 0; d0 < 4; ++d0) { v[d0] = o[d0][r] * inv[r] - X[(d0 * 16 + r) * 64 + lane]; ss += v[d0] * v[d0]; }
      ss += __shfl_xor(ss, 1); ss += __shfl_xor(ss, 2); ss += __shfl_xor(ss, 4); ss += __shfl_xor(ss, 8); ss += __shfl_xor(ss, 16);
      const float rstd = rsqrtf(ss * (1.f / 128.f) + 1e-6f);
      const int q = crow(r, hi);
#pragma unroll
      for (int d0 = 0; d0 < 4; ++d0) { const float g = bf2f(Gw[(long)q * PITCH + d0 * 32 + r32]);
        Yw[(long)q * YP + d0 * 32 + r32] = f2bf(v[d0] * rstd * gs[d0] * silu(g)); }
    }
  }
  }
  ATT_WAIT_BAR(0);
}

template <int DIL, int NBLK, int QSTEP>
__device__ __forceinline__ void dil_pattern(const bf16* __restrict__ Kb, const bf16* __restrict__ Vb, int S, int i0, int resid, const bf16x8 (&qr)[4], float& m, float& l, f32x16 (&o)[2],
                                            LAS char* vl, LAS float* wsf, int lane, int r32, int hi, u32x4 (&kr)[4], u32x4 (&vr)[4]) {
  const int L = S / DIL;
  const int qidx = i0 + QSTEP * r32;
  const int lo_q = qidx - 64 < 0 ? 0 : qidx - 64, w_q = (qidx + 64 > L - 1 ? L - 1 : qidx + 64) - lo_q;
  const lds_cptr vq = (lds_cptr)vl + ((lane >> 4) & 1) * 32 + (lane & 3) * 8 + (4 * hi + ((lane & 15) >> 2)) * 64;
  const int lrow = lane >> 3, lch = lane & 7;
  LAS char* kw = vl + 4096 + lch * 512 + ((lrow ^ lch) * 16);
  LAS char* vw = vl + (lch >> 2) * 2048 + (lrow & 7) * 64 + (lch & 3) * 16;
  const lds_cptr kr_ = (lds_cptr)vl + 4096;
  int kb_lo = (64 - i0) >> 5; kb_lo = kb_lo < 0 ? 0 : kb_lo;
  int kb_hi = (L + 64 - i0 + 31) >> 5; kb_hi = kb_hi > NBLK ? NBLK : kb_hi;
#define DIL_LOAD(KB_) do { const int kbase_ = i0 - 64 + 32 * (KB_); \
    _Pragma("unroll") for (int i = 0; i < 4; ++i) { int kx_ = kbase_ + 8 * i + lrow; kx_ = kx_ < 0 ? 0 : (kx_ >= L ? L - 1 : kx_); \
      const long ro_ = (long)(resid + DIL * kx_) * PITCH + lch * 8; \
      kr[i] = *reinterpret_cast<const u32x4*>(Kb + ro_); vr[i] = *reinterpret_cast<const u32x4*>(Vb + ro_); } } while (0)
  for (int kb = kb_lo; kb < kb_hi; ++kb) {
    const int kbase = i0 - 64 + 32 * kb;
#pragma unroll
    for (int i = 0; i < 4; ++i) { *(LAS u32x4*)(kw + i * 128) = kr[i]; *(LAS u32x4*)(vw + (i >> 1) * 1024 + (i & 1) * 512) = vr[i]; }
    { const int kn = (kb + 1 < kb_hi) ? kb + 1 : kb; DIL_LOAD(kn); }
    f32x16 p0 = f32x16{};
#pragma unroll
    for (int d0 = 0; d0 < 4; ++d0) { const int ch = 2 * d0 + hi;
      const bf16x8 kfr = *(const LAS bf16x8*)(kr_ + ch * 512 + ((r32 ^ ch) * 16));
      p0 = __builtin_amdgcn_mfma_f32_32x32x16_bf16(kfr, qr[d0], p0, 0, 0, 0); }
    float rm = -1e30f;
    { const int a0 = lo_q - kbase;
      if (!__all(a0 <= 0 && a0 + w_q >= 31)) { const int a1 = a0 - 4 * hi;
#pragma unroll
        for (int rr = 0; rr < 16; ++rr) { const bool ok = (unsigned)(((rr & 3) + 8 * (rr >> 2)) - a1) <= (unsigned)w_q; p0[rr] = ok ? p0[rr] : -1e30f; } }
      const float r0 = ATT_MX3(p0[0], p0[1], p0[2]), r1 = ATT_MX3(p0[3], p0[4], p0[5]), r2 = ATT_MX3(p0[6], p0[7], p0[8]), r3 = ATT_MX3(p0[9], p0[10], p0[11]), r4 = ATT_MX3(p0[12], p0[13], p0[14]);
      rm = fmaxf(ATT_MX3(r0, r1, r2), ATT_MX3(r3, r4, p0[15])); }
    rm = swap_max(rm);
    if (__any(rm > m + 6.f)) {
      const float mn = fmaxf(m, rm); const float f = __builtin_amdgcn_exp2f(m - mn); m = mn; l *= f;
      if (hi == 0) wsf[r32] = f;
#pragma unroll
      for (int rr = 0; rr < 16; ++rr) { const float fr_ = wsf[crow(rr, hi)]; o[0][rr] *= fr_; o[1][rr] *= fr_; }
    }
#pragma unroll
    for (int rr = 0; rr < 16; ++rr) p0[rr] -= m;
    { float s0 = 0.f, s1 = 0.f;
      ATT_EXP2(p0[0], p0[1]);
#pragma unroll
      for (int rr = 2; rr < 16; rr += 2) ATT_EXP2_ADD2(p0[rr], p0[rr + 1], s0, s1, p0[rr - 2], p0[rr - 1]);
      ATT_ADD2(s0, s1, p0[14], p0[15]);
      l += s0 + s1; }
    const bf16x8 pa0 = __builtin_bit_cast(bf16x8, ATT_PACK(p0, 0)), pa1 = __builtin_bit_cast(bf16x8, ATT_PACK(p0, 8));
#pragma unroll
    for (int d0 = 0; d0 < 2; ++d0) {
      const s16x4 lo0 = vtr(vq + d0 * 2048), hi0 = vtr(vq + d0 * 2048 + 512), lo1 = vtr(vq + d0 * 2048 + 1024), hi1 = vtr(vq + d0 * 2048 + 1536);
      o[d0] = __builtin_amdgcn_mfma_f32_32x32x16_bf16(pa0, ATT_VFR(lo0, hi0), o[d0], 0, 0, 0);
      o[d0] = __builtin_amdgcn_mfma_f32_32x32x16_bf16(pa1, ATT_VFR(lo1, hi1), o[d0], 0, 0, 0);
    }
  }
#undef DIL_LOAD
}
template <int DIL>
__device__ __forceinline__ void dil_first(u32x4 (&kr)[4], u32x4 (&vr)[4], const bf16* __restrict__ Kb, const bf16* __restrict__ Vb, int S, int i0, int resid, int lane) {
  const int L = S / DIL, lrow = lane >> 3, lch = lane & 7;
  int kb_lo = (64 - i0) >> 5; kb_lo = kb_lo < 0 ? 0 : kb_lo;
  const int kbase = i0 - 64 + 32 * kb_lo;
#pragma unroll
  for (int i = 0; i < 4; ++i) { int kx = kbase + 8 * i + lrow; kx = kx < 0 ? 0 : (kx >= L ? L - 1 : kx);
    const long ro = (long)(resid + DIL * kx) * PITCH + lch * 8;
    kr[i] = *reinterpret_cast<const u32x4*>(Kb + ro); vr[i] = *reinterpret_cast<const u32x4*>(Vb + ro); }
}
__device__ __forceinline__ void dil_q(bf16x8 (&qr)[4], const bf16* __restrict__ Qb, long tok, int hi) {
#pragma unroll
  for (int d0 = 0; d0 < 4; ++d0) qr[d0] = *reinterpret_cast<const bf16x8*>(Qb + tok * PITCH + d0 * 16 + hi * 8);
}
__device__ __forceinline__ void dil_item_a(const bf16* __restrict__ P, long rowbase, int S, int h, int c, int r, LAS char* vl, LAS float* wsf, LAS bf16* OA, LAS float* ML, const bf16x8 (&qr)[4], u32x4 (&kr)[4], u32x4 (&vr)[4]) {
  const int lane = fresh_tid() & 63, r32 = lane & 31, hi = lane >> 5;
  const bf16* Kb = P + pc(512 + h * 64) + rowbase * PITCH; const bf16* Vb = P + pc(1024 + h * 64) + rowbase * PITCH;
  float m = -1e30f, l = 0.f; f32x16 o[2]; o[0] = f32x16{}; o[1] = f32x16{};
  dil_pattern<16, 5, 1>(Kb, Vb, S, 32 * c, r, qr, m, l, o, vl, wsf, lane, r32, hi, kr, vr);
  l = swap_sum(l);
  if (hi == 0) { wsf[32 + r32] = 1.f / l; ML[(r + 16 * r32) * 2] = m; ML[(r + 16 * r32) * 2 + 1] = l; }
#pragma unroll
  for (int rr = 0; rr < 16; ++rr) { const float iv = wsf[32 + crow(rr, hi)]; const int tl = r + 16 * crow(rr, hi);
#pragma unroll
    for (int d0 = 0; d0 < 2; ++d0) OA[tl * 64 + d0 * 32 + r32] = f2bf(o[d0][rr] * iv); }
}
__device__ __forceinline__ void dil_item_m(const bf16* __restrict__ P, long rowbase, int S, int h, int c, int g, LAS char* vl, LAS float* wsf, LAS bf16* OA, LAS float* ML, const bf16x8 (&qr)[4], u32x4 (&kr)[4], u32x4 (&vr)[4]) {
  const int lane = fresh_tid() & 63, r32 = lane & 31, hi = lane >> 5;
  const int r4 = g & 3, jb = g >> 2;
  const bf16* Kb = P + pc(512 + h * 64) + rowbase * PITCH; const bf16* Vb = P + pc(1024 + h * 64) + rowbase * PITCH;
  const int tl0 = r4 + 128 * jb;
  float m = -1e30f, l = 0.f; f32x16 o[2]; o[0] = f32x16{}; o[1] = f32x16{};
  dil_pattern<4, 5, 1>(Kb, Vb, S, 128 * c + 32 * jb, r4, qr, m, l, o, vl, wsf, lane, r32, hi, kr, vr);
  l = swap_sum(l);
  if (hi == 0) {
    const int tl = tl0 + 4 * r32;
    const float ma = ML[tl * 2], la = ML[tl * 2 + 1];
    const float mm = fmaxf(ma, m), wa = la * __builtin_amdgcn_exp2f(ma - mm), wb = __builtin_amdgcn_exp2f(m - mm);
    const float den = wa + l * wb, rden = 1.f / den;
    wsf[r32] = wa * rden; wsf[32 + r32] = wb * rden; ML[tl * 2] = mm; ML[tl * 2 + 1] = den; }
#pragma unroll
  for (int rr = 0; rr < 16; ++rr) { const int q = crow(rr, hi); const float fa = wsf[q], fb = wsf[32 + q]; const int tl = tl0 + 4 * q;
#pragma unroll
    for (int d0 = 0; d0 < 2; ++d0) { const float oa = bf2f(OA[tl * 64 + d0 * 32 + r32]); OA[tl * 64 + d0 * 32 + r32] = f2bf(oa * fa + o[d0][rr] * fb); } }
}
__device__ __forceinline__ void dil_item_b(const bf16* __restrict__ P, bf16* __restrict__ Y, long rowbase, int S, int h, int c, int j, LAS char* vl, LAS float* wsf, const LAS bf16* OA, const LAS float* ML, const bf16x8 (&qr)[4], u32x4 (&kr)[4], u32x4 (&vr)[4]) {
  const int lane = fresh_tid() & 63, r32 = lane & 31, hi = lane >> 5;
  const bf16* Kb = P + pc(512 + h * 64) + rowbase * PITCH; const bf16* Vb = P + pc(1024 + h * 64) + rowbase * PITCH; const bf16* Gb = P + pc(1536 + h * 64) + rowbase * PITCH;
  const int tq0 = 512 * c + 32 * j;
  float m = -1e30f, l = 0.f; f32x16 o[2]; o[0] = f32x16{}; o[1] = f32x16{};
  dil_pattern<1, 5, 1>(Kb, Vb, S, tq0, 0, qr, m, l, o, vl, wsf, lane, r32, hi, kr, vr);
  l = swap_sum(l);
  if (hi == 0) {
    const float ma = ML[(32 * j + r32) * 2], la = ML[(32 * j + r32) * 2 + 1];
    const float mm = fmaxf(ma, m), wa = la * __builtin_amdgcn_exp2f(ma - mm), wb = __builtin_amdgcn_exp2f(m - mm);
    const float rden = 1.f / (wa + l * wb);
    wsf[r32] = wa * rden; wsf[32 + r32] = wb * rden; }
  bf16* Yb = Y + rowbase * YP + h * 64;
#pragma unroll
  for (int rr = 0; rr < 16; ++rr) { const int q = crow(rr, hi); const float fa = wsf[q], fb = wsf[32 + q]; const long tok = tq0 + q;
#pragma unroll
    for (int d0 = 0; d0 < 2; ++d0) { const float g = bf2f(Gb[tok * PITCH + d0 * 32 + r32]); const float oa = bf2f(OA[(32 * j + q) * 64 + d0 * 32 + r32]);
      Yb[tok * YP + d0 * 32 + r32] = f2bf((oa * fa + o[d0][rr] * fb) * silu(g)); } }
}
}
typedef unsigned short bf16;
typedef float f32x4g __attribute__((ext_vector_type(4)));
typedef unsigned v4u __attribute__((ext_vector_type(4)));
constexpr int NTOK = 65536, DMODEL = 1024, DPROJ = 4096, NBATCH = 20, NPROMPT_ROWS = 32768;
constexpr size_t MiB = 1u << 20;
constexpr size_t WS_PROJ = 0, WS_Y = 0, WS_SSQ = 128 * MiB, WS_GATE = 132 * MiB, WS_NEED = 512 * MiB;
constexpr size_t DO_H = 0, DO_WIN = 128 * MiB, DO_WOUT = 136 * MiB, DO_MOD = 138 * MiB, DO_ROPE = 139 * MiB, DO_MISC = 140 * MiB;
constexpr size_t DO_BAR = 141 * MiB;
constexpr int LDS_XB = 147392;
constexpr int LDS_BYTES = 147456;
#define XB_TMO      128
#define XB_XCNT(j)  (256  + 64 * (j))
#define XB_XSUB(j)  (1280 + 64 * (j))
#define XB_XGEN(j)  (2304 + 64 * (j))
#define XB_TOP      3328
#define XB_TOPGEN   3392
#define XCD_BAR_WORDS 3456
#define XB_SPIN_CAP (1u << 18)

__device__ __forceinline__ unsigned xb_ld(unsigned* p)              { return __hip_atomic_load(p, __ATOMIC_RELAXED, __HIP_MEMORY_SCOPE_AGENT); }
__device__ __forceinline__ unsigned xb_add(unsigned* p, unsigned v) { return __hip_atomic_fetch_add(p, v, __ATOMIC_RELAXED, __HIP_MEMORY_SCOPE_AGENT); }
__device__ __forceinline__ unsigned xb_xcc_id() { return (unsigned)__builtin_amdgcn_s_getreg((3 << 11) | 20) & 0xFu; }
#define XB_SPIN(cond, bar) do { unsigned _sp = 0; while (cond) { __builtin_amdgcn_s_sleep(1); \
    if ((++_sp & 255u) == 0u) { if (xb_ld(&(bar)[XB_TMO])) break; if (_sp > XB_SPIN_CAP) { atomicAdd(&(bar)[XB_TMO], 1u); break; } } } } while (0)

struct XcdBarrier {
    unsigned* bar; unsigned x;
    volatile LAS unsigned* st;
};

__device__ __forceinline__ XcdBarrier xcd_barrier_post(unsigned* bar, volatile LAS unsigned* st) {
    XcdBarrier b; b.bar = bar; b.x = xb_xcc_id(); b.st = st;
    if (threadIdx.x == 0) (void)xb_add(&bar[XB_XCNT(b.x)], 1u);
    return b;
}
__device__ __forceinline__ void xcd_barrier_complete(unsigned* bar, unsigned x, unsigned& nloc, unsigned& nx) {
    const unsigned G = gridDim.x * gridDim.y * gridDim.z;
    unsigned sum, cnt, mine, sp = 0u;
    for (;;) {
        sum = 0u; cnt = 0u; mine = 0u;
#pragma unroll
        for (unsigned j = 0; j < 16; ++j) { const unsigned c = xb_ld(&bar[XB_XCNT(j)]); sum += c; cnt += (c > 0u) ? 1u : 0u; mine = (j == x) ? c : mine; }
        if (sum == G) break;
        __builtin_amdgcn_s_sleep(1);
        if ((++sp & 255u) == 0u) { if (xb_ld(&bar[XB_TMO])) break; if (sp > XB_SPIN_CAP) { atomicAdd(&bar[XB_TMO], 1u); break; } }
    }
    nloc = mine > 0u ? mine : 1u; nx = cnt > 0u ? cnt : 1u;
}

__device__ __forceinline__ void xcd_barrier(const XcdBarrier& b) {
    asm volatile("s_waitcnt vmcnt(0)" ::: "memory");
    __syncthreads();
    if (threadIdx.x == 0) {
        unsigned* bar = b.bar;
        __builtin_amdgcn_s_waitcnt(0);
        unsigned nloc = b.st[0], nx = b.st[1];
        if (nloc == 0u) { xcd_barrier_complete(bar, b.x, nloc, nx); b.st[0] = nloc; b.st[1] = nx; }
        const unsigned old = xb_add(&bar[XB_XSUB(b.x)], 1u);
        const unsigned gen = old / nloc;
        if (old + 1u == (gen + 1u) * nloc) {
            __builtin_amdgcn_fence(__ATOMIC_RELEASE, "agent");
            asm volatile("s_waitcnt vmcnt(0)" ::: "memory");
            const unsigned og = xb_add(&bar[XB_TOP], 1u);
            const unsigned tg = og / nx;
            if (og + 1u == (tg + 1u) * nx) xb_add(&bar[XB_TOPGEN], 1u);
            else XB_SPIN(xb_ld(&bar[XB_TOPGEN]) == tg, bar);
            __builtin_amdgcn_fence(__ATOMIC_ACQUIRE, "agent");
            xb_add(&bar[XB_XGEN(b.x)], 1u);
            asm volatile("s_waitcnt vmcnt(0)" ::: "memory");
        } else {
            XB_SPIN(xb_ld(&bar[XB_XGEN(b.x)]) == gen, bar);
            __builtin_amdgcn_fence(__ATOMIC_ACQUIRE, "agent");
            asm volatile("s_waitcnt vmcnt(0)" ::: "memory");
        }
    }
    __syncthreads();
}

struct Params { const float* in[15]; float* out; unsigned char* ws; int mask; int pad; };

__device__ __forceinline__ unsigned f2bf_u(float f) { unsigned u = __builtin_bit_cast(unsigned, f); return (u + 0x7fffu + ((u >> 16) & 1u)) >> 16; }
__device__ __forceinline__ unsigned pk2(float lo, float hi) { return f2bf_u(lo) | (f2bf_u(hi) << 16); }
__device__ __forceinline__ float wave_sum(float v) {
#pragma unroll
    for (int o = 1; o < 64; o <<= 1) v += __shfl_xor(v, o);
    return v;
}
__device__ __forceinline__ void transpose_item(const float* W, int K, int N, bf16* WT, LAS float* scr, int item, int lane) {
    const int nblk = N / 32, kb = item / nblk, nb = item % nblk, k0 = 64 * kb, n0 = 32 * nb;
#pragma unroll 8
    for (int i = 0; i < 32; ++i) { const int kk = 2 * i + (lane >> 5); scr[kk * 33 + (lane & 31)] = W[(size_t)(k0 + kk) * N + n0 + (lane & 31)]; }
    asm volatile("s_waitcnt lgkmcnt(0)" ::: "memory");
    const int c = lane & 7;
#pragma unroll
    for (int j = 0; j < 4; ++j) { const int n = (lane >> 3) + 8 * j; const LAS float* s = scr + (8 * c) * 33 + n;
        v4u o; o.x = pk2(s[0 * 33], s[1 * 33]); o.y = pk2(s[2 * 33], s[3 * 33]); o.z = pk2(s[4 * 33], s[5 * 33]); o.w = pk2(s[6 * 33], s[7 * 33]);
        *(v4u*)(WT + (size_t)(n0 + n) * K + k0 + 8 * c) = o; }
    asm volatile("s_waitcnt lgkmcnt(0)" ::: "memory");
}
__device__ __forceinline__ const float* xrow_ptr(const Params& p, int row) { return row < NPROMPT_ROWS ? p.in[0] + (size_t)row * DMODEL : p.in[1] + (size_t)(row - NPROMPT_ROWS) * DMODEL; }
__device__ __forceinline__ int row_batch(int row) { return row < NPROMPT_ROWS ? (row >> 13) : 4 + ((row - NPROMPT_ROWS) >> 11); }

__global__ void __launch_bounds__(512, 2) mega_fwd(Params p) {
    extern __shared__ __attribute__((aligned(16))) unsigned char lds_raw[];
    LAS unsigned char* lds = (LAS unsigned char*)lds_raw;
    cg::grid_group grid = cg::this_grid();
    const int tid = threadIdx.x, lane = tid & 63, wave = __builtin_amdgcn_readfirstlane(tid >> 6);
    const int G = gridDim.x, bx = blockIdx.x;
    const int vcu = (G % 8 == 0) ? (bx % 8) * (G / 8) + bx / 8 : bx;
    unsigned char* dob = (unsigned char*)p.out;
    bf16* H = (bf16*)(dob + DO_H); bf16* WIN = (bf16*)(dob + DO_WIN); bf16* WOUT = (bf16*)(dob + DO_WOUT);
    float* MOD = (float*)(dob + DO_MOD); float* ROPE = (float*)(dob + DO_ROPE); float* MISC = (float*)(dob + DO_MISC);
    bf16* PROJ = (bf16*)(p.ws + WS_PROJ); bf16* YB = (bf16*)(p.ws + WS_Y); float* SSQ = (float*)(p.ws + WS_SSQ); float* GATE = (float*)(p.ws + WS_GATE);
    const int gw = vcu * 8 + wave, NGW = G * 8;
    { unsigned* bw = (unsigned*)(dob + DO_BAR); for (int i = bx * 512 + tid; i < XCD_BAR_WORDS; i += G * 512) bw[i] = 0u; }
    if (tid < 2) ((volatile LAS unsigned*)(lds + LDS_XB))[tid] = 0u;

    asm volatile(".p2align 8\n\t.rept " PAD_STR(PAD_P0A) "\n\ts_nop 0\n\t.endr");
    if (p.mask & 1) {
        for (int e = bx * 512 + tid; e < 8192 * 8; e += G * 512) {
            const int pos = e >> 3, i = e & 7;
            const float inv = exp2f(-(float)i * (1.0f / 8.0f) * 18.931568569324174f);
            const float ang = (float)pos * inv;
            const double ad = (double)ang; const double n = rint(ad * 0.15915494309189535); const float red = (float)(ad - n * 6.283185307179586);
            ROPE[2 * e] = cosf(red); ROPE[2 * e + 1] = sinf(red);
        }
        __syncthreads();
        if (bx < 192) {
            LAS float* sc = (LAS float*)lds;
            LAS float* red = (LAS float*)(lds + 81920);
            { float cvv[NBATCH * 2];
#pragma unroll
              for (int q = 0; q < NBATCH * 2; ++q) { const int i = tid + 512 * q; const int b = i >> 10, k = i & 1023; cvv[q] = b < 4 ? p.in[2][b * DMODEL + k] : p.in[3][(b - 4) * DMODEL + k]; }
#pragma unroll
              for (int q = 0; q < NBATCH * 2; ++q) sc[tid + 512 * q] = cvv[q] / (1.f + __expf(-cvv[q])); }
            __syncthreads();
            const int col = tid & 15, ks = tid >> 4, j = bx * 16 + col;
            float acc[NBATCH];
#pragma unroll
            for (int b = 0; b < NBATCH; ++b) acc[b] = 0.f;
            float wv[32];
#pragma unroll
            for (int i = 0; i < 32; ++i) wv[i] = p.in[8][(size_t)(ks + 32 * i) * 3072 + j];
#pragma unroll
            for (int i = 0; i < 32; ++i) {
#pragma unroll
                for (int b = 0; b < NBATCH; ++b) acc[b] += sc[b * DMODEL + ks + 32 * i] * wv[i]; }
#pragma unroll
            for (int b = 0; b < NBATCH; ++b) red[(ks * NBATCH + b) * 16 + col] = acc[b];
            __syncthreads();
            if (tid < NBATCH * 16) { const int b = tid >> 4, cc = tid & 15; float s = 0.f;
                for (int k2 = 0; k2 < 32; ++k2) s += red[(k2 * NBATCH + b) * 16 + cc];
                MOD[b * 3072 + bx * 16 + cc] = s + p.in[9][bx * 16 + cc]; }
        }
        if (bx == G - 1 && wave == 0) {
            const float a = wave_sum(p.in[10][lane] * p.in[11][lane]), b2 = wave_sum(p.in[12][lane] * p.in[13][lane]);
            if (lane == 0) MISC[0] = expf(a) - expf(b2) + 0.2f;
        }
    }
    asm volatile("s_waitcnt vmcnt(0)\n\ts_nop 0" ::: "memory");
    grid.sync();
    const XcdBarrier xbar = xcd_barrier_post((unsigned*)(dob + DO_BAR), (volatile LAS unsigned*)(lds + LDS_XB));
    asm volatile(".p2align 8\n\t.rept " PAD_STR(PAD_P0B) "\n\ts_nop 0\n\t.endr");
    if (p.mask & 2) { const int lane = att::fresh_tid() & 63;
    f32x4g gpre[4];
#pragma unroll
    for (int j = 0; j < 4; ++j) gpre[j] = ((const f32x4g*)p.in[6])[lane + 64 * j];
    for (int rb = gw; rb < NTOK; rb += 4 * NGW) {
        f32x4g v[4][4];
#pragma unroll
        for (int q = 0; q < 4; ++q) { const int row = rb + q * NGW; if (row < NTOK) { const f32x4g* xr = (const f32x4g*)xrow_ptr(p, row) + lane;
#pragma unroll
            for (int j = 0; j < 4; ++j) v[q][j] = __builtin_nontemporal_load(&xr[64 * j]); } }
#pragma unroll
        for (int q = 0; q < 4; ++q) { const int row = rb + q * NGW; if (row < NTOK) {
            const int b = row_batch(row); float s = 0.f;
#pragma unroll
            for (int j = 0; j < 4; ++j) s += (v[q][j].x * v[q][j].x + v[q][j].y * v[q][j].y) + (v[q][j].z * v[q][j].z + v[q][j].w * v[q][j].w);
            const float rstd = rsqrtf(wave_sum(s) * (1.f / DMODEL) + 1e-6f);
            unsigned long long* o8 = (unsigned long long*)(H + (size_t)row * DMODEL) + lane;
#pragma unroll
            for (int j = 0; j < 4; ++j) {
                const f32x4g sh = ((const f32x4g*)(MOD + b * 3072))[lane + 64 * j], sl = ((const f32x4g*)(MOD + b * 3072 + 1024))[lane + 64 * j];
                const f32x4g hv = v[q][j] * rstd * gpre[j] * (sl + 1.f) + sh;
                o8[64 * j] = (unsigned long long)pk2(hv.x, hv.y) | ((unsigned long long)pk2(hv.z, hv.w) << 32);
            } } }
    }
    {
        LAS float* scr = (LAS float*)(lds + wave * 16384);
        constexpr int I_IN = (DMODEL / 64) * (DPROJ / 32), I_OUT = (DMODEL / 64) * (DMODEL / 32);
        for (int it = gw; it < I_IN + I_OUT; it += NGW) {
            if (it < I_IN) transpose_item(p.in[4], DMODEL, DPROJ, WIN, scr, it, lane);
            else transpose_item(p.in[5], DMODEL, DMODEL, WOUT, scr, it - I_IN, lane);
        }
    } }
    xcd_barrier(xbar);
#ifndef NO_P1
    asm volatile(".p2align 8\n\t.rept " PAD_STR(PAD_P1) "\n\ts_nop 0\n\t.endr");
    if (p.mask & 4) {
        pg8::Gemm g{H, WIN, NTOK, DPROJ, DMODEL}; pg8::StaticOrder S; S.init(NTOK, DPROJ, G, bx);
        pg8::EpiProj E{PROJ, 256, ROPE};
        pg8::gemm_phase<pg8::EpiProj, pg8::StaticOrder, true, true>(lds, g, S, E);
    }
#endif
    xcd_barrier(xbar);
    {
        bf16* YM = H;
        const float lam = MISC[0];
#ifndef NO_DIFF
    asm volatile(".p2align 8\n\t.rept " PAD_STR(PAD_DIFF) "\n\ts_nop 0\n\t.endr");
        if (p.mask & 8)
        for (int u = vcu; u < 2048; u += G) {
            int bh, qt, S; long rowbase;
            if (u < 1024) { bh = (u & 255) >> 4; qt = (u & 15) * 4 + (u >> 8); S = 8192; rowbase = (long)(bh >> 2) * 8192; }
            else { const int u2 = u - 1024; bh = (u2 & 255) >> 2; qt = (u2 & 3) * 4 + (u2 >> 8); S = 2048; rowbase = NPROMPT_ROWS + (long)(bh >> 2) * 2048; }
            att::diff_unit(PROJ, YM, rowbase, S, bh & 3, qt, (LAS char*)lds, lam, p.in[14]);
        }
#endif
#ifndef NO_DIL
        LAS char* vl = (LAS char*)lds + wave * 8448; LAS float* wsf = (LAS float*)(lds + wave * 8448 + 8192);
        LAS att::bf16* OA = (LAS att::bf16*)(lds + 67584); LAS float* ML = (LAS float*)(lds + 67584 + 65536);
    asm volatile(".p2align 8\n\t.rept " PAD_STR(PAD_DIL) "\n\ts_nop 0\n\t.endr");
        if (p.mask & 16)
        for (int u = vcu; u < 1024; u += G) {
            int b, h, c, S; long rowbase;
            if (u < 512) { const int id = (u & 255) * 2 + (u >> 8); c = id & 15; h = (id >> 4) & 7; b = id >> 7; S = 8192; rowbase = (long)b * 8192; }
            else { const int u2 = u - 512; const int id = (u2 & 255) * 2 + (u2 >> 8); c = id & 3; h = (id >> 2) & 7; b = id >> 5; S = 2048; rowbase = NPROMPT_ROWS + (long)b * 2048; }
            {
                const int ln = att::fresh_tid() & 63, r32 = ln & 31, hi = ln >> 5;
                const att::bf16* Qb = PROJ + att::pc(h * 64) + rowbase * att::PITCH;
                const long t0 = 512L * c;
                att::bf16x8 q0[4], q1[4];
                const att::bf16* Kb = PROJ + att::pc(512 + h * 64) + rowbase * att::PITCH; const att::bf16* Vb = PROJ + att::pc(1024 + h * 64) + rowbase * att::PITCH;
                att::u32x4 ka[4], va[4], kc[4], vc[4];
                const int g0 = wave, g1 = wave + 8;
                att::dil_q(q0, Qb, t0 + wave + 16 * r32, hi); att::dil_q(q1, Qb, t0 + wave + 8 + 16 * r32, hi);
                att::dil_first<16>(ka, va, Kb, Vb, S, 32 * c, wave, ln);
                att::dil_first<16>(kc, vc, Kb, Vb, S, 32 * c, wave + 8, ln);
                att::dil_item_a(PROJ, rowbase, S, h, c, wave, vl, wsf, OA, ML, q0, ka, va);
                att::dil_q(q0, Qb, t0 + (g0 & 3) + 128 * (g0 >> 2) + 4 * r32, hi);
                att::dil_first<4>(ka, va, Kb, Vb, S, 128 * c + 32 * (g0 >> 2), g0 & 3, ln);
                att::dil_item_a(PROJ, rowbase, S, h, c, wave + 8, vl, wsf, OA, ML, q1, kc, vc);
                att::dil_q(q1, Qb, t0 + (g1 & 3) + 128 * (g1 >> 2) + 4 * r32, hi);
                att::dil_first<4>(kc, vc, Kb, Vb, S, 128 * c + 32 * (g1 >> 2), g1 & 3, ln);
                __syncthreads();
                att::dil_item_m(PROJ, rowbase, S, h, c, wave, vl, wsf, OA, ML, q0, ka, va);
                att::dil_q(q0, Qb, t0 + 32 * wave + r32, hi);
                att::dil_first<1>(ka, va, Kb, Vb, S, 512 * c + 32 * wave, 0, ln);
                att::dil_item_m(PROJ, rowbase, S, h, c, wave + 8, vl, wsf, OA, ML, q1, kc, vc);
                att::dil_q(q1, Qb, t0 + 32 * (wave + 8) + r32, hi);
                att::dil_first<1>(kc, vc, Kb, Vb, S, 512 * c + 32 * (wave + 8), 0, ln);
                __syncthreads();
                att::dil_item_b(PROJ, YM, rowbase, S, h, c, wave, vl, wsf, OA, ML, q0, ka, va);
                att::dil_item_b(PROJ, YM, rowbase, S, h, c, wave + 8, vl, wsf, OA, ML, q1, kc, vc);
            }
            __syncthreads();
        }
#endif
    }
    xcd_barrier(xbar);
    asm volatile(".p2align 8\n\t.rept " PAD_STR(PAD_P3) "\n\ts_nop 0\n\t.endr");
    if (p.mask & 32) {
        for (int i = bx * 512 + tid; i < NBATCH * DMODEL; i += G * 512) GATE[i] = MOD[(i >> 10) * 3072 + 2048 + (i & 1023)];
#ifndef NO_P3
        pg8::Gemm g{H, WOUT, NTOK, DMODEL, DMODEL}; pg8::StaticOrder S; S.init(NTOK, DMODEL, G, bx);
        pg8::EpiY E{YB, DMODEL, SSQ};
        pg8::gemm_phase<pg8::EpiY, pg8::StaticOrder, true, true>(lds, g, S, E);
#endif
    }
    asm volatile("s_waitcnt vmcnt(0)\n\ts_nop 0" ::: "memory");
    grid.sync();
    asm volatile(".p2align 8\n\t.rept " PAD_STR(PAD_P4) "\n\ts_nop 0\n\t.endr");
    if (p.mask & 64) { const int lane = att::fresh_tid() & 63;
    for (int row = gw; row < NTOK; row += NGW) {
        const f32x4g* xr = (const f32x4g*)xrow_ptr(p, row) + lane;
        const int b = row_batch(row);
        const float ss = wave_sum(lane < 16 ? SSQ[(size_t)row * 16 + lane] : 0.f);
        const float rstd = rsqrtf(ss * (1.f / DMODEL) + 1e-6f);
        const unsigned long long* y8 = (const unsigned long long*)(YB + (size_t)row * DMODEL) + lane;
        f32x4g* orow = (f32x4g*)(p.out + (size_t)row * DMODEL) + lane;
#pragma unroll
        for (int j = 0; j < 4; ++j) {
            const unsigned long long yv = __builtin_nontemporal_load(&y8[64 * j]);
            f32x4g y; y.x = __uint_as_float(((unsigned)yv) << 16); y.y = __uint_as_float(((unsigned)yv) & 0xffff0000u);
            y.z = __uint_as_float(((unsigned)(yv >> 32)) << 16); y.w = __uint_as_float(((unsigned)(yv >> 32)) & 0xffff0000u);
            const f32x4g gt = ((const f32x4g*)(GATE + b * DMODEL))[lane + 64 * j], gp = ((const f32x4g*)p.in[7])[lane + 64 * j];
            __builtin_nontemporal_store(__builtin_nontemporal_load(&xr[64 * j]) + gt * (y * rstd) * gp, &orow[64 * j]);
        }
    } }
}

extern "C" void kernel_launch(void* const* d_in, const int* in_sizes, int n_in, void* d_out, int out_size, void* d_ws, size_t ws_size, hipStream_t stream) {
    static int grid = 0;
    if (grid == 0) {
        if (n_in != 15 || ws_size < WS_NEED || out_size != NTOK * DMODEL) { fprintf(stderr, "kernel_launch: unexpected shapes (n_in %d, ws %zu, out %d)\n", n_in, ws_size, out_size); grid = -1; return; }
        int dev = 0, cus = 0, per_cu = 0;
        hipGetDevice(&dev); hipDeviceGetAttribute(&cus, hipDeviceAttributeMultiprocessorCount, dev);
        hipFuncSetAttribute((const void*)mega_fwd, hipFuncAttributeMaxDynamicSharedMemorySize, LDS_BYTES);
        hipOccupancyMaxActiveBlocksPerMultiprocessor(&per_cu, (const void*)mega_fwd, 512, LDS_BYTES);
        (void)hipGetLastError();
        if (per_cu < 1) per_cu = 1;
        grid = cus;
    }
    if (grid < 0) return;
    Params p{};
    for (int i = 0; i < 15; ++i) p.in[i] = (const float*)d_in[i];
    p.out = (float*)d_out; p.ws = (unsigned char*)d_ws; p.mask = 127;
#ifdef PROBE_MASK
    { Params p2 = p; p2.mask = PROBE_MASK; void* args2[] = {&p2}; (void)hipLaunchCooperativeKernel((const void*)mega_fwd, dim3(grid), dim3(512), args2, LDS_BYTES, stream); }
#endif
    void* args[] = {&p};
    hipError_t e = hipLaunchCooperativeKernel((const void*)mega_fwd, dim3(grid), dim3(512), args, LDS_BYTES, stream);
    if (e != hipSuccess) fprintf(stderr, "cooperative launch failed: %s (grid %d)\n", hipGetErrorString(e), grid);
}
```

```cpp
#include <hip/hip_runtime.h>
#include <hip/hip_cooperative_groups.h>
#include <cstdio>
#include <cstdint>
namespace cg = cooperative_groups;
#define PAD_STR2(x) #x
#define PAD_STR(x) PAD_STR2(x)
#define PAD_P0A 0
#define PAD_P0B 0
#define PAD_P1 0
#define PAD_DIFF 0
#define PAD_DIL 0
#define PAD_P3 0
#define PAD_P4 0
constexpr float QK_C2 = 0.125f * 1.4426950408889634f;
namespace pg8 {
#define PG8_LAS __attribute__((address_space(3)))
typedef unsigned short bf16_t;
typedef short bf16x8 __attribute__((ext_vector_type(8)));
typedef float f32x4 __attribute__((ext_vector_type(4)));
typedef unsigned u32x4 __attribute__((ext_vector_type(4)));
constexpr int BM = 256, BK = 64, HALF = 128, HTB = HALF * BK * 2  , STAGE_BYTES = 8 * HTB, NXCD = 8, WGM = 8;

__host__ __device__ __forceinline__ int lds_byte(int r, int c) { const int st = (r >> 4) * 2 + (c >> 5), rr = r & 15, cc = c & 31, ob = rr * 64 + cc * 2; return st * 1024 + (ob ^ (((ob >> 9) & 1) << 5)); }
__host__ __device__ __forceinline__ void stage_rc(int b, int& R, int& C) { const int st = b / 1024, sb = b % 1024, swz = sb ^ (((sb >> 9) & 1) << 5); R = (st >> 1) * 16 + swz / 64; C = (st & 1) * 32 + (swz % 64) / 2; }
__host__ __device__ __forceinline__ int perm32(int rho) { const int n = rho >> 4, i = rho & 15; return 8 * (i >> 2) + 4 * n + (i & 3); }

struct Unit { int pm, pn; };
struct Gemm { const bf16_t* A; const bf16_t* Bt; int M, N, K; };

struct StaticOrder {
    int nM, nN, nwg, G, c;
    __host__ __device__ void init(int M, int N, int G_, int c_) { nM = M / BM; nN = N / BM; nwg = nM * nN; G = G_; c = c_; }
    __host__ __device__ bool next(int i, Unit& u) const {
        const long L = (long)i * G + c; if (L >= nwg) return false;
        int wgid = (int)L; { const int q = nwg / NXCD, r = nwg % NXCD, xcd = wgid % NXCD, off = wgid / NXCD; wgid = (xcd < r ? xcd * (q + 1) : r * (q + 1) + (xcd - r) * q) + off; }
        const int nig = WGM * nN, gid = wgid / nig, fm = gid * WGM, gsz = (nM - fm) < WGM ? (nM - fm) : WGM;
        u.pm = fm + ((wgid % nig) % gsz); u.pn = (wgid % nig) / gsz; return true;
    }
    __device__ __forceinline__ void a_ready(const Unit&) const {}
    __device__ __forceinline__ void done(const Unit&) const {}
};

__device__ __forceinline__ unsigned cvt_pk_bf16(float lo, float hi) { unsigned r; asm volatile("v_cvt_pk_bf16_f32 %0, %1, %2" : "=v"(r) : "v"(lo), "v"(hi)); return r; }
struct EpiProj {
    static constexpr bool PERM = true, AFTER_DRAIN = false;
    bf16_t* O; int ldc; const float* rope;
    __device__ __forceinline__ void operator()(const f32x4 (&acc)[2][2][4][2], const Unit& u, int wr, int wc, int fr, int fq) const {
        const int row0 = u.pm * BM + wr * 64 + fr;
        const bool tile_rope = (u.pn & 4) == 0;
        const bool lane_rope = tile_rope && ((wc & 1) == 0) && (fq < 2);
        const float sc = ((u.pn & 6) == 0) ? QK_C2 : 1.f;
        const float sgn = (fq == 0) ? -1.f : 1.f;
        const int col0 = wc * 32 + 8 * fq;
        bf16_t* const Op = O + (size_t)u.pn * ((size_t)65536 * 256);
#pragma unroll
        for (int ai = 0; ai < 2; ++ai)
#pragma unroll
            for (int m = 0; m < 4; ++m) {
                const int row = row0 + ai * HALF + m * 16;
                const int pos = row < 32768 ? (row & 8191) : (row & 2047);
                f32x4 cs[4];
                if (tile_rope) {
#pragma unroll
                    for (int q = 0; q < 4; ++q) cs[q] = *(const f32x4*)(rope + (size_t)pos * 16 + q * 4);
                }
                bf16_t* rowp = Op + (size_t)row * ldc + col0;
#pragma unroll
                for (int bj = 0; bj < 2; ++bj) {
                    f32x4 v0 = acc[ai][bj][m][0], v1 = acc[ai][bj][m][1];
                    if (tile_rope) {
                        f32x4 p0, p1;
#pragma unroll
                        for (int j = 0; j < 4; ++j) { p0[j] = __shfl_xor(v0[j], 16); p1[j] = __shfl_xor(v1[j], 16); }
                        if (lane_rope) {
                            v0[0] = v0[0] * cs[0][0] + sgn * p0[0] * cs[0][1]; v0[1] = v0[1] * cs[0][2] + sgn * p0[1] * cs[0][3];
                            v0[2] = v0[2] * cs[1][0] + sgn * p0[2] * cs[1][1]; v0[3] = v0[3] * cs[1][2] + sgn * p0[3] * cs[1][3];
                            v1[0] = v1[0] * cs[2][0] + sgn * p1[0] * cs[2][1]; v1[1] = v1[1] * cs[2][2] + sgn * p1[1] * cs[2][3];
                            v1[2] = v1[2] * cs[3][0] + sgn * p1[2] * cs[3][1]; v1[3] = v1[3] * cs[3][2] + sgn * p1[3] * cs[3][3];
                        }
                    }
                    v0 = v0 * sc; v1 = v1 * sc;
                    u32x4 w; w.x = cvt_pk_bf16(v0[0], v0[1]); w.y = cvt_pk_bf16(v0[2], v0[3]); w.z = cvt_pk_bf16(v1[0], v1[1]); w.w = cvt_pk_bf16(v1[2], v1[3]);
                    __builtin_nontemporal_store(w, (u32x4*)(rowp + bj * HALF));
                }
            }
    }
};
struct EpiY {
    static constexpr bool PERM = true, AFTER_DRAIN = false;
    bf16_t* O; int ldc; float* ssq;
    __device__ __forceinline__ void operator()(const f32x4 (&acc)[2][2][4][2], const Unit& u, int wr, int wc, int fr, int fq) const {
        const int row0 = u.pm * BM + wr * 64 + fr;
        const int col0 = u.pn * BM + wc * 32 + 8 * fq;
#pragma unroll
        for (int ai = 0; ai < 2; ++ai)
#pragma unroll
            for (int m = 0; m < 4; ++m) {
                const int row = row0 + ai * HALF + m * 16;
                bf16_t* rowp = O + (size_t)row * ldc + col0;
                float s = 0.f;
#pragma unroll
                for (int bj = 0; bj < 2; ++bj) {
                    const f32x4 v0 = acc[ai][bj][m][0], v1 = acc[ai][bj][m][1];
                    s += (v0[0] * v0[0] + v0[1] * v0[1]) + (v0[2] * v0[2] + v0[3] * v0[3]) + (v1[0] * v1[0] + v1[1] * v1[1]) + (v1[2] * v1[2] + v1[3] * v1[3]);
                    u32x4 w; w.x = cvt_pk_bf16(v0[0], v0[1]); w.y = cvt_pk_bf16(v0[2], v0[3]); w.z = cvt_pk_bf16(v1[0], v1[1]); w.w = cvt_pk_bf16(v1[2], v1[3]);
                    *(u32x4*)(rowp + bj * HALF) = w;
                }
                s += __shfl_xor(s, 16); s += __shfl_xor(s, 32);
                if (fq == 0) ssq[(size_t)row * 16 + u.pn * 4 + wc] = s;
            }
    }
};
template <class Epi, class Sched, bool ALIGN_EPI = false, bool SP2 = false>
__device__ __forceinline__ void gemm_phase(PG8_LAS unsigned char* lds, const Gemm g, const Sched& S, const Epi& E) {
    const int tid = threadIdx.x, wid = __builtin_amdgcn_readfirstlane(tid >> 6), lane = tid & 63, wr = wid >> 2, wc = wid & 3, fr = lane & 15, fq = lane >> 4;
    const int K = g.K, nt = K / BK;
    unsigned voffA[2], voffB[2];
#pragma unroll
    for (int i = 0; i < 2; ++i) { int R, C; stage_rc(tid * 16 + i * 8192, R, C); const int Rb = Epi::PERM ? ((R & ~31) + perm32(R & 31)) : R;
        voffA[i] = (unsigned)(R * K + C) * 2u; voffB[i] = (unsigned)(Rb * K + C) * 2u; }
    const size_t kstep = (size_t)(BK * 2);
    const size_t hstep = (size_t)HALF * K * 2;
    const size_t tstep = 2 * hstep;
    const unsigned ldsw = (unsigned)wid * 1024u;
    const int aoff = lds_byte(wr * 64 + fr, fq * 8), boff = lds_byte(wc * 32 + fr, fq * 8);
#define PG8_SA(b, h) (((b) * 2 + (h)) * HTB)
#define PG8_SB(b, h) ((4 + (b) * 2 + (h)) * HTB)
#define PG8_STAGE(bufoff, gbase, voff) do { _Pragma("unroll") for (int _i = 0; _i < 2; ++_i) \
        __builtin_amdgcn_global_load_lds((const unsigned*)((const char*)(gbase) + (voff)[_i]), (PG8_LAS unsigned*)(lds + (bufoff) + ldsw + _i * 8192), 16, 0, 0); } while (0)
#define PG8_LDA(dst, b, h) do { _Pragma("unroll") for (int m = 0; m < 4; ++m) _Pragma("unroll") for (int k = 0; k < 2; ++k) dst[m][k] = *(const PG8_LAS bf16x8*)(lds + PG8_SA(b, h) + aoff + m * 2048 + k * 1024); } while (0)
#define PG8_LDB(dst, b, h) do { _Pragma("unroll") for (int n = 0; n < 2; ++n) _Pragma("unroll") for (int k = 0; k < 2; ++k) dst[n][k] = *(const PG8_LAS bf16x8*)(lds + PG8_SB(b, h) + boff + n * 2048 + k * 1024); } while (0)
#define PG8_MMA(ai, bj, At, Bt) do { __builtin_amdgcn_s_setprio(1); _Pragma("unroll") for (int m = 0; m < 4; ++m) _Pragma("unroll") for (int n = 0; n < 2; ++n) _Pragma("unroll") for (int k = 0; k < 2; ++k) \
        acc[ai][bj][m][n] = __builtin_amdgcn_mfma_f32_16x16x32_bf16(Bt[n][k], At[m][k], acc[ai][bj][m][n], 0, 0, 0); __builtin_amdgcn_s_setprio(0); } while (0)
#define PG8_WAIT_V(n) asm volatile("s_waitcnt vmcnt(" #n ")" ::: "memory")
#define PG8_WAIT_L(n) asm volatile("s_waitcnt lgkmcnt(" #n ")" ::: "memory")
#define PG8_BAR __builtin_amdgcn_s_barrier()
#define PG8_SCHED __builtin_amdgcn_sched_barrier(0)
    Unit cur, nxt; int ui = 0;
    if (!S.next(0, cur)) return;
    f32x4 acc[2][2][4][2];
#pragma unroll
    for (int a = 0; a < 2; ++a)
#pragma unroll
        for (int b = 0; b < 2; ++b)
#pragma unroll
            for (int m = 0; m < 4; ++m)
#pragma unroll
                for (int n = 0; n < 2; ++n) acc[a][b][m][n] = (f32x4){0.f, 0.f, 0.f, 0.f};
    bf16x8 At[4][2], B0[2][2], B1[2][2];
    const char* cA = (const char*)g.A + (size_t)cur.pm * tstep; const char* cB = (const char*)g.Bt + (size_t)cur.pn * tstep;
    S.a_ready(cur);
    if constexpr (SP2) {
        PG8_STAGE(PG8_SB(0, 0), cB, voffB); PG8_STAGE(PG8_SB(0, 1), cB + hstep, voffB); PG8_STAGE(PG8_SA(0, 0), cA, voffA); PG8_STAGE(PG8_SA(0, 1), cA + hstep, voffA);
        if (wr == 1) PG8_BAR;
        PG8_WAIT_V(2); PG8_BAR;
        PG8_STAGE(PG8_SB(1, 0), cB + kstep, voffB); PG8_STAGE(PG8_SA(1, 0), cA + kstep, voffA); PG8_STAGE(PG8_SB(1, 1), cB + hstep + kstep, voffB);
        PG8_WAIT_V(6); PG8_BAR;
    } else {
        PG8_STAGE(PG8_SB(0, 0), cB, voffB); PG8_STAGE(PG8_SA(0, 0), cA, voffA); PG8_STAGE(PG8_SB(0, 1), cB + hstep, voffB); PG8_STAGE(PG8_SA(0, 1), cA + hstep, voffA);
        if (wr == 1) PG8_BAR;
        PG8_WAIT_V(4); PG8_BAR;
        PG8_STAGE(PG8_SB(1, 0), cB + kstep, voffB); PG8_STAGE(PG8_SA(1, 0), cA + kstep, voffA); PG8_STAGE(PG8_SB(1, 1), cB + hstep + kstep, voffB);
        PG8_WAIT_V(6); PG8_BAR;
    }
    for (;;) {
        const bool has_next = S.next(ui + 1, nxt);
        const char* nA = has_next ? (const char*)g.A + (size_t)nxt.pm * tstep : cA; const char* nB = has_next ? (const char*)g.Bt + (size_t)nxt.pn * tstep : cB;
        for (int t = 0; t < nt; t += 2) {
            const bool last = (t == nt - 2);
            const char* a1 = cA + (size_t)(t + 1) * kstep;
            const char* a2 = last ? nA : cA + (size_t)(t + 2) * kstep; const char* b2 = last ? nB : cB + (size_t)(t + 2) * kstep;
            const char* a3 = a2 + kstep; const char* b3 = b2 + kstep;
            if (last && has_next) S.a_ready(nxt);
            if constexpr (SP2) {
            PG8_LDB(B0, 0, 0); PG8_LDB(B1, 0, 1); PG8_SCHED; PG8_LDA(At, 0, 0); PG8_STAGE(PG8_SA(1, 1), a1 + hstep, voffA);
            PG8_WAIT_V(8); PG8_WAIT_L(0); PG8_BAR; PG8_MMA(0, 0, At, B0); PG8_MMA(0, 1, At, B1); PG8_BAR; PG8_SCHED;
            PG8_LDA(At, 0, 1); PG8_STAGE(PG8_SB(0, 0), b2, voffB); PG8_STAGE(PG8_SB(0, 1), b2 + hstep, voffB); PG8_STAGE(PG8_SA(0, 0), a2, voffA);
            PG8_WAIT_V(8); PG8_WAIT_L(0); PG8_BAR; PG8_MMA(1, 0, At, B0); PG8_MMA(1, 1, At, B1); PG8_BAR; PG8_SCHED;
            PG8_LDB(B0, 1, 0); PG8_LDB(B1, 1, 1); PG8_SCHED; PG8_LDA(At, 1, 0); PG8_STAGE(PG8_SA(0, 1), a2 + hstep, voffA);
            PG8_WAIT_V(8); PG8_WAIT_L(0); PG8_BAR; PG8_MMA(0, 0, At, B0); PG8_MMA(0, 1, At, B1); PG8_BAR; PG8_SCHED;
            PG8_LDA(At, 1, 1); PG8_STAGE(PG8_SB(1, 0), b3, voffB); PG8_STAGE(PG8_SB(1, 1), b3 + hstep, voffB); PG8_STAGE(PG8_SA(1, 0), a3, voffA);
            PG8_WAIT_V(8); PG8_WAIT_L(0); PG8_BAR; PG8_MMA(1, 0, At, B0); PG8_MMA(1, 1, At, B1); PG8_BAR; PG8_SCHED;
            } else {
            PG8_LDB(B0, 0, 0); PG8_SCHED; PG8_LDA(At, 0, 0); PG8_STAGE(PG8_SA(1, 1), a1 + hstep, voffA);
            PG8_WAIT_L(8); PG8_BAR; PG8_WAIT_L(0); PG8_MMA(0, 0, At, B0); PG8_BAR; PG8_SCHED;
            PG8_LDB(B1, 0, 1); PG8_STAGE(PG8_SB(0, 0), b2, voffB);
            PG8_BAR; PG8_WAIT_L(0); PG8_MMA(0, 1, At, B1); PG8_BAR;
            PG8_LDA(At, 0, 1); PG8_STAGE(PG8_SA(0, 0), a2, voffA);
            PG8_BAR; PG8_WAIT_L(0); PG8_MMA(1, 0, At, B0); PG8_BAR; PG8_SCHED;
            PG8_STAGE(PG8_SB(0, 1), b2 + hstep, voffB);
            PG8_WAIT_V(6); PG8_BAR; PG8_MMA(1, 1, At, B1); PG8_BAR;
            PG8_LDB(B0, 1, 0); PG8_SCHED; PG8_LDA(At, 1, 0); PG8_STAGE(PG8_SA(0, 1), a2 + hstep, voffA);
            PG8_WAIT_L(8); PG8_BAR; PG8_WAIT_L(0); PG8_MMA(0, 0, At, B0); PG8_BAR; PG8_SCHED;
            PG8_LDB(B1, 1, 1); PG8_STAGE(PG8_SB(1, 0), b3, voffB);
            PG8_BAR; PG8_WAIT_L(0); PG8_MMA(0, 1, At, B1); PG8_BAR;
            PG8_LDA(At, 1, 1); PG8_STAGE(PG8_SA(1, 0), a3, voffA);
            PG8_BAR; PG8_WAIT_L(0); PG8_MMA(1, 0, At, B0); PG8_BAR; PG8_SCHED;
            PG8_STAGE(PG8_SB(1, 1), b3 + hstep, voffB);
            PG8_WAIT_V(6); PG8_BAR; PG8_MMA(1, 1, At, B1); PG8_BAR;
            }
        }
        if constexpr (ALIGN_EPI) { if (wr == 0) PG8_BAR; }
        if constexpr (!Epi::AFTER_DRAIN) { E(acc, cur, wr, wc, fr, fq); S.done(cur); }
        if (!has_next) break;
#pragma unroll
        for (int a = 0; a < 2; ++a)
#pragma unroll
            for (int b = 0; b < 2; ++b)
#pragma unroll
                for (int m = 0; m < 4; ++m)
#pragma unroll
                    for (int n = 0; n < 2; ++n) acc[a][b][m][n] = (f32x4){0.f, 0.f, 0.f, 0.f};
        cur = nxt; cA = nA; cB = nB; ++ui;
        if constexpr (ALIGN_EPI) { if (wr == 1) PG8_BAR; }
    }
    PG8_WAIT_V(0);
    if constexpr (!ALIGN_EPI) { if (wr == 0) PG8_BAR; }
    PG8_BAR;
    if constexpr (Epi::AFTER_DRAIN) { E.fused(acc, cur, wr, wc, fr, fq, lds, wid, lane); S.done(cur); }
#undef PG8_SA
#undef PG8_SB
#undef PG8_STAGE
#undef PG8_LDA
#undef PG8_LDB
#undef PG8_MMA
#undef PG8_WAIT_V
#undef PG8_WAIT_L
#undef PG8_BAR
#undef PG8_SCHED
}
}
#define LAS __attribute__((address_space(3)))
namespace att {
typedef unsigned short bf16;
typedef short bf16x8 __attribute__((ext_vector_type(8)));
typedef short s16x4 __attribute__((ext_vector_type(4)));
typedef short v4i16_t __attribute__((ext_vector_type(4)));
typedef float f32x16 __attribute__((ext_vector_type(16)));
typedef unsigned u32x4 __attribute__((ext_vector_type(4)));
typedef float f32x2_t __attribute__((ext_vector_type(2)));
typedef __bf16 bf16x2_t __attribute__((ext_vector_type(2)));
typedef LAS const char* lds_cptr;
constexpr int PITCH = 256;
constexpr long PANEL = 65536L * 256;
__device__ __forceinline__ long pc(int col) { return (long)(col >> 8) * PANEL + (col & 255); }
constexpr int YP = 1024;
__device__ __forceinline__ int fresh_tid() { int t = threadIdx.x; asm volatile("" : "+v"(t)); return t; }
__device__ __forceinline__ int crow(int r, int hi) { return (r & 3) + 8 * (r >> 2) + 4 * hi; }
__device__ __forceinline__ void glds16(const void* gsrc, unsigned lds_dst) { unsigned keep;
  asm volatile("s_mov_b32 %0, m0\n\ts_mov_b32 m0, %2\n\ts_nop 0\n\tglobal_load_lds_dwordx4 %1, off\n\ts_mov_b32 m0, %0" : "=&s"(keep) : "v"(gsrc), "s"(lds_dst) : "memory"); }
__device__ __forceinline__ unsigned cvtpk_s(float lo, float hi) { f32x2_t v = {lo, hi}; bf16x2_t b = __builtin_convertvector(v, bf16x2_t); return __builtin_bit_cast(unsigned, b); }
__device__ __forceinline__ s16x4 vtr(lds_cptr p) { return __builtin_bit_cast(s16x4, __builtin_amdgcn_ds_read_tr16_b64_v4i16((LAS v4i16_t*)p)); }
__device__ __forceinline__ float bf2f(bf16 v) { return __uint_as_float(((unsigned)v) << 16); }
__device__ __forceinline__ bf16 f2bf(float f) { unsigned u = __float_as_uint(f); return (bf16)((u + 0x7fffu + ((u >> 16) & 1u)) >> 16); }
__device__ __forceinline__ float swap_max(float m) { auto rr = __builtin_amdgcn_permlane32_swap(__float_as_uint(m), __float_as_uint(m), false, false); return fmaxf(__uint_as_float(rr[0]), __uint_as_float(rr[1])); }
__device__ __forceinline__ float swap_sum(float m) { auto rr = __builtin_amdgcn_permlane32_swap(__float_as_uint(m), __float_as_uint(m), false, false); return __uint_as_float(rr[0]) + __uint_as_float(rr[1]); }
#define ATT_EXP2(A, B) asm("v_exp_f32_e32 %0, %0\n\tv_exp_f32_e32 %1, %1\n\ts_nop 0" : "+v"(A), "+v"(B))
#define ATT_EXP2_ADD2(A, B, SA, SB, PA, PB) asm("v_exp_f32_e32 %0, %0\n\tv_exp_f32_e32 %1, %1\n\tv_add_f32_e32 %2, %2, %4\n\tv_add_f32_e32 %3, %3, %5" : "+v"(A), "+v"(B), "+v"(SA), "+v"(SB) : "v"(PA), "v"(PB))
#define ATT_ADD2(SA, SB, PA, PB) asm("s_nop 0\n\tv_add_f32_e32 %0, %0, %2\n\tv_add_f32_e32 %1, %1, %3" : "+v"(SA), "+v"(SB) : "v"(PA), "v"(PB))
__device__ __forceinline__ float silu(float g) { return g / (1.f + __expf(-g)); }
#define ATT_WAIT_BAR(N) asm volatile("s_waitcnt vmcnt(" #N ") lgkmcnt(0)\n\ts_barrier" ::: "memory")
#define ATT_PACK(P, B) (u32x4){cvtpk_s(P[B], P[B + 1]), cvtpk_s(P[B + 2], P[B + 3]), cvtpk_s(P[B + 4], P[B + 5]), cvtpk_s(P[B + 6], P[B + 7])}
#define ATT_VFR(lo, hi) (bf16x8){lo[0], lo[1], lo[2], lo[3], hi[0], hi[1], hi[2], hi[3]}

constexpr int D_SLOT = 32768, D_NSLOT = 4, D_WSF = D_SLOT * D_NSLOT;
#define ATT_MX3(a, b, c) __builtin_fmaxf(__builtin_fmaxf((a), (b)), (c))
__device__ __forceinline__ void diff_unit(const bf16* __restrict__ P, bf16* __restrict__ Y, long rowbase, int S, int h, int qt, LAS char* shm, float lam, const float* __restrict__ g_sub) {
  const int tid = fresh_tid(), lane = tid & 63, r32 = lane & 31, hi = lane >> 5; const int wid = __builtin_amdgcn_readfirstlane(tid >> 6);
  const int map = wid >> 2, wq = wid & 3;
  const long qrow0 = rowbase + (long)qt * 128 + wq * 32;
  const bf16* Qw = P + pc(2048 + (2 * h + map) * 64) + qrow0 * PITCH;
  const bf16* Kb = P + pc(2560 + (2 * h + map) * 64) + rowbase * PITCH;
  const bf16* Vb = P + pc(3072 + h * 128) + rowbase * PITCH;
  const unsigned lds0 = (unsigned)(uintptr_t)shm;
  LAS float* wsf = (LAS float*)(shm + D_WSF) + wid * 64;
  const bf16* ksrc0 = Kb + (long)lane * PITCH + (2 * wq) * 8;
  const bf16* ksrc1 = ksrc0 + 8;
  const unsigned kdst0 = map * 8192 + (2 * wq) * 1024, kdst1 = kdst0 + 1024;
  const int vp0 = 2 * wid, vp1 = 2 * wid + 1;
  const bf16* vsrc0 = Vb + (long)(16 * (vp0 & 3) + (lane >> 2)) * PITCH + 32 * (vp0 >> 2) + 8 * (lane & 3);
  const bf16* vsrc1 = Vb + (long)(16 * (vp1 & 3) + (lane >> 2)) * PITCH + 32 * (vp1 >> 2) + 8 * (lane & 3);
  const unsigned vdst0 = 16384 + vp0 * 1024, vdst1 = 16384 + vp1 * 1024;
#define D_DMA(t, slot) do { const long toff_ = (long)(t) * 64 * PITCH; const unsigned sb_ = lds0 + (slot); \
    glds16(ksrc0 + toff_, (unsigned)__builtin_amdgcn_readfirstlane(sb_ + kdst0)); glds16(ksrc1 + toff_, (unsigned)__builtin_amdgcn_readfirstlane(sb_ + kdst1)); \
    glds16(vsrc0 + toff_, (unsigned)__builtin_amdgcn_readfirstlane(sb_ + vdst0)); glds16(vsrc1 + toff_, (unsigned)__builtin_amdgcn_readfirstlane(sb_ + vdst1)); } while (0)
  const int NT = S / 64;
  asm volatile("s_waitcnt vmcnt(0)" ::: "memory");
  bf16x8 qr[4];
#pragma unroll
  for (int d0 = 0; d0 < 4; ++d0) qr[d0] = *reinterpret_cast<const bf16x8*>(&Qw[(long)r32 * PITCH + d0 * 16 + hi * 8]);
  asm volatile("" ::: "memory");
  D_DMA(0, 0); D_DMA(1, D_SLOT); D_DMA(2, 2 * D_SLOT);
  float m = 0.f, l = 0.f;
  f32x16 o[4];
#pragma unroll
  for (int d0 = 0; d0 < 4; ++d0) o[d0] = f32x16{};
  f32x16 negm = f32x16{}; asm volatile("" : "+v"(negm));
  const lds_cptr shm3 = (lds_cptr)shm;
  const lds_cptr kp0 = shm3 + map * 8192 + hi * 1024 + r32 * 16;
  const lds_cptr vp = shm3 + 16384 + ((lane >> 4) & 1) * 32 + (lane & 3) * 8 + (4 * hi + ((lane & 15) >> 2)) * 64;
  bf16x8 pa0, pa1, pa2, pa3;
  pa0 = pa1 = pa2 = pa3 = bf16x8{};
#define D_KLD(SL_) do { const lds_cptr kp = kp0 + (SL_); \
    _Pragma("unroll") for (int d0 = 0; d0 < 4; ++d0) { kf[2 * d0] = *(const LAS bf16x8*)(kp + d0 * 2048); kf[2 * d0 + 1] = *(const LAS bf16x8*)(kp + d0 * 2048 + 512); } } while (0)
#define D_QKSM(T_, SL_) do { \
    f32x16 p0, p1; \
    p0 = __builtin_amdgcn_mfma_f32_32x32x16_bf16(kf[0], qr[0], negm, 0, 0, 0); p1 = __builtin_amdgcn_mfma_f32_32x32x16_bf16(kf[1], qr[0], negm, 0, 0, 0); \
    _Pragma("unroll") for (int d0 = 1; d0 < 4; ++d0) { \
      p0 = __builtin_amdgcn_mfma_f32_32x32x16_bf16(kf[2 * d0], qr[d0], p0, 0, 0, 0); p1 = __builtin_amdgcn_mfma_f32_32x32x16_bf16(kf[2 * d0 + 1], qr[d0], p1, 0, 0, 0); } \
    float ra = ATT_MX3(p0[0], p0[1], p1[0]), rb = ATT_MX3(p0[2], p0[3], p1[1]); ra = ATT_MX3(ra, p1[2], p1[3]); \
    _Pragma("unroll") for (int r = 4; r < 16; r += 4) { ra = ATT_MX3(ra, p0[r], p0[r + 1]); rb = ATT_MX3(rb, p0[r + 2], p0[r + 3]); ra = ATT_MX3(ra, p1[r], p1[r + 1]); rb = ATT_MX3(rb, p1[r + 2], p1[r + 3]); } \
    const float rm = swap_max(fmaxf(ra, rb)); \
    if ((T_) == 0 || __any(rm > 6.f)) { \
      const float dl = ((T_) == 0) ? rm : fmaxf(rm, 0.f); m += dl; \
      _Pragma("unroll") for (int r = 0; r < 16; ++r) { p0[r] -= dl; p1[r] -= dl; } \
      _Pragma("unroll") for (int r = 0; r < 16; ++r) negm[r] = -m; \
      asm volatile("" : "+v"(negm)); \
      const float f = __builtin_amdgcn_exp2f(-dl); l *= f; \
      if (hi == 0) wsf[r32] = f; \
      _Pragma("unroll") for (int r = 0; r < 16; ++r) { const float fr_ = wsf[crow(r, hi)]; \
        _Pragma("unroll") for (int d0 = 0; d0 < 4; ++d0) o[d0][r] *= fr_; } \
    } \
    float sacc = 0.f, sacd = 0.f; \
    ATT_EXP2(p0[0], p1[0]); \
    _Pragma("unroll") for (int r = 1; r < 16; ++r) ATT_EXP2_ADD2(p0[r], p1[r], sacc, sacd, p0[r - 1], p1[r - 1]); \
    ATT_ADD2(sacc, sacd, p0[15], p1[15]); \
    l += sacc + sacd; \
    pa0 = __builtin_bit_cast(bf16x8, ATT_PACK(p0, 0)); pa1 = __builtin_bit_cast(bf16x8, ATT_PACK(p0, 8)); \
    pa2 = __builtin_bit_cast(bf16x8, ATT_PACK(p1, 0)); pa3 = __builtin_bit_cast(bf16x8, ATT_PACK(p1, 8)); } while (0)
#define D_PV(SL_) do { const lds_cptr vq = vp + (SL_); \
    _Pragma("unroll") for (int d0 = 0; d0 < 4; ++d0) { s16x4 lo[4], hh[4]; \
      _Pragma("unroll") for (int ks = 0; ks < 4; ++ks) { lo[ks] = vtr(vq + d0 * 4096 + ks * 1024); hh[ks] = vtr(vq + d0 * 4096 + ks * 1024 + 512); } \
      o[d0] = __builtin_amdgcn_mfma_f32_32x32x16_bf16(pa0, ATT_VFR(lo[0], hh[0]), o[d0], 0, 0, 0); \
      o[d0] = __builtin_amdgcn_mfma_f32_32x32x16_bf16(pa1, ATT_VFR(lo[1], hh[1]), o[d0], 0, 0, 0); \
      o[d0] = __builtin_amdgcn_mfma_f32_32x32x16_bf16(pa2, ATT_VFR(lo[2], hh[2]), o[d0], 0, 0, 0); \
      o[d0] = __builtin_amdgcn_mfma_f32_32x32x16_bf16(pa3, ATT_VFR(lo[3], hh[3]), o[d0], 0, 0, 0); } } while (0)
  ATT_WAIT_BAR(8);
  bf16x8 kf[8];
  if (map == 1) asm volatile("s_barrier" ::: "memory");
  for (int t = 0; t < NT; ++t) {
    const int cur = (t & 3) * D_SLOT;
    D_KLD(cur);
    D_QKSM(t, cur);
    __builtin_amdgcn_sched_barrier(0);
    if (t + 2 < NT) { ATT_WAIT_BAR(4); } else { ATT_WAIT_BAR(0); }
    __builtin_amdgcn_sched_barrier(0);
    if (t + 3 < NT) D_DMA(t + 3, ((t + 3) & 3) * D_SLOT);
    D_PV(cur);
    __builtin_amdgcn_sched_barrier(0);
    asm volatile("s_waitcnt lgkmcnt(0)\n\ts_barrier" ::: "memory");
    __builtin_amdgcn_sched_barrier(0);
  }
  if (map == 0) asm volatile("s_barrier" ::: "memory");
#undef D_DMA
#undef D_KLD
#undef D_QKSM
#undef D_PV
  l = swap_sum(l);
  { const int te = fresh_tid(); const int lane = te & 63, r32 = lane & 31, hi = lane >> 5;
  LAS float* wsf = (LAS float*)(shm + D_WSF) + wid * 64;
  if (hi == 0) wsf[32 + r32] = (map == 1 ? lam : 1.f) / l;
  float inv[16];
#pragma unroll
  for (int r = 0; r < 16; ++r) inv[r] = wsf[32 + crow(r, hi)];
  ATT_WAIT_BAR(0);
  LAS float* X = (LAS float*)shm + wq * 4096;
  if (map == 1) {
#pragma unroll
    for (int d0 = 0; d0 < 4; ++d0)
#pragma unroll
      for (int r = 0; r < 16; ++r) X[(d0 * 16 + r) * 64 + lane] = o[d0][r] * inv[r];
  }
  ATT_WAIT_BAR(0);
  if (map == 0) {
    const bf16* Gw = P + pc(3584 + h * 128) + qrow0 * PITCH;
    bf16* Yw = Y + qrow0 * YP + 512 + h * 128;
    float gs[4];
#pragma unroll
    for (int d0 = 0; d0 < 4; ++d0) gs[d0] = g_sub[d0 * 32 + r32] * 0.8f;
#pragma unroll
    for (int r = 0; r < 16; ++r) {
      float v[4]; float ss = 0.f;
#pragma unroll
      for (int d0 = 0; d0 < 4; ++d0) { v[d0] = o[d0][r] * inv[r] - X[(d0 * 16 + r) * 64 + lane]; ss += v[d0] * v[d0]; }
      ss += __shfl_xor(ss, 1); ss += __shfl_xor(ss, 2); ss += __shfl_xor(ss, 4); ss += __shfl_xor(ss, 8); ss += __shfl_xor(ss, 16);
      const float rstd = rsqrtf(ss * (1.f / 128.f) + 1e-6f);
      const int q = crow(r, hi);
#pragma unroll
      for (int d0 = 0; d0 < 4; ++d0) { const float g = bf2f(Gw[(long)q * PITCH + d0 * 32 + r32]);
        Yw[(long)q * YP + d0 * 32 + r32] = f2bf(v[d0] * rstd * gs[d0] * silu(g)); }
    }
  }
  }
  ATT_WAIT_BAR(0);
}

template <int DIL, int NBLK, int QSTEP>
__device__ __forceinline__ void dil_pattern(const bf16* __restrict__ Kb, const bf16* __restrict__ Vb, int S, int i0, int resid, const bf16x8 (&qr)[4], float& m, float& l, f32x16 (&o)[2],
                                            LAS char* vl, LAS float* wsf, int lane, int r32, int hi) {
  const int L = S / DIL;
  const int qidx = i0 + QSTEP * r32;
  const int lo_q = qidx - 64 < 0 ? 0 : qidx - 64, w_q = (qidx + 64 > L - 1 ? L - 1 : qidx + 64) - lo_q;
  const lds_cptr vq = (lds_cptr)vl + ((lane >> 4) & 1) * 32 + (lane & 3) * 8 + (4 * hi + ((lane & 15) >> 2)) * 64;
  const int lrow = lane >> 3, lch = lane & 7;
  LAS char* kw = vl + 4096 + lch * 512 + ((lrow ^ lch) * 16);
  LAS char* vw = vl + (lch >> 2) * 2048 + (lrow & 7) * 64 + (lch & 3) * 16;
  const lds_cptr kr_ = (lds_cptr)vl + 4096;
  int kb_lo = (64 - i0) >> 5; kb_lo = kb_lo < 0 ? 0 : kb_lo;
  int kb_hi = (L + 64 - i0 + 31) >> 5; kb_hi = kb_hi > NBLK ? NBLK : kb_hi;
  u32x4 kr[4], vr[4];
#define DIL_LOAD(KB_) do { const int kbase_ = i0 - 64 + 32 * (KB_); \
    _Pragma("unroll") for (int i = 0; i < 4; ++i) { int kx_ = kbase_ + 8 * i + lrow; kx_ = kx_ < 0 ? 0 : (kx_ >= L ? L - 1 : kx_); \
      const long ro_ = (long)(resid + DIL * kx_) * PITCH + lch * 8; \
      kr[i] = *reinterpret_cast<const u32x4*>(Kb + ro_); vr[i] = *reinterpret_cast<const u32x4*>(Vb + ro_); } } while (0)
  DIL_LOAD(kb_lo);
  for (int kb = kb_lo; kb < kb_hi; ++kb) {
    const int kbase = i0 - 64 + 32 * kb;
#pragma unroll
    for (int i = 0; i < 4; ++i) { *(LAS u32x4*)(kw + i * 128) = kr[i]; *(LAS u32x4*)(vw + (i >> 1) * 1024 + (i & 1) * 512) = vr[i]; }
    { const int kn = (kb + 1 < kb_hi) ? kb + 1 : kb; DIL_LOAD(kn); }
    f32x16 p0 = f32x16{};
#pragma unroll
    for (int d0 = 0; d0 < 4; ++d0) { const int ch = 2 * d0 + hi;
      const bf16x8 kfr = *(const LAS bf16x8*)(kr_ + ch * 512 + ((r32 ^ ch) * 16));
      p0 = __builtin_amdgcn_mfma_f32_32x32x16_bf16(kfr, qr[d0], p0, 0, 0, 0); }
    float rm = -1e30f;
    { const int a0 = lo_q - kbase;
      if (!__all(a0 <= 0 && a0 + w_q >= 31)) { const int a1 = a0 - 4 * hi;
#pragma unroll
        for (int rr = 0; rr < 16; ++rr) { const bool ok = (unsigned)(((rr & 3) + 8 * (rr >> 2)) - a1) <= (unsigned)w_q; p0[rr] = ok ? p0[rr] : -1e30f; } }
      const float r0 = ATT_MX3(p0[0], p0[1], p0[2]), r1 = ATT_MX3(p0[3], p0[4], p0[5]), r2 = ATT_MX3(p0[6], p0[7], p0[8]), r3 = ATT_MX3(p0[9], p0[10], p0[11]), r4 = ATT_MX3(p0[12], p0[13], p0[14]);
      rm = fmaxf(ATT_MX3(r0, r1, r2), ATT_MX3(r3, r4, p0[15])); }
    rm = swap_max(rm);
    if (__any(rm > m + 6.f)) {
      const float mn = fmaxf(m, rm); const float f = __builtin_amdgcn_exp2f(m - mn); m = mn; l *= f;
      if (hi == 0) wsf[r32] = f;
#pragma unroll
      for (int rr = 0; rr < 16; ++rr) { const float fr_ = wsf[crow(rr, hi)]; o[0][rr] *= fr_; o[1][rr] *= fr_; }
    }
#pragma unroll
    for (int rr = 0; rr < 16; ++rr) p0[rr] -= m;
    { float s0 = 0.f, s1 = 0.f;
      ATT_EXP2(p0[0], p0[1]);
#pragma unroll
      for (int rr = 2; rr < 16; rr += 2) ATT_EXP2_ADD2(p0[rr], p0[rr + 1], s0, s1, p0[rr - 2], p0[rr - 1]);
      ATT_ADD2(s0, s1, p0[14], p0[15]);
      l += s0 + s1; }
    const bf16x8 pa0 = __builtin_bit_cast(bf16x8, ATT_PACK(p0, 0)), pa1 = __builtin_bit_cast(bf16x8, ATT_PACK(p0, 8));
#pragma unroll
    for (int d0 = 0; d0 < 2; ++d0) {
      const s16x4 lo0 = vtr(vq + d0 * 2048), hi0 = vtr(vq + d0 * 2048 + 512), lo1 = vtr(vq + d0 * 2048 + 1024), hi1 = vtr(vq + d0 * 2048 + 1536);
      o[d0] = __builtin_amdgcn_mfma_f32_32x32x16_bf16(pa0, ATT_VFR(lo0, hi0), o[d0], 0, 0, 0);
      o[d0] = __builtin_amdgcn_mfma_f32_32x32x16_bf16(pa1, ATT_VFR(lo1, hi1), o[d0], 0, 0, 0);
    }
  }
#undef DIL_LOAD
}
__device__ __forceinline__ void dil_q(bf16x8 (&qr)[4], const bf16* __restrict__ Qb, long tok, int hi) {
#pragma unroll
  for (int d0 = 0; d0 < 4; ++d0) qr[d0] = *reinterpret_cast<const bf16x8*>(Qb + tok * PITCH + d0 * 16 + hi * 8);
}
__device__ __forceinline__ void dil_item_a(const bf16* __restrict__ P, long rowbase, int S, int h, int c, int r, LAS char* vl, LAS float* wsf, LAS bf16* OA, LAS float* ML, const bf16x8 (&qr)[4]) {
  const int lane = fresh_tid() & 63, r32 = lane & 31, hi = lane >> 5;
  const bf16* Kb = P + pc(512 + h * 64) + rowbase * PITCH; const bf16* Vb = P + pc(1024 + h * 64) + rowbase * PITCH;
  float m = -1e30f, l = 0.f; f32x16 o[2]; o[0] = f32x16{}; o[1] = f32x16{};
  dil_pattern<16, 5, 1>(Kb, Vb, S, 32 * c, r, qr, m, l, o, vl, wsf, lane, r32, hi);
  l = swap_sum(l);
  if (hi == 0) { wsf[32 + r32] = 1.f / l; ML[(r + 16 * r32) * 2] = m; ML[(r + 16 * r32) * 2 + 1] = l; }
#pragma unroll
  for (int rr = 0; rr < 16; ++rr) { const float iv = wsf[32 + crow(rr, hi)]; const int tl = r + 16 * crow(rr, hi);
#pragma unroll
    for (int d0 = 0; d0 < 2; ++d0) OA[tl * 64 + d0 * 32 + r32] = f2bf(o[d0][rr] * iv); }
}
__device__ __forceinline__ void dil_item_m(const bf16* __restrict__ P, long rowbase, int S, int h, int c, int g, LAS char* vl, LAS float* wsf, LAS bf16* OA, LAS float* ML, const bf16x8 (&qr)[4]) {
  const int lane = fresh_tid() & 63, r32 = lane & 31, hi = lane >> 5;
  const int r4 = g & 3, jb = g >> 2;
  const bf16* Kb = P + pc(512 + h * 64) + rowbase * PITCH; const bf16* Vb = P + pc(1024 + h * 64) + rowbase * PITCH;
  const int tl0 = r4 + 128 * jb;
  float m = -1e30f, l = 0.f; f32x16 o[2]; o[0] = f32x16{}; o[1] = f32x16{};
  dil_pattern<4, 5, 1>(Kb, Vb, S, 128 * c + 32 * jb, r4, qr, m, l, o, vl, wsf, lane, r32, hi);
  l = swap_sum(l);
  if (hi == 0) {
    const int tl = tl0 + 4 * r32;
    const float ma = ML[tl * 2], la = ML[tl * 2 + 1];
    const float mm = fmaxf(ma, m), wa = la * __builtin_amdgcn_exp2f(ma - mm), wb = __builtin_amdgcn_exp2f(m - mm);
    const float den = wa + l * wb, rden = 1.f / den;
    wsf[r32] = wa * rden; wsf[32 + r32] = wb * rden; ML[tl * 2] = mm; ML[tl * 2 + 1] = den; }
#pragma unroll
  for (int rr = 0; rr < 16; ++rr) { const int q = crow(rr, hi); const float fa = wsf[q], fb = wsf[32 + q]; const int tl = tl0 + 4 * q;
#pragma unroll
    for (int d0 = 0; d0 < 2; ++d0) { const float oa = bf2f(OA[tl * 64 + d0 * 32 + r32]); OA[tl * 64 + d0 * 32 + r32] = f2bf(oa * fa + o[d0][rr] * fb); } }
}
__device__ __forceinline__ void dil_item_b(const bf16* __restrict__ P, bf16* __restrict__ Y, long rowbase, int S, int h, int c, int j, LAS char* vl, LAS float* wsf, const LAS bf16* OA, const LAS float* ML, const bf16x8 (&qr)[4]) {
  const int lane = fresh_tid() & 63, r32 = lane & 31, hi = lane >> 5;
  const bf16* Kb = P + pc(512 + h * 64) + rowbase * PITCH; const bf16* Vb = P + pc(1024 + h * 64) + rowbase * PITCH; const bf16* Gb = P + pc(1536 + h * 64) + rowbase * PITCH;
  const int tq0 = 512 * c + 32 * j;
  float m = -1e30f, l = 0.f; f32x16 o[2]; o[0] = f32x16{}; o[1] = f32x16{};
  dil_pattern<1, 5, 1>(Kb, Vb, S, tq0, 0, qr, m, l, o, vl, wsf, lane, r32, hi);
  l = swap_sum(l);
  if (hi == 0) {
    const float ma = ML[(32 * j + r32) * 2], la = ML[(32 * j + r32) * 2 + 1];
    const float mm = fmaxf(ma, m), wa = la * __builtin_amdgcn_exp2f(ma - mm), wb = __builtin_amdgcn_exp2f(m - mm);
    const float rden = 1.f / (wa + l * wb);
    wsf[r32] = wa * rden; wsf[32 + r32] = wb * rden; }
  bf16* Yb = Y + rowbase * YP + h * 64;
#pragma unroll
  for (int rr = 0; rr < 16; ++rr) { const int q = crow(rr, hi); const float fa = wsf[q], fb = wsf[32 + q]; const long tok = tq0 + q;
#pragma unroll
    for (int d0 = 0; d0 < 2; ++d0) { const float g = bf2f(Gb[tok * PITCH + d0 * 32 + r32]); const float oa = bf2f(OA[(32 * j + q) * 64 + d0 * 32 + r32]);
      Yb[tok * YP + d0 * 32 + r32] = f2bf((oa * fa + o[d0][rr] * fb) * silu(g)); } }
}
}
typedef unsigned short bf16;
typedef float f32x4g __attribute__((ext_vector_type(4)));
typedef unsigned v4u __attribute__((ext_vector_type(4)));
constexpr int NTOK = 65536, DMODEL = 1024, DPROJ = 4096, NBATCH = 20, NPROMPT_ROWS = 32768;
constexpr size_t MiB = 1u << 20;
constexpr size_t WS_PROJ = 0, WS_Y = 0, WS_SSQ = 128 * MiB, WS_GATE = 132 * MiB, WS_NEED = 512 * MiB;
constexpr size_t DO_H = 0, DO_WIN = 128 * MiB, DO_WOUT = 136 * MiB, DO_MOD = 138 * MiB, DO_ROPE = 139 * MiB, DO_MISC = 140 * MiB;
constexpr size_t DO_BAR = 141 * MiB;
constexpr int LDS_XB = 147392;
constexpr int LDS_BYTES = 147456;
#define XB_TMO      128
#define XB_XCNT(j)  (256  + 64 * (j))
#define XB_XSUB(j)  (1280 + 64 * (j))
#define XB_XGEN(j)  (2304 + 64 * (j))
#define XB_TOP      3328
#define XB_TOPGEN   3392
#define XCD_BAR_WORDS 3456
#define XB_SPIN_CAP (1u << 18)

__device__ __forceinline__ unsigned xb_ld(unsigned* p)              { return __hip_atomic_load(p, __ATOMIC_RELAXED, __HIP_MEMORY_SCOPE_AGENT); }
__device__ __forceinline__ unsigned xb_add(unsigned* p, unsigned v) { return __hip_atomic_fetch_add(p, v, __ATOMIC_RELAXED, __HIP_MEMORY_SCOPE_AGENT); }
__device__ __forceinline__ unsigned xb_xcc_id() { return (unsigned)__builtin_amdgcn_s_getreg((3 << 11) | 20) & 0xFu; }
#define XB_SPIN(cond, bar) do { unsigned _sp = 0; while (cond) { __builtin_amdgcn_s_sleep(1); \
    if ((++_sp & 255u) == 0u) { if (xb_ld(&(bar)[XB_TMO])) break; if (_sp > XB_SPIN_CAP) { atomicAdd(&(bar)[XB_TMO], 1u); break; } } } } while (0)

struct XcdBarrier {
    unsigned* bar; unsigned x;
    volatile LAS unsigned* st;
};

__device__ __forceinline__ XcdBarrier xcd_barrier_post(unsigned* bar, volatile LAS unsigned* st) {
    XcdBarrier b; b.bar = bar; b.x = xb_xcc_id(); b.st = st;
    if (threadIdx.x == 0) (void)xb_add(&bar[XB_XCNT(b.x)], 1u);
    return b;
}
__device__ __forceinline__ void xcd_barrier_complete(unsigned* bar, unsigned x, unsigned& nloc, unsigned& nx) {
    const unsigned G = gridDim.x * gridDim.y * gridDim.z;
    unsigned sum, cnt, mine, sp = 0u;
    for (;;) {
        sum = 0u; cnt = 0u; mine = 0u;
#pragma unroll
        for (unsigned j = 0; j < 16; ++j) { const unsigned c = xb_ld(&bar[XB_XCNT(j)]); sum += c; cnt += (c > 0u) ? 1u : 0u; mine = (j == x) ? c : mine; }
        if (sum == G) break;
        __builtin_amdgcn_s_sleep(1);
        if ((++sp & 255u) == 0u) { if (xb_ld(&bar[XB_TMO])) break; if (sp > XB_SPIN_CAP) { atomicAdd(&bar[XB_TMO], 1u); break; } }
    }
    nloc = mine > 0u ? mine : 1u; nx = cnt > 0u ? cnt : 1u;
}

__device__ __forceinline__ void xcd_barrier(const XcdBarrier& b) {
    asm volatile("s_waitcnt vmcnt(0)" ::: "memory");
    __syncthreads();
    if (threadIdx.x == 0) {
        unsigned* bar = b.bar;
        __builtin_amdgcn_s_waitcnt(0);
        unsigned nloc = b.st[0], nx = b.st[1];
        if (nloc == 0u) { xcd_barrier_complete(bar, b.x, nloc, nx); b.st[0] = nloc; b.st[1] = nx; }
        const unsigned old = xb_add(&bar[XB_XSUB(b.x)], 1u);
        const unsigned gen = old / nloc;
        if (old + 1u == (gen + 1u) * nloc) {
            __builtin_amdgcn_fence(__ATOMIC_RELEASE, "agent");
            asm volatile("s_waitcnt vmcnt(0)" ::: "memory");
            const unsigned og = xb_add(&bar[XB_TOP], 1u);
            const unsigned tg = og / nx;
            if (og + 1u == (tg + 1u) * nx) xb_add(&bar[XB_TOPGEN], 1u);
            else XB_SPIN(xb_ld(&bar[XB_TOPGEN]) == tg, bar);
            __builtin_amdgcn_fence(__ATOMIC_ACQUIRE, "agent");
            xb_add(&bar[XB_XGEN(b.x)], 1u);
            asm volatile("s_waitcnt vmcnt(0)" ::: "memory");
        } else {
            XB_SPIN(xb_ld(&bar[XB_XGEN(b.x)]) == gen, bar);
            __builtin_amdgcn_fence(__ATOMIC_ACQUIRE, "agent");
            asm volatile("s_waitcnt vmcnt(0)" ::: "memory");
        }
    }
    __syncthreads();
}

struct Params { const float* in[15]; float* out; unsigned char* ws; int mask; int pad; };

__device__ __forceinline__ unsigned f2bf_u(float f) { unsigned u = __builtin_bit_cast(unsigned, f); return (u + 0x7fffu + ((u >> 16) & 1u)) >> 16; }
__device__ __forceinline__ unsigned pk2(float lo, float hi) { return f2bf_u(lo) | (f2bf_u(hi) << 16); }
__device__ __forceinline__ float wave_sum(float v) {
#pragma unroll
    for (int o = 1; o < 64; o <<= 1) v += __shfl_xor(v, o);
    return v;
}
__device__ __forceinline__ void transpose_item(const float* W, int K, int N, bf16* WT, LAS float* scr, int item, int lane) {
    const int nblk = N / 32, kb = item / nblk, nb = item % nblk, k0 = 64 * kb, n0 = 32 * nb;
#pragma unroll 8
    for (int i = 0; i < 32; ++i) { const int kk = 2 * i + (lane >> 5); scr[kk * 33 + (lane & 31)] = W[(size_t)(k0 + kk) * N + n0 + (lane & 31)]; }
    asm volatile("s_waitcnt lgkmcnt(0)" ::: "memory");
    const int c = lane & 7;
#pragma unroll
    for (int j = 0; j < 4; ++j) { const int n = (lane >> 3) + 8 * j; const LAS float* s = scr + (8 * c) * 33 + n;
        v4u o; o.x = pk2(s[0 * 33], s[1 * 33]); o.y = pk2(s[2 * 33], s[3 * 33]); o.z = pk2(s[4 * 33], s[5 * 33]); o.w = pk2(s[6 * 33], s[7 * 33]);
        *(v4u*)(WT + (size_t)(n0 + n) * K + k0 + 8 * c) = o; }
    asm volatile("s_waitcnt lgkmcnt(0)" ::: "memory");
}
__device__ __forceinline__ const float* xrow_ptr(const Params& p, int row) { return row < NPROMPT_ROWS ? p.in[0] + (size_t)row * DMODEL : p.in[1] + (size_t)(row - NPROMPT_ROWS) * DMODEL; }
__device__ __forceinline__ int row_batch(int row) { return row < NPROMPT_ROWS ? (row >> 13) : 4 + ((row - NPROMPT_ROWS) >> 11); }

__global__ void __launch_bounds__(512, 2) mega_fwd(Params p) {
    extern __shared__ __attribute__((aligned(16))) unsigned char lds_raw[];
    LAS unsigned char* lds = (LAS unsigned char*)lds_raw;
    cg::grid_group grid = cg::this_grid();
    const int tid = threadIdx.x, lane = tid & 63, wave = __builtin_amdgcn_readfirstlane(tid >> 6);
    const int G = gridDim.x, bx = blockIdx.x;
    const int vcu = (G % 8 == 0) ? (bx % 8) * (G / 8) + bx / 8 : bx;
    unsigned char* dob = (unsigned char*)p.out;
    bf16* H = (bf16*)(dob + DO_H); bf16* WIN = (bf16*)(dob + DO_WIN); bf16* WOUT = (bf16*)(dob + DO_WOUT);
    float* MOD = (float*)(dob + DO_MOD); float* ROPE = (float*)(dob + DO_ROPE); float* MISC = (float*)(dob + DO_MISC);
    bf16* PROJ = (bf16*)(p.ws + WS_PROJ); bf16* YB = (bf16*)(p.ws + WS_Y); float* SSQ = (float*)(p.ws + WS_SSQ); float* GATE = (float*)(p.ws + WS_GATE);
    const int gw = vcu * 8 + wave, NGW = G * 8;
    { unsigned* bw = (unsigned*)(dob + DO_BAR); for (int i = bx * 512 + tid; i < XCD_BAR_WORDS; i += G * 512) bw[i] = 0u; }
    if (tid < 2) ((volatile LAS unsigned*)(lds + LDS_XB))[tid] = 0u;

    asm volatile(".p2align 8\n\t.rept " PAD_STR(PAD_P0A) "\n\ts_nop 0\n\t.endr");
    if (p.mask & 1) {
        for (int e = bx * 512 + tid; e < 8192 * 8; e += G * 512) {
            const int pos = e >> 3, i = e & 7;
            const float inv = exp2f(-(float)i * (1.0f / 8.0f) * 18.931568569324174f);
            const float ang = (float)pos * inv;
            const double ad = (double)ang; const double n = rint(ad * 0.15915494309189535); const float red = (float)(ad - n * 6.283185307179586);
            ROPE[2 * e] = cosf(red); ROPE[2 * e + 1] = sinf(red);
        }
        __syncthreads();
        if (bx < 192) {
            LAS float* sc = (LAS float*)lds;
            LAS float* red = (LAS float*)(lds + 81920);
            { float cvv[NBATCH * 2];
#pragma unroll
              for (int q = 0; q < NBATCH * 2; ++q) { const int i = tid + 512 * q; const int b = i >> 10, k = i & 1023; cvv[q] = b < 4 ? p.in[2][b * DMODEL + k] : p.in[3][(b - 4) * DMODEL + k]; }
#pragma unroll
              for (int q = 0; q < NBATCH * 2; ++q) sc[tid + 512 * q] = cvv[q] / (1.f + __expf(-cvv[q])); }
            __syncthreads();
            const int col = tid & 15, ks = tid >> 4, j = bx * 16 + col;
            float acc[NBATCH];
#pragma unroll
            for (int b = 0; b < NBATCH; ++b) acc[b] = 0.f;
            float wv[32];
#pragma unroll
            for (int i = 0; i < 32; ++i) wv[i] = p.in[8][(size_t)(ks + 32 * i) * 3072 + j];
#pragma unroll
            for (int i = 0; i < 32; ++i) {
#pragma unroll
                for (int b = 0; b < NBATCH; ++b) acc[b] += sc[b * DMODEL + ks + 32 * i] * wv[i]; }
#pragma unroll
            for (int b = 0; b < NBATCH; ++b) red[(ks * NBATCH + b) * 16 + col] = acc[b];
            __syncthreads();
            if (tid < NBATCH * 16) { const int b = tid >> 4, cc = tid & 15; float s = 0.f;
                for (int k2 = 0; k2 < 32; ++k2) s += red[(k2 * NBATCH + b) * 16 + cc];
                MOD[b * 3072 + bx * 16 + cc] = s + p.in[9][bx * 16 + cc]; }
        }
        if (bx == G - 1 && wave == 0) {
            const float a = wave_sum(p.in[10][lane] * p.in[11][lane]), b2 = wave_sum(p.in[12][lane] * p.in[13][lane]);
            if (lane == 0) MISC[0] = expf(a) - expf(b2) + 0.2f;
        }
    }
    asm volatile("s_waitcnt vmcnt(0)\n\ts_nop 0" ::: "memory");
    grid.sync();
    const XcdBarrier xbar = xcd_barrier_post((unsigned*)(dob + DO_BAR), (volatile LAS unsigned*)(lds + LDS_XB));
    asm volatile(".p2align 8\n\t.rept " PAD_STR(PAD_P0B) "\n\ts_nop 0\n\t.endr");
    if (p.mask & 2) { const int lane = att::fresh_tid() & 63;
    f32x4g gpre[4];
#pragma unroll
    for (int j = 0; j < 4; ++j) gpre[j] = ((const f32x4g*)p.in[6])[lane + 64 * j];
    for (int rb = gw; rb < NTOK; rb += 4 * NGW) {
        f32x4g v[4][4];
#pragma unroll
        for (int q = 0; q < 4; ++q) { const int row = rb + q * NGW; if (row < NTOK) { const f32x4g* xr = (const f32x4g*)xrow_ptr(p, row) + lane;
#pragma unroll
            for (int j = 0; j < 4; ++j) v[q][j] = __builtin_nontemporal_load(&xr[64 * j]); } }
#pragma unroll
        for (int q = 0; q < 4; ++q) { const int row = rb + q * NGW; if (row < NTOK) {
            const int b = row_batch(row); float s = 0.f;
#pragma unroll
            for (int j = 0; j < 4; ++j) s += (v[q][j].x * v[q][j].x + v[q][j].y * v[q][j].y) + (v[q][j].z * v[q][j].z + v[q][j].w * v[q][j].w);
            const float rstd = rsqrtf(wave_sum(s) * (1.f / DMODEL) + 1e-6f);
            unsigned long long* o8 = (unsigned long long*)(H + (size_t)row * DMODEL) + lane;
#pragma unroll
            for (int j = 0; j < 4; ++j) {
                const f32x4g sh = ((const f32x4g*)(MOD + b * 3072))[lane + 64 * j], sl = ((const f32x4g*)(MOD + b * 3072 + 1024))[lane + 64 * j];
                const f32x4g hv = v[q][j] * rstd * gpre[j] * (sl + 1.f) + sh;
                o8[64 * j] = (unsigned long long)pk2(hv.x, hv.y) | ((unsigned long long)pk2(hv.z, hv.w) << 32);
            } } }
    }
    {
        LAS float* scr = (LAS float*)(lds + wave * 16384);
        constexpr int I_IN = (DMODEL / 64) * (DPROJ / 32), I_OUT = (DMODEL / 64) * (DMODEL / 32);
        for (int it = gw; it < I_IN + I_OUT; it += NGW) {
            if (it < I_IN) transpose_item(p.in[4], DMODEL, DPROJ, WIN, scr, it, lane);
            else transpose_item(p.in[5], DMODEL, DMODEL, WOUT, scr, it - I_IN, lane);
        }
    } }
    xcd_barrier(xbar);
#ifndef NO_P1
    asm volatile(".p2align 8\n\t.rept " PAD_STR(PAD_P1) "\n\ts_nop 0\n\t.endr");
    if (p.mask & 4) {
        pg8::Gemm g{H, WIN, NTOK, DPROJ, DMODEL}; pg8::StaticOrder S; S.init(NTOK, DPROJ, G, bx);
        pg8::EpiProj E{PROJ, 256, ROPE};
        pg8::gemm_phase<pg8::EpiProj, pg8::StaticOrder, true, true>(lds, g, S, E);
    }
#endif
    xcd_barrier(xbar);
    {
        bf16* YM = H;
        const float lam = MISC[0];
#ifndef NO_DIFF
    asm volatile(".p2align 8\n\t.rept " PAD_STR(PAD_DIFF) "\n\ts_nop 0\n\t.endr");
        if (p.mask & 8)
        for (int u = vcu; u < 2048; u += G) {
            int bh, qt, S; long rowbase;
            if (u < 1024) { bh = (u & 255) >> 4; qt = (u & 15) * 4 + (u >> 8); S = 8192; rowbase = (long)(bh >> 2) * 8192; }
            else { const int u2 = u - 1024; bh = (u2 & 255) >> 2; qt = (u2 & 3) * 4 + (u2 >> 8); S = 2048; rowbase = NPROMPT_ROWS + (long)(bh >> 2) * 2048; }
            att::diff_unit(PROJ, YM, rowbase, S, bh & 3, qt, (LAS char*)lds, lam, p.in[14]);
        }
#endif
#ifndef NO_DIL
        LAS char* vl = (LAS char*)lds + wave * 8448; LAS float* wsf = (LAS float*)(lds + wave * 8448 + 8192);
        LAS att::bf16* OA = (LAS att::bf16*)(lds + 67584); LAS float* ML = (LAS float*)(lds + 67584 + 65536);
    asm volatile(".p2align 8\n\t.rept " PAD_STR(PAD_DIL) "\n\ts_nop 0\n\t.endr");
        if (p.mask & 16)
        for (int u = vcu; u < 1024; u += G) {
            int b, h, c, S; long rowbase;
            if (u < 512) { const int id = (u & 255) * 2 + (u >> 8); c = id & 15; h = (id >> 4) & 7; b = id >> 7; S = 8192; rowbase = (long)b * 8192; }
            else { const int u2 = u - 512; const int id = (u2 & 255) * 2 + (u2 >> 8); c = id & 3; h = (id >> 2) & 7; b = id >> 5; S = 2048; rowbase = NPROMPT_ROWS + (long)b * 2048; }
            {
                const int ln = att::fresh_tid() & 63, r32 = ln & 31, hi = ln >> 5;
                const att::bf16* Qb = PROJ + att::pc(h * 64) + rowbase * att::PITCH;
                const long t0 = 512L * c;
                att::bf16x8 q0[4], q1[4];
                att::dil_q(q0, Qb, t0 + wave + 16 * r32, hi); att::dil_q(q1, Qb, t0 + wave + 8 + 16 * r32, hi);
                att::dil_item_a(PROJ, rowbase, S, h, c, wave, vl, wsf, OA, ML, q0);
                att::dil_item_a(PROJ, rowbase, S, h, c, wave + 8, vl, wsf, OA, ML, q1);
                { const int g0 = wave, g1 = wave + 8;
                  att::dil_q(q0, Qb, t0 + (g0 & 3) + 128 * (g0 >> 2) + 4 * r32, hi); att::dil_q(q1, Qb, t0 + (g1 & 3) + 128 * (g1 >> 2) + 4 * r32, hi); }
                __syncthreads();
                att::dil_item_m(PROJ, rowbase, S, h, c, wave, vl, wsf, OA, ML, q0);
                att::dil_item_m(PROJ, rowbase, S, h, c, wave + 8, vl, wsf, OA, ML, q1);
                att::dil_q(q0, Qb, t0 + 32 * wave + r32, hi); att::dil_q(q1, Qb, t0 + 32 * (wave + 8) + r32, hi);
                __syncthreads();
                att::dil_item_b(PROJ, YM, rowbase, S, h, c, wave, vl, wsf, OA, ML, q0);
                att::dil_item_b(PROJ, YM, rowbase, S, h, c, wave + 8, vl, wsf, OA, ML, q1);
            }
            __syncthreads();
        }
#endif
    }
    xcd_barrier(xbar);
    asm volatile(".p2align 8\n\t.rept " PAD_STR(PAD_P3) "\n\ts_nop 0\n\t.endr");
    if (p.mask & 32) {
        for (int i = bx * 512 + tid; i < NBATCH * DMODEL; i += G * 512) GATE[i] = MOD[(i >> 10) * 3072 + 2048 + (i & 1023)];
#ifndef NO_P3
        pg8::Gemm g{H, WOUT, NTOK, DMODEL, DMODEL}; pg8::StaticOrder S; S.init(NTOK, DMODEL, G, bx);
        pg8::EpiY E{YB, DMODEL, SSQ};
        pg8::gemm_phase<pg8::EpiY, pg8::StaticOrder, true, true>(lds, g, S, E);
#endif
    }
    asm volatile("s_waitcnt vmcnt(0)\n\ts_nop 0" ::: "memory");
    grid.sync();
    asm volatile(".p2align 8\n\t.rept " PAD_STR(PAD_P4) "\n\ts_nop 0\n\t.endr");
    if (p.mask & 64) { const int lane = att::fresh_tid() & 63;
    f32x4g gpo[4];
#pragma unroll
    for (int j = 0; j < 4; ++j) gpo[j] = ((const f32x4g*)p.in[7])[lane + 64 * j];
    for (int rb = gw; rb < NTOK; rb += 2 * NGW) {
        f32x4g xv[2][4]; unsigned long long yv[2][4]; float sq[2];
#pragma unroll
        for (int q = 0; q < 2; ++q) { const int row = rb + q * NGW; if (row < NTOK) { const f32x4g* xr = (const f32x4g*)xrow_ptr(p, row) + lane;
            const unsigned long long* y8 = (const unsigned long long*)(YB + (size_t)row * DMODEL) + lane;
            sq[q] = lane < 16 ? SSQ[(size_t)row * 16 + lane] : 0.f;
#pragma unroll
            for (int j = 0; j < 4; ++j) { xv[q][j] = __builtin_nontemporal_load(&xr[64 * j]); yv[q][j] = __builtin_nontemporal_load(&y8[64 * j]); } } }
#pragma unroll
        for (int q = 0; q < 2; ++q) { const int row = rb + q * NGW; if (row < NTOK) {
            const int b = row_batch(row);
            const float rstd = rsqrtf(wave_sum(sq[q]) * (1.f / DMODEL) + 1e-6f);
            f32x4g* orow = (f32x4g*)(p.out + (size_t)row * DMODEL) + lane;
#pragma unroll
            for (int j = 0; j < 4; ++j) {
                const unsigned long long w = yv[q][j];
                f32x4g y; y.x = __uint_as_float(((unsigned)w) << 16); y.y = __uint_as_float(((unsigned)w) & 0xffff0000u);
                y.z = __uint_as_float(((unsigned)(w >> 32)) << 16); y.w = __uint_as_float(((unsigned)(w >> 32)) & 0xffff0000u);
                const f32x4g gt = ((const f32x4g*)(GATE + b * DMODEL))[lane + 64 * j];
                __builtin_nontemporal_store(xv[q][j] + gt * (y * rstd) * gpo[j], &orow[64 * j]);
            } } }
    } }
}

extern "C" void kernel_launch(void* const* d_in, const int* in_sizes, int n_in, void* d_out, int out_size, void* d_ws, size_t ws_size, hipStream_t stream) {
    static int grid = 0;
    if (grid == 0) {
        if (n_in != 15 || ws_size < WS_NEED || out_size != NTOK * DMODEL) { fprintf(stderr, "kernel_launch: unexpected shapes (n_in %d, ws %zu, out %d)\n", n_in, ws_size, out_size); grid = -1; return; }
        int dev = 0, cus = 0, per_cu = 0;
        hipGetDevice(&dev); hipDeviceGetAttribute(&cus, hipDeviceAttributeMultiprocessorCount, dev);
        hipFuncSetAttribute((const void*)mega_fwd, hipFuncAttributeMaxDynamicSharedMemorySize, LDS_BYTES);
        hipOccupancyMaxActiveBlocksPerMultiprocessor(&per_cu, (const void*)mega_fwd, 512, LDS_BYTES);
        (void)hipGetLastError();
        if (per_cu < 1) per_cu = 1;
        grid = cus;
    }
    if (grid < 0) return;
    Params p{};
    for (int i = 0; i < 15; ++i) p.in[i] = (const float*)d_in[i];
    p.out = (float*)d_out; p.ws = (unsigned char*)d_ws; p.mask = 127;
#ifdef PROBE_MASK
    { Params p2 = p; p2.mask = PROBE_MASK; void* args2[] = {&p2}; (void)hipLaunchCooperativeKernel((const void*)mega_fwd, dim3(grid), dim3(512), args2, LDS_BYTES, stream); }
#endif
    void* args[] = {&p};
    hipError_t e = hipLaunchCooperativeKernel((const void*)mega_fwd, dim3(grid), dim3(512), args, LDS_BYTES, stream);
    if (e != hipSuccess) fprintf(stderr, "cooperative launch failed: %s (grid %d)\n", hipGetErrorString(e), grid);
}
```

```cpp
#include <hip/hip_runtime.h>
#include <hip/hip_cooperative_groups.h>
#include <cstdio>
#include <cstdint>
namespace cg = cooperative_groups;
#define PAD_STR2(x) #x
#define PAD_STR(x) PAD_STR2(x)
#define PAD_P0A 0
#define PAD_P0B 0
#define PAD_P1 0
#define PAD_DIFF 0
#define PAD_DIL 0
#define PAD_P3 0
#define PAD_P4 0
constexpr float QK_C2 = 0.125f * 1.4426950408889634f;
namespace pg8 {
#define PG8_LAS __attribute__((address_space(3)))
typedef unsigned short bf16_t;
typedef short bf16x8 __attribute__((ext_vector_type(8)));
typedef float f32x4 __attribute__((ext_vector_type(4)));
typedef unsigned u32x4 __attribute__((ext_vector_type(4)));
constexpr int BM = 256, BK = 64, HALF = 128, HTB = HALF * BK * 2  , STAGE_BYTES = 8 * HTB, NXCD = 8, WGM = 8;

__host__ __device__ __forceinline__ int lds_byte(int r, int c) { const int st = (r >> 4) * 2 + (c >> 5), rr = r & 15, cc = c & 31, ob = rr * 64 + cc * 2; return st * 1024 + (ob ^ (((ob >> 9) & 1) << 5)); }
__host__ __device__ __forceinline__ void stage_rc(int b, int& R, int& C) { const int st = b / 1024, sb = b % 1024, swz = sb ^ (((sb >> 9) & 1) << 5); R = (st >> 1) * 16 + swz / 64; C = (st & 1) * 32 + (swz % 64) / 2; }
__host__ __device__ __forceinline__ int perm32(int rho) { const int n = rho >> 4, i = rho & 15; return 8 * (i >> 2) + 4 * n + (i & 3); }

struct Unit { int pm, pn; };
struct Gemm { const bf16_t* A; const bf16_t* Bt; int M, N, K; };

struct StaticOrder {
    int nM, nN, nwg, G, c;
    __host__ __device__ void init(int M, int N, int G_, int c_) { nM = M / BM; nN = N / BM; nwg = nM * nN; G = G_; c = c_; }
    __host__ __device__ bool next(int i, Unit& u) const {
        const long L = (long)i * G + c; if (L >= nwg) return false;
        int wgid = (int)L; { const int q = nwg / NXCD, r = nwg % NXCD, xcd = wgid % NXCD, off = wgid / NXCD; wgid = (xcd < r ? xcd * (q + 1) : r * (q + 1) + (xcd - r) * q) + off; }
        const int nig = WGM * nN, gid = wgid / nig, fm = gid * WGM, gsz = (nM - fm) < WGM ? (nM - fm) : WGM;
        u.pm = fm + ((wgid % nig) % gsz); u.pn = (wgid % nig) / gsz; return true;
    }
    __device__ __forceinline__ void a_ready(const Unit&) const {}
    __device__ __forceinline__ void done(const Unit&) const {}
};

__device__ __forceinline__ unsigned cvt_pk_bf16(float lo, float hi) { unsigned r; asm volatile("v_cvt_pk_bf16_f32 %0, %1, %2" : "=v"(r) : "v"(lo), "v"(hi)); return r; }
struct EpiProj {
    static constexpr bool PERM = true, AFTER_DRAIN = false;
    bf16_t* O; int ldc; const float* rope;
    __device__ __forceinline__ void operator()(const f32x4 (&acc)[2][2][4][2], const Unit& u, int wr, int wc, int fr, int fq) const {
        const int row0 = u.pm * BM + wr * 64 + fr;
        const bool tile_rope = (u.pn & 4) == 0;
        const bool lane_rope = tile_rope && ((wc & 1) == 0) && (fq < 2);
        const float sc = ((u.pn & 6) == 0) ? QK_C2 : 1.f;
        const float sgn = (fq == 0) ? -1.f : 1.f;
        const int col0 = wc * 32 + 8 * fq;
        bf16_t* const Op = O + (size_t)u.pn * ((size_t)65536 * 256);
#pragma unroll
        for (int ai = 0; ai < 2; ++ai)
#pragma unroll
            for (int m = 0; m < 4; ++m) {
                const int row = row0 + ai * HALF + m * 16;
                const int pos = row < 32768 ? (row & 8191) : (row & 2047);
                f32x4 cs[4];
                if (tile_rope) {
#pragma unroll
                    for (int q = 0; q < 4; ++q) cs[q] = *(const f32x4*)(rope + (size_t)pos * 16 + q * 4);
                }
                bf16_t* rowp = Op + (size_t)row * ldc + col0;
#pragma unroll
                for (int bj = 0; bj < 2; ++bj) {
                    f32x4 v0 = acc[ai][bj][m][0], v1 = acc[ai][bj][m][1];
                    if (tile_rope) {
                        f32x4 p0, p1;
#pragma unroll
                        for (int j = 0; j < 4; ++j) { p0[j] = __shfl_xor(v0[j], 16); p1[j] = __shfl_xor(v1[j], 16); }
                        if (lane_rope) {
                            v0[0] = v0[0] * cs[0][0] + sgn * p0[0] * cs[0][1]; v0[1] = v0[1] * cs[0][2] + sgn * p0[1] * cs[0][3];
                            v0[2] = v0[2] * cs[1][0] + sgn * p0[2] * cs[1][1]; v0[3] = v0[3] * cs[1][2] + sgn * p0[3] * cs[1][3];
                            v1[0] = v1[0] * cs[2][0] + sgn * p1[0] * cs[2][1]; v1[1] = v1[1] * cs[2][2] + sgn * p1[1] * cs[2][3];
                            v1[2] = v1[2] * cs[3][0] + sgn * p1[2] * cs[3][1]; v1[3] = v1[3] * cs[3][2] + sgn * p1[3] * cs[3][3];
                        }
                    }
                    v0 = v0 * sc; v1 = v1 * sc;
                    u32x4 w; w.x = cvt_pk_bf16(v0[0], v0[1]); w.y = cvt_pk_bf16(v0[2], v0[3]); w.z = cvt_pk_bf16(v1[0], v1[1]); w.w = cvt_pk_bf16(v1[2], v1[3]);
                    __builtin_nontemporal_store(w, (u32x4*)(rowp + bj * HALF));
                }
            }
    }
};
struct EpiY {
    static constexpr bool PERM = true, AFTER_DRAIN = false;
    bf16_t* O; int ldc; float* ssq;
    __device__ __forceinline__ void operator()(const f32x4 (&acc)[2][2][4][2], const Unit& u, int wr, int wc, int fr, int fq) const {
        const int row0 = u.pm * BM + wr * 64 + fr;
        const int col0 = u.pn * BM + wc * 32 + 8 * fq;
#pragma unroll
        for (int ai = 0; ai < 2; ++ai)
#pragma unroll
            for (int m = 0; m < 4; ++m) {
                const int row = row0 + ai * HALF + m * 16;
                bf16_t* rowp = O + (size_t)row * ldc + col0;
                float s = 0.f;
#pragma unroll
                for (int bj = 0; bj < 2; ++bj) {
                    const f32x4 v0 = acc[ai][bj][m][0], v1 = acc[ai][bj][m][1];
                    s += (v0[0] * v0[0] + v0[1] * v0[1]) + (v0[2] * v0[2] + v0[3] * v0[3]) + (v1[0] * v1[0] + v1[1] * v1[1]) + (v1[2] * v1[2] + v1[3] * v1[3]);
                    u32x4 w; w.x = cvt_pk_bf16(v0[0], v0[1]); w.y = cvt_pk_bf16(v0[2], v0[3]); w.z = cvt_pk_bf16(v1[0], v1[1]); w.w = cvt_pk_bf16(v1[2], v1[3]);
                    *(u32x4*)(rowp + bj * HALF) = w;
                }
                s += __shfl_xor(s, 16); s += __shfl_xor(s, 32);
                if (fq == 0) ssq[(size_t)row * 16 + u.pn * 4 + wc] = s;
            }
    }
};
template <class Epi, class Sched, bool ALIGN_EPI = false, bool SP2 = false>
__device__ __forceinline__ void gemm_phase(PG8_LAS unsigned char* lds, const Gemm g, const Sched& S, const Epi& E) {
    const int tid = threadIdx.x, wid = __builtin_amdgcn_readfirstlane(tid >> 6), lane = tid & 63, wr = wid >> 2, wc = wid & 3, fr = lane & 15, fq = lane >> 4;
    const int K = g.K, nt = K / BK;
    unsigned voffA[2], voffB[2];
#pragma unroll
    for (int i = 0; i < 2; ++i) { int R, C; stage_rc(tid * 16 + i * 8192, R, C); const int Rb = Epi::PERM ? ((R & ~31) + perm32(R & 31)) : R;
        voffA[i] = (unsigned)(R * K + C) * 2u; voffB[i] = (unsigned)(Rb * K + C) * 2u; }
    const size_t kstep = (size_t)(BK * 2);
    const size_t hstep = (size_t)HALF * K * 2;
    const size_t tstep = 2 * hstep;
    const unsigned ldsw = (unsigned)wid * 1024u;
    const int aoff = lds_byte(wr * 64 + fr, fq * 8), boff = lds_byte(wc * 32 + fr, fq * 8);
#define PG8_SA(b, h) (((b) * 2 + (h)) * HTB)
#define PG8_SB(b, h) ((4 + (b) * 2 + (h)) * HTB)
#define PG8_STAGE(bufoff, gbase, voff) do { _Pragma("unroll") for (int _i = 0; _i < 2; ++_i) \
        __builtin_amdgcn_global_load_lds((const unsigned*)((const char*)(gbase) + (voff)[_i]), (PG8_LAS unsigned*)(lds + (bufoff) + ldsw + _i * 8192), 16, 0, 0); } while (0)
#define PG8_LDA(dst, b, h) do { _Pragma("unroll") for (int m = 0; m < 4; ++m) _Pragma("unroll") for (int k = 0; k < 2; ++k) dst[m][k] = *(const PG8_LAS bf16x8*)(lds + PG8_SA(b, h) + aoff + m * 2048 + k * 1024); } while (0)
#define PG8_LDB(dst, b, h) do { _Pragma("unroll") for (int n = 0; n < 2; ++n) _Pragma("unroll") for (int k = 0; k < 2; ++k) dst[n][k] = *(const PG8_LAS bf16x8*)(lds + PG8_SB(b, h) + boff + n * 2048 + k * 1024); } while (0)
#define PG8_MMA(ai, bj, At, Bt) do { __builtin_amdgcn_s_setprio(1); _Pragma("unroll") for (int m = 0; m < 4; ++m) _Pragma("unroll") for (int n = 0; n < 2; ++n) _Pragma("unroll") for (int k = 0; k < 2; ++k) \
        acc[ai][bj][m][n] = __builtin_amdgcn_mfma_f32_16x16x32_bf16(Bt[n][k], At[m][k], acc[ai][bj][m][n], 0, 0, 0); __builtin_amdgcn_s_setprio(0); } while (0)
#define PG8_WAIT_V(n) asm volatile("s_waitcnt vmcnt(" #n ")" ::: "memory")
#define PG8_WAIT_L(n) asm volatile("s_waitcnt lgkmcnt(" #n ")" ::: "memory")
#define PG8_BAR __builtin_amdgcn_s_barrier()
#define PG8_SCHED __builtin_amdgcn_sched_barrier(0)
    Unit cur, nxt; int ui = 0;
    if (!S.next(0, cur)) return;
    f32x4 acc[2][2][4][2];
#pragma unroll
    for (int a = 0; a < 2; ++a)
#pragma unroll
        for (int b = 0; b < 2; ++b)
#pragma unroll
            for (int m = 0; m < 4; ++m)
#pragma unroll
                for (int n = 0; n < 2; ++n) acc[a][b][m][n] = (f32x4){0.f, 0.f, 0.f, 0.f};
    bf16x8 At[4][2], B0[2][2], B1[2][2];
    const char* cA = (const char*)g.A + (size_t)cur.pm * tstep; const char* cB = (const char*)g.Bt + (size_t)cur.pn * tstep;
    S.a_ready(cur);
    if constexpr (SP2) {
        PG8_STAGE(PG8_SB(0, 0), cB, voffB); PG8_STAGE(PG8_SB(0, 1), cB + hstep, voffB); PG8_STAGE(PG8_SA(0, 0), cA, voffA); PG8_STAGE(PG8_SA(0, 1), cA + hstep, voffA);
        if (wr == 1) PG8_BAR;
        PG8_WAIT_V(2); PG8_BAR;
        PG8_STAGE(PG8_SB(1, 0), cB + kstep, voffB); PG8_STAGE(PG8_SA(1, 0), cA + kstep, voffA); PG8_STAGE(PG8_SB(1, 1), cB + hstep + kstep, voffB);
        PG8_WAIT_V(6); PG8_BAR;
    } else {
        PG8_STAGE(PG8_SB(0, 0), cB, voffB); PG8_STAGE(PG8_SA(0, 0), cA, voffA); PG8_STAGE(PG8_SB(0, 1), cB + hstep, voffB); PG8_STAGE(PG8_SA(0, 1), cA + hstep, voffA);
        if (wr == 1) PG8_BAR;
        PG8_WAIT_V(4); PG8_BAR;
        PG8_STAGE(PG8_SB(1, 0), cB + kstep, voffB); PG8_STAGE(PG8_SA(1, 0), cA + kstep, voffA); PG8_STAGE(PG8_SB(1, 1), cB + hstep + kstep, voffB);
        PG8_WAIT_V(6); PG8_BAR;
    }
    for (;;) {
        const bool has_next = S.next(ui + 1, nxt);
        const char* nA = has_next ? (const char*)g.A + (size_t)nxt.pm * tstep : cA; const char* nB = has_next ? (const char*)g.Bt + (size_t)nxt.pn * tstep : cB;
        for (int t = 0; t < nt; t += 2) {
            const bool last = (t == nt - 2);
            const char* a1 = cA + (size_t)(t + 1) * kstep;
            const char* a2 = last ? nA : cA + (size_t)(t + 2) * kstep; const char* b2 = last ? nB : cB + (size_t)(t + 2) * kstep;
            const char* a3 = a2 + kstep; const char* b3 = b2 + kstep;
            if (last && has_next) S.a_ready(nxt);
            if constexpr (SP2) {
            PG8_LDB(B0, 0, 0); PG8_LDB(B1, 0, 1); PG8_SCHED; PG8_LDA(At, 0, 0); PG8_STAGE(PG8_SA(1, 1), a1 + hstep, voffA);
            PG8_WAIT_V(8); PG8_WAIT_L(0); PG8_BAR; PG8_MMA(0, 0, At, B0); PG8_MMA(0, 1, At, B1); PG8_BAR; PG8_SCHED;
            PG8_LDA(At, 0, 1); PG8_STAGE(PG8_SB(0, 0), b2, voffB); PG8_STAGE(PG8_SB(0, 1), b2 + hstep, voffB); PG8_STAGE(PG8_SA(0, 0), a2, voffA);
            PG8_WAIT_V(8); PG8_WAIT_L(0); PG8_BAR; PG8_MMA(1, 0, At, B0); PG8_MMA(1, 1, At, B1); PG8_BAR; PG8_SCHED;
            PG8_LDB(B0, 1, 0); PG8_LDB(B1, 1, 1); PG8_SCHED; PG8_LDA(At, 1, 0); PG8_STAGE(PG8_SA(0, 1), a2 + hstep, voffA);
            PG8_WAIT_V(8); PG8_WAIT_L(0); PG8_BAR; PG8_MMA(0, 0, At, B0); PG8_MMA(0, 1, At, B1); PG8_BAR; PG8_SCHED;
            PG8_LDA(At, 1, 1); PG8_STAGE(PG8_SB(1, 0), b3, voffB); PG8_STAGE(PG8_SB(1, 1), b3 + hstep, voffB); PG8_STAGE(PG8_SA(1, 0), a3, voffA);
            PG8_WAIT_V(8); PG8_WAIT_L(0); PG8_BAR; PG8_MMA(1, 0, At, B0); PG8_MMA(1, 1, At, B1); PG8_BAR; PG8_SCHED;
            } else {
            PG8_LDB(B0, 0, 0); PG8_SCHED; PG8_LDA(At, 0, 0); PG8_STAGE(PG8_SA(1, 1), a1 + hstep, voffA);
            PG8_WAIT_L(8); PG8_BAR; PG8_WAIT_L(0); PG8_MMA(0, 0, At, B0); PG8_BAR; PG8_SCHED;
            PG8_LDB(B1, 0, 1); PG8_STAGE(PG8_SB(0, 0), b2, voffB);
            PG8_BAR; PG8_WAIT_L(0); PG8_MMA(0, 1, At, B1); PG8_BAR;
            PG8_LDA(At, 0, 1); PG8_STAGE(PG8_SA(0, 0), a2, voffA);
            PG8_BAR; PG8_WAIT_L(0); PG8_MMA(1, 0, At, B0); PG8_BAR; PG8_SCHED;
            PG8_STAGE(PG8_SB(0, 1), b2 + hstep, voffB);
            PG8_WAIT_V(6); PG8_BAR; PG8_MMA(1, 1, At, B1); PG8_BAR;
            PG8_LDB(B0, 1, 0); PG8_SCHED; PG8_LDA(At, 1, 0); PG8_STAGE(PG8_SA(0, 1), a2 + hstep, voffA);
            PG8_WAIT_L(8); PG8_BAR; PG8_WAIT_L(0); PG8_MMA(0, 0, At, B0); PG8_BAR; PG8_SCHED;
            PG8_LDB(B1, 1, 1); PG8_STAGE(PG8_SB(1, 0), b3, voffB);
            PG8_BAR; PG8_WAIT_L(0); PG8_MMA(0, 1, At, B1); PG8_BAR;
            PG8_LDA(At, 1, 1); PG8_STAGE(PG8_SA(1, 0), a3, voffA);
            PG8_BAR; PG8_WAIT_L(0); PG8_MMA(1, 0, At, B0); PG8_BAR; PG8_SCHED;
            PG8_STAGE(PG8_SB(1, 1), b3 + hstep, voffB);
            PG8_WAIT_V(6); PG8_BAR; PG8_MMA(1, 1, At, B1); PG8_BAR;
            }
        }
        if constexpr (ALIGN_EPI) { if (wr == 0) PG8_BAR; }
        if constexpr (!Epi::AFTER_DRAIN) { E(acc, cur, wr, wc, fr, fq); S.done(cur); }
        if (!has_next) break;
#pragma unroll
        for (int a = 0; a < 2; ++a)
#pragma unroll
            for (int b = 0; b < 2; ++b)
#pragma unroll
                for (int m = 0; m < 4; ++m)
#pragma unroll
                    for (int n = 0; n < 2; ++n) acc[a][b][m][n] = (f32x4){0.f, 0.f, 0.f, 0.f};
        cur = nxt; cA = nA; cB = nB; ++ui;
        if constexpr (ALIGN_EPI) { if (wr == 1) PG8_BAR; }
    }
    PG8_WAIT_V(0);
    if constexpr (!ALIGN_EPI) { if (wr == 0) PG8_BAR; }
    PG8_BAR;
    if constexpr (Epi::AFTER_DRAIN) { E.fused(acc, cur, wr, wc, fr, fq, lds, wid, lane); S.done(cur); }
#undef PG8_SA
#undef PG8_SB
#undef PG8_STAGE
#undef PG8_LDA
#undef PG8_LDB
#undef PG8_MMA
#undef PG8_WAIT_V
#undef PG8_WAIT_L
#undef PG8_BAR
#undef PG8_SCHED
}
}
#define LAS __attribute__((address_space(3)))
namespace att {
typedef unsigned short bf16;
typedef short bf16x8 __attribute__((ext_vector_type(8)));
typedef short s16x4 __attribute__((ext_vector_type(4)));
typedef short v4i16_t __attribute__((ext_vector_type(4)));
typedef float f32x16 __attribute__((ext_vector_type(16)));
typedef unsigned u32x4 __attribute__((ext_vector_type(4)));
typedef float f32x2_t __attribute__((ext_vector_type(2)));
typedef __bf16 bf16x2_t __attribute__((ext_vector_type(2)));
typedef LAS const char* lds_cptr;
constexpr int PITCH = 256;
constexpr long PANEL = 65536L * 256;
__device__ __forceinline__ long pc(int col) { return (long)(col >> 8) * PANEL + (col & 255); }
constexpr int YP = 1024;
__device__ __forceinline__ int fresh_tid() { int t = threadIdx.x; asm volatile("" : "+v"(t)); return t; }
__device__ __forceinline__ int crow(int r, int hi) { return (r & 3) + 8 * (r >> 2) + 4 * hi; }
__device__ __forceinline__ void glds16(const void* gsrc, unsigned lds_dst) { unsigned keep;
  asm volatile("s_mov_b32 %0, m0\n\ts_mov_b32 m0, %2\n\ts_nop 0\n\tglobal_load_lds_dwordx4 %1, off\n\ts_mov_b32 m0, %0" : "=&s"(keep) : "v"(gsrc), "s"(lds_dst) : "memory"); }
__device__ __forceinline__ unsigned cvtpk_s(float lo, float hi) { f32x2_t v = {lo, hi}; bf16x2_t b = __builtin_convertvector(v, bf16x2_t); return __builtin_bit_cast(unsigned, b); }
__device__ __forceinline__ s16x4 vtr(lds_cptr p) { return __builtin_bit_cast(s16x4, __builtin_amdgcn_ds_read_tr16_b64_v4i16((LAS v4i16_t*)p)); }
__device__ __forceinline__ float bf2f(bf16 v) { return __uint_as_float(((unsigned)v) << 16); }
__device__ __forceinline__ bf16 f2bf(float f) { unsigned u = __float_as_uint(f); return (bf16)((u + 0x7fffu + ((u >> 16) & 1u)) >> 16); }
__device__ __forceinline__ float swap_max(float m) { auto rr = __builtin_amdgcn_permlane32_swap(__float_as_uint(m), __float_as_uint(m), false, false); return fmaxf(__uint_as_float(rr[0]), __uint_as_float(rr[1])); }
__device__ __forceinline__ float swap_sum(float m) { auto rr = __builtin_amdgcn_permlane32_swap(__float_as_uint(m), __float_as_uint(m), false, false); return __uint_as_float(rr[0]) + __uint_as_float(rr[1]); }
#define ATT_EXP2(A, B) asm("v_exp_f32_e32 %0, %0\n\tv_exp_f32_e32 %1, %1\n\ts_nop 0" : "+v"(A), "+v"(B))
#define ATT_EXP2_ADD2(A, B, SA, SB, PA, PB) asm("v_exp_f32_e32 %0, %0\n\tv_exp_f32_e32 %1, %1\n\tv_add_f32_e32 %2, %2, %4\n\tv_add_f32_e32 %3, %3, %5" : "+v"(A), "+v"(B), "+v"(SA), "+v"(SB) : "v"(PA), "v"(PB))
#define ATT_ADD2(SA, SB, PA, PB) asm("s_nop 0\n\tv_add_f32_e32 %0, %0, %2\n\tv_add_f32_e32 %1, %1, %3" : "+v"(SA), "+v"(SB) : "v"(PA), "v"(PB))
__device__ __forceinline__ float silu(float g) { return g / (1.f + __expf(-g)); }
#define ATT_WAIT_BAR(N) asm volatile("s_waitcnt vmcnt(" #N ") lgkmcnt(0)\n\ts_barrier" ::: "memory")
#define ATT_PACK(P, B) (u32x4){cvtpk_s(P[B], P[B + 1]), cvtpk_s(P[B + 2], P[B + 3]), cvtpk_s(P[B + 4], P[B + 5]), cvtpk_s(P[B + 6], P[B + 7])}
#define ATT_VFR(lo, hi) (bf16x8){lo[0], lo[1], lo[2], lo[3], hi[0], hi[1], hi[2], hi[3]}

constexpr int D_SLOT = 32768, D_NSLOT = 4, D_WSF = D_SLOT * D_NSLOT;
#define ATT_MX3(a, b, c) __builtin_fmaxf(__builtin_fmaxf((a), (b)), (c))
__device__ __forceinline__ void diff_unit(const bf16* __restrict__ P, bf16* __restrict__ Y, long rowbase, int S, int h, int qt, LAS char* shm, float lam, const float* __restrict__ g_sub) {
  const int tid = fresh_tid(), lane = tid & 63, r32 = lane & 31, hi = lane >> 5; const int wid = __builtin_amdgcn_readfirstlane(tid >> 6);
  const int map = wid >> 2, wq = wid & 3;
  const long qrow0 = rowbase + (long)qt * 128 + wq * 32;
  const bf16* Qw = P + pc(2048 + (2 * h + map) * 64) + qrow0 * PITCH;
  const bf16* Kb = P + pc(2560 + (2 * h + map) * 64) + rowbase * PITCH;
  const bf16* Vb = P + pc(3072 + h * 128) + rowbase * PITCH;
  const unsigned lds0 = (unsigned)(uintptr_t)shm;
  LAS float* wsf = (LAS float*)(shm + D_WSF) + wid * 64;
  const bf16* ksrc0 = Kb + (long)lane * PITCH + (2 * wq) * 8;
  const bf16* ksrc1 = ksrc0 + 8;
  const unsigned kdst0 = map * 8192 + (2 * wq) * 1024, kdst1 = kdst0 + 1024;
  const int vp0 = 2 * wid, vp1 = 2 * wid + 1;
  const bf16* vsrc0 = Vb + (long)(16 * (vp0 & 3) + (lane >> 2)) * PITCH + 32 * (vp0 >> 2) + 8 * (lane & 3);
  const bf16* vsrc1 = Vb + (long)(16 * (vp1 & 3) + (lane >> 2)) * PITCH + 32 * (vp1 >> 2) + 8 * (lane & 3);
  const unsigned vdst0 = 16384 + vp0 * 1024, vdst1 = 16384 + vp1 * 1024;
#define D_DMA(t, slot) do { const long toff_ = (long)(t) * 64 * PITCH; const unsigned sb_ = lds0 + (slot); \
    glds16(ksrc0 + toff_, (unsigned)__builtin_amdgcn_readfirstlane(sb_ + kdst0)); glds16(ksrc1 + toff_, (unsigned)__builtin_amdgcn_readfirstlane(sb_ + kdst1)); \
    glds16(vsrc0 + toff_, (unsigned)__builtin_amdgcn_readfirstlane(sb_ + vdst0)); glds16(vsrc1 + toff_, (unsigned)__builtin_amdgcn_readfirstlane(sb_ + vdst1)); } while (0)
  const int NT = S / 64;
  asm volatile("s_waitcnt vmcnt(0)" ::: "memory");
  bf16x8 qr[4];
#pragma unroll
  for (int d0 = 0; d0 < 4; ++d0) qr[d0] = *reinterpret_cast<const bf16x8*>(&Qw[(long)r32 * PITCH + d0 * 16 + hi * 8]);
  asm volatile("" ::: "memory");
  D_DMA(0, 0); D_DMA(1, D_SLOT); D_DMA(2, 2 * D_SLOT);
  float m = 0.f, l = 0.f;
  f32x16 o[4];
#pragma unroll
  for (int d0 = 0; d0 < 4; ++d0) o[d0] = f32x16{};
  f32x16 negm = f32x16{}; asm volatile("" : "+v"(negm));
  const lds_cptr shm3 = (lds_cptr)shm;
  const lds_cptr kp0 = shm3 + map * 8192 + hi * 1024 + r32 * 16;
  const lds_cptr vp = shm3 + 16384 + ((lane >> 4) & 1) * 32 + (lane & 3) * 8 + (4 * hi + ((lane & 15) >> 2)) * 64;
  bf16x8 pa0, pa1, pa2, pa3;
  pa0 = pa1 = pa2 = pa3 = bf16x8{};
#define D_KLD(SL_) do { const lds_cptr kp = kp0 + (SL_); \
    _Pragma("unroll") for (int d0 = 0; d0 < 4; ++d0) { kf[2 * d0] = *(const LAS bf16x8*)(kp + d0 * 2048); kf[2 * d0 + 1] = *(const LAS bf16x8*)(kp + d0 * 2048 + 512); } } while (0)
#define D_QKSM(T_, SL_) do { \
    f32x16 p0, p1; \
    p0 = __builtin_amdgcn_mfma_f32_32x32x16_bf16(kf[0], qr[0], negm, 0, 0, 0); p1 = __builtin_amdgcn_mfma_f32_32x32x16_bf16(kf[1], qr[0], negm, 0, 0, 0); \
    _Pragma("unroll") for (int d0 = 1; d0 < 4; ++d0) { \
      p0 = __builtin_amdgcn_mfma_f32_32x32x16_bf16(kf[2 * d0], qr[d0], p0, 0, 0, 0); p1 = __builtin_amdgcn_mfma_f32_32x32x16_bf16(kf[2 * d0 + 1], qr[d0], p1, 0, 0, 0); } \
    float ra = ATT_MX3(p0[0], p0[1], p1[0]), rb = ATT_MX3(p0[2], p0[3], p1[1]); ra = ATT_MX3(ra, p1[2], p1[3]); \
    _Pragma("unroll") for (int r = 4; r < 16; r += 4) { ra = ATT_MX3(ra, p0[r], p0[r + 1]); rb = ATT_MX3(rb, p0[r + 2], p0[r + 3]); ra = ATT_MX3(ra, p1[r], p1[r + 1]); rb = ATT_MX3(rb, p1[r + 2], p1[r + 3]); } \
    const float rm = swap_max(fmaxf(ra, rb)); \
    if ((T_) == 0 || __any(rm > 6.f)) { \
      const float dl = ((T_) == 0) ? rm : fmaxf(rm, 0.f); m += dl; \
      _Pragma("unroll") for (int r = 0; r < 16; ++r) { p0[r] -= dl; p1[r] -= dl; } \
      _Pragma("unroll") for (int r = 0; r < 16; ++r) negm[r] = -m; \
      asm volatile("" : "+v"(negm)); \
      const float f = __builtin_amdgcn_exp2f(-dl); l *= f; \
      if (hi == 0) wsf[r32] = f; \
      _Pragma("unroll") for (int r = 0; r < 16; ++r) { const float fr_ = wsf[crow(r, hi)]; \
        _Pragma("unroll") for (int d0 = 0; d0 < 4; ++d0) o[d0][r] *= fr_; } \
    } \
    float sacc = 0.f, sacd = 0.f; \
    ATT_EXP2(p0[0], p1[0]); \
    _Pragma("unroll") for (int r = 1; r < 16; ++r) ATT_EXP2_ADD2(p0[r], p1[r], sacc, sacd, p0[r - 1], p1[r - 1]); \
    ATT_ADD2(sacc, sacd, p0[15], p1[15]); \
    l += sacc + sacd; \
    pa0 = __builtin_bit_cast(bf16x8, ATT_PACK(p0, 0)); pa1 = __builtin_bit_cast(bf16x8, ATT_PACK(p0, 8)); \
    pa2 = __builtin_bit_cast(bf16x8, ATT_PACK(p1, 0)); pa3 = __builtin_bit_cast(bf16x8, ATT_PACK(p1, 8)); } while (0)
#define D_PV(SL_) do { const lds_cptr vq = vp + (SL_); \
    _Pragma("unroll") for (int d0 = 0; d0 < 4; ++d0) { s16x4 lo[4], hh[4]; \
      _Pragma("unroll") for (int ks = 0; ks < 4; ++ks) { lo[ks] = vtr(vq + d0 * 4096 + ks * 1024); hh[ks] = vtr(vq + d0 * 4096 + ks * 1024 + 512); } \
      o[d0] = __builtin_amdgcn_mfma_f32_32x32x16_bf16(pa0, ATT_VFR(lo[0], hh[0]), o[d0], 0, 0, 0); \
      o[d0] = __builtin_amdgcn_mfma_f32_32x32x16_bf16(pa1, ATT_VFR(lo[1], hh[1]), o[d0], 0, 0, 0); \
      o[d0] = __builtin_amdgcn_mfma_f32_32x32x16_bf16(pa2, ATT_VFR(lo[2], hh[2]), o[d0], 0, 0, 0); \
      o[d0] = __builtin_amdgcn_mfma_f32_32x32x16_bf16(pa3, ATT_VFR(lo[3], hh[3]), o[d0], 0, 0, 0); } } while (0)
  ATT_WAIT_BAR(8);
  bf16x8 kf[8];
  if (map == 1) asm volatile("s_barrier" ::: "memory");
  for (int t = 0; t < NT; ++t) {
    const int cur = (t & 3) * D_SLOT;
    D_KLD(cur);
    D_QKSM(t, cur);
    __builtin_amdgcn_sched_barrier(0);
    if (t + 2 < NT) { ATT_WAIT_BAR(4); } else { ATT_WAIT_BAR(0); }
    __builtin_amdgcn_sched_barrier(0);
    if (t + 3 < NT) D_DMA(t + 3, ((t + 3) & 3) * D_SLOT);
    D_PV(cur);
    __builtin_amdgcn_sched_barrier(0);
    asm volatile("s_waitcnt lgkmcnt(0)\n\ts_barrier" ::: "memory");
    __builtin_amdgcn_sched_barrier(0);
  }
  if (map == 0) asm volatile("s_barrier" ::: "memory");
#undef D_DMA
#undef D_KLD
#undef D_QKSM
#undef D_PV
  l = swap_sum(l);
  { const int te = fresh_tid(); const int lane = te & 63, r32 = lane & 31, hi = lane >> 5;
  LAS float* wsf = (LAS float*)(shm + D_WSF) + wid * 64;
  if (hi == 0) wsf[32 + r32] = (map == 1 ? lam : 1.f) / l;
  float inv[16];
#pragma unroll
  for (int r = 0; r < 16; ++r) inv[r] = wsf[32 + crow(r, hi)];
  ATT_WAIT_BAR(0);
  LAS float* X = (LAS float*)shm + wq * 4096;
  if (map == 1) {
#pragma unroll
    for (int d0 = 0; d0 < 4; ++d0)
#pragma unroll
      for (int r = 0; r < 16; ++r) X[(d0 * 16 + r) * 64 + lane] = o[d0][r] * inv[r];
  }
  ATT_WAIT_BAR(0);
  if (map == 0) {
    const bf16* Gw = P + pc(3584 + h * 128) + qrow0 * PITCH;
    bf16* Yw = Y + qrow0 * YP + 512 + h * 128;
    float gs[4];
#pragma unroll
    for (int d0 = 0; d0 < 4; ++d0) gs[d0] = g_sub[d0 * 32 + r32] * 0.8f;
#pragma unroll
    for (int r = 0; r < 16; ++r) {
      float v[4]; float ss = 0.f;
#pragma unroll
      for (int d0 = 0; d0 < 4; ++d0) { v[d0] = o[d0][r] * inv[r] - X[(d0 * 16 + r) * 64 + lane]; ss += v[d0] * v[d0]; }
      ss += __shfl_xor(ss, 1); ss += __shfl_xor(ss, 2); ss += __shfl_xor(ss, 4); ss += __shfl_xor(ss, 8); ss += __shfl_xor(ss, 16);
      const float rstd = rsqrtf(ss * (1.f / 128.f) + 1e-6f);
      const int q = crow(r, hi);
#pragma unroll
      for (int d0 = 0; d0 < 4; ++d0) { const float g = bf2f(Gw[(long)q * PITCH + d0 * 32 + r32]);
        Yw[(long)q * YP + d0 * 32 + r32] = f2bf(v[d0] * rstd * gs[d0] * silu(g)); }
    }
  }
  }
  ATT_WAIT_BAR(0);
}

template <int DIL, int NBLK, int QSTEP>
__device__ __forceinline__ void dil_pattern(const bf16* __restrict__ Kb, const bf16* __restrict__ Vb, int S, int i0, int resid, const bf16x8 (&qr)[4], float& m, float& l, f32x16 (&o)[2],
                                            LAS char* vl, LAS float* wsf, int lane, int r32, int hi) {
  const int L = S / DIL;
  const int qidx = i0 + QSTEP * r32;
  const int lo_q = qidx - 64 < 0 ? 0 : qidx - 64, w_q = (qidx + 64 > L - 1 ? L - 1 : qidx + 64) - lo_q;
  const lds_cptr vq = (lds_cptr)vl + ((lane >> 4) & 1) * 32 + (lane & 3) * 8 + (4 * hi + ((lane & 15) >> 2)) * 64;
  const int lrow = lane >> 3, lch = lane & 7;
  LAS char* kw = vl + 4096 + lch * 512 + ((lrow ^ lch) * 16);
  LAS char* vw = vl + (lch >> 2) * 2048 + (lrow & 7) * 64 + (lch & 3) * 16;
  const lds_cptr kr_ = (lds_cptr)vl + 4096;
  int kb_lo = (64 - i0) >> 5; kb_lo = kb_lo < 0 ? 0 : kb_lo;
  int kb_hi = (L + 64 - i0 + 31) >> 5; kb_hi = kb_hi > NBLK ? NBLK : kb_hi;
  u32x4 kr[4], vr[4];
  f32x16 negm;
#pragma unroll
  for (int rr = 0; rr < 16; ++rr) negm[rr] = -m;
  asm volatile("" : "+v"(negm));
#define DIL_LOAD(KB_) do { const int kbase_ = i0 - 64 + 32 * (KB_); \
    _Pragma("unroll") for (int i = 0; i < 4; ++i) { int kx_ = kbase_ + 8 * i + lrow; kx_ = kx_ < 0 ? 0 : (kx_ >= L ? L - 1 : kx_); \
      const long ro_ = (long)(resid + DIL * kx_) * PITCH + lch * 8; \
      kr[i] = *reinterpret_cast<const u32x4*>(Kb + ro_); vr[i] = *reinterpret_cast<const u32x4*>(Vb + ro_); } } while (0)
  DIL_LOAD(kb_lo);
  for (int kb = kb_lo; kb < kb_hi; ++kb) {
    const int kbase = i0 - 64 + 32 * kb;
#pragma unroll
    for (int i = 0; i < 4; ++i) { *(LAS u32x4*)(kw + i * 128) = kr[i]; *(LAS u32x4*)(vw + (i >> 1) * 1024 + (i & 1) * 512) = vr[i]; }
    { const int kn = (kb + 1 < kb_hi) ? kb + 1 : kb; DIL_LOAD(kn); }
    f32x16 p0;
#pragma unroll
    for (int d0 = 0; d0 < 4; ++d0) { const int ch = 2 * d0 + hi;
      const bf16x8 kfr = *(const LAS bf16x8*)(kr_ + ch * 512 + ((r32 ^ ch) * 16));
      p0 = __builtin_amdgcn_mfma_f32_32x32x16_bf16(kfr, qr[d0], d0 == 0 ? negm : p0, 0, 0, 0); }
    float rm = -1e30f;
    { const int a0 = lo_q - kbase;
      if (!__all(a0 <= 0 && a0 + w_q >= 31)) { const int a1 = a0 - 4 * hi;
#pragma unroll
        for (int rr = 0; rr < 16; ++rr) { const bool ok = (unsigned)(((rr & 3) + 8 * (rr >> 2)) - a1) <= (unsigned)w_q; p0[rr] = ok ? p0[rr] : -1e30f; } }
      const float r0 = ATT_MX3(p0[0], p0[1], p0[2]), r1 = ATT_MX3(p0[3], p0[4], p0[5]), r2 = ATT_MX3(p0[6], p0[7], p0[8]), r3 = ATT_MX3(p0[9], p0[10], p0[11]), r4 = ATT_MX3(p0[12], p0[13], p0[14]);
      rm = fmaxf(ATT_MX3(r0, r1, r2), ATT_MX3(r3, r4, p0[15])); }
    rm = swap_max(rm);
    const bool first = (kb == kb_lo);
    if (first || __any(rm > 6.f)) {
      const float dl = first ? rm : fmaxf(rm, 0.f); m += dl;
#pragma unroll
      for (int rr = 0; rr < 16; ++rr) p0[rr] -= dl;
#pragma unroll
      for (int rr = 0; rr < 16; ++rr) negm[rr] = -m;
      asm volatile("" : "+v"(negm));
      if (!first) {
        const float f = __builtin_amdgcn_exp2f(-dl); l *= f;
        if (hi == 0) wsf[r32] = f;
#pragma unroll
        for (int rr = 0; rr < 16; ++rr) { const float fr_ = wsf[crow(rr, hi)]; o[0][rr] *= fr_; o[1][rr] *= fr_; }
      }
    }
    { float s0 = 0.f, s1 = 0.f;
      ATT_EXP2(p0[0], p0[1]);
#pragma unroll
      for (int rr = 2; rr < 16; rr += 2) ATT_EXP2_ADD2(p0[rr], p0[rr + 1], s0, s1, p0[rr - 2], p0[rr - 1]);
      ATT_ADD2(s0, s1, p0[14], p0[15]);
      l += s0 + s1; }
    const bf16x8 pa0 = __builtin_bit_cast(bf16x8, ATT_PACK(p0, 0)), pa1 = __builtin_bit_cast(bf16x8, ATT_PACK(p0, 8));
#pragma unroll
    for (int d0 = 0; d0 < 2; ++d0) {
      const s16x4 lo0 = vtr(vq + d0 * 2048), hi0 = vtr(vq + d0 * 2048 + 512), lo1 = vtr(vq + d0 * 2048 + 1024), hi1 = vtr(vq + d0 * 2048 + 1536);
      o[d0] = __builtin_amdgcn_mfma_f32_32x32x16_bf16(pa0, ATT_VFR(lo0, hi0), o[d0], 0, 0, 0);
      o[d0] = __builtin_amdgcn_mfma_f32_32x32x16_bf16(pa1, ATT_VFR(lo1, hi1), o[d0], 0, 0, 0);
    }
  }
#undef DIL_LOAD
}
__device__ __forceinline__ void dil_q(bf16x8 (&qr)[4], const bf16* __restrict__ Qb, long tok, int hi) {
#pragma unroll
  for (int d0 = 0; d0 < 4; ++d0) qr[d0] = *reinterpret_cast<const bf16x8*>(Qb + tok * PITCH + d0 * 16 + hi * 8);
}
__device__ __forceinline__ void dil_item_a(const bf16* __restrict__ P, long rowbase, int S, int h, int c, int r, LAS char* vl, LAS float* wsf, LAS bf16* OA, LAS float* ML, const bf16x8 (&qr)[4]) {
  const int lane = fresh_tid() & 63, r32 = lane & 31, hi = lane >> 5;
  const bf16* Kb = P + pc(512 + h * 64) + rowbase * PITCH; const bf16* Vb = P + pc(1024 + h * 64) + rowbase * PITCH;
  float m = 0.f, l = 0.f; f32x16 o[2]; o[0] = f32x16{}; o[1] = f32x16{};
  dil_pattern<16, 5, 1>(Kb, Vb, S, 32 * c, r, qr, m, l, o, vl, wsf, lane, r32, hi);
  l = swap_sum(l);
  if (hi == 0) { wsf[32 + r32] = 1.f / l; ML[(r + 16 * r32) * 2] = m; ML[(r + 16 * r32) * 2 + 1] = l; }
#pragma unroll
  for (int rr = 0; rr < 16; ++rr) { const float iv = wsf[32 + crow(rr, hi)]; const int tl = r + 16 * crow(rr, hi);
#pragma unroll
    for (int d0 = 0; d0 < 2; ++d0) OA[tl * 64 + d0 * 32 + r32] = f2bf(o[d0][rr] * iv); }
}
__device__ __forceinline__ void dil_item_m(const bf16* __restrict__ P, long rowbase, int S, int h, int c, int g, LAS char* vl, LAS float* wsf, LAS bf16* OA, LAS float* ML, const bf16x8 (&qr)[4]) {
  const int lane = fresh_tid() & 63, r32 = lane & 31, hi = lane >> 5;
  const int r4 = g & 3, jb = g >> 2;
  const bf16* Kb = P + pc(512 + h * 64) + rowbase * PITCH; const bf16* Vb = P + pc(1024 + h * 64) + rowbase * PITCH;
  const int tl0 = r4 + 128 * jb;
  float m = 0.f, l = 0.f; f32x16 o[2]; o[0] = f32x16{}; o[1] = f32x16{};
  dil_pattern<4, 5, 1>(Kb, Vb, S, 128 * c + 32 * jb, r4, qr, m, l, o, vl, wsf, lane, r32, hi);
  l = swap_sum(l);
  if (hi == 0) {
    const int tl = tl0 + 4 * r32;
    const float ma = ML[tl * 2], la = ML[tl * 2 + 1];
    const float mm = fmaxf(ma, m), wa = la * __builtin_amdgcn_exp2f(ma - mm), wb = __builtin_amdgcn_exp2f(m - mm);
    const float den = wa + l * wb, rden = 1.f / den;
    wsf[r32] = wa * rden; wsf[32 + r32] = wb * rden; ML[tl * 2] = mm; ML[tl * 2 + 1] = den; }
#pragma unroll
  for (int rr = 0; rr < 16; ++rr) { const int q = crow(rr, hi); const float fa = wsf[q], fb = wsf[32 + q]; const int tl = tl0 + 4 * q;
#pragma unroll
    for (int d0 = 0; d0 < 2; ++d0) { const float oa = bf2f(OA[tl * 64 + d0 * 32 + r32]); OA[tl * 64 + d0 * 32 + r32] = f2bf(oa * fa + o[d0][rr] * fb); } }
}
__device__ __forceinline__ void dil_item_b(const bf16* __restrict__ P, bf16* __restrict__ Y, long rowbase, int S, int h, int c, int j, LAS char* vl, LAS float* wsf, const LAS bf16* OA, const LAS float* ML, const bf16x8 (&qr)[4]) {
  const int lane = fresh_tid() & 63, r32 = lane & 31, hi = lane >> 5;
  const bf16* Kb = P + pc(512 + h * 64) + rowbase * PITCH; const bf16* Vb = P + pc(1024 + h * 64) + rowbase * PITCH; const bf16* Gb = P + pc(1536 + h * 64) + rowbase * PITCH;
  const int tq0 = 512 * c + 32 * j;
  float m = 0.f, l = 0.f; f32x16 o[2]; o[0] = f32x16{}; o[1] = f32x16{};
  dil_pattern<1, 5, 1>(Kb, Vb, S, tq0, 0, qr, m, l, o, vl, wsf, lane, r32, hi);
  l = swap_sum(l);
  if (hi == 0) {
    const float ma = ML[(32 * j + r32) * 2], la = ML[(32 * j + r32) * 2 + 1];
    const float mm = fmaxf(ma, m), wa = la * __builtin_amdgcn_exp2f(ma - mm), wb = __builtin_amdgcn_exp2f(m - mm);
    const float rden = 1.f / (wa + l * wb);
    wsf[r32] = wa * rden; wsf[32 + r32] = wb * rden; }
  bf16* Yb = Y + rowbase * YP + h * 64;
#pragma unroll
  for (int rr = 0; rr < 16; ++rr) { const int q = crow(rr, hi); const float fa = wsf[q], fb = wsf[32 + q]; const long tok = tq0 + q;
#pragma unroll
    for (int d0 = 0; d0 < 2; ++d0) { const float g = bf2f(Gb[tok * PITCH + d0 * 32 + r32]); const float oa = bf2f(OA[(32 * j + q) * 64 + d0 * 32 + r32]);
      Yb[tok * YP + d0 * 32 + r32] = f2bf((oa * fa + o[d0][rr] * fb) * silu(g)); } }
}
}
typedef unsigned short bf16;
typedef float f32x4g __attribute__((ext_vector_type(4)));
typedef unsigned v4u __attribute__((ext_vector_type(4)));
constexpr int NTOK = 65536, DMODEL = 1024, DPROJ = 4096, NBATCH = 20, NPROMPT_ROWS = 32768;
constexpr size_t MiB = 1u << 20;
constexpr size_t WS_PROJ = 0, WS_Y = 0, WS_SSQ = 128 * MiB, WS_GATE = 132 * MiB, WS_NEED = 512 * MiB;
constexpr size_t DO_H = 0, DO_WIN = 128 * MiB, DO_WOUT = 136 * MiB, DO_MOD = 138 * MiB, DO_ROPE = 139 * MiB, DO_MISC = 140 * MiB;
constexpr size_t DO_BAR = 141 * MiB;
constexpr int LDS_XB = 147392;
constexpr int LDS_BYTES = 147456;
#define XB_TMO      128
#define XB_XCNT(j)  (256  + 64 * (j))
#define XB_XSUB(j)  (1280 + 64 * (j))
#define XB_XGEN(j)  (2304 + 64 * (j))
#define XB_TOP      3328
#define XB_TOPGEN   3392
#define XCD_BAR_WORDS 3456
#define XB_SPIN_CAP (1u << 18)

__device__ __forceinline__ unsigned xb_ld(unsigned* p)              { return __hip_atomic_load(p, __ATOMIC_RELAXED, __HIP_MEMORY_SCOPE_AGENT); }
__device__ __forceinline__ unsigned xb_add(unsigned* p, unsigned v) { return __hip_atomic_fetch_add(p, v, __ATOMIC_RELAXED, __HIP_MEMORY_SCOPE_AGENT); }
__device__ __forceinline__ unsigned xb_xcc_id() { return (unsigned)__builtin_amdgcn_s_getreg((3 << 11) | 20) & 0xFu; }
#define XB_SPIN(cond, bar) do { unsigned _sp = 0; while (cond) { __builtin_amdgcn_s_sleep(1); \
    if ((++_sp & 255u) == 0u) { if (xb_ld(&(bar)[XB_TMO])) break; if (_sp > XB_SPIN_CAP) { atomicAdd(&(bar)[XB_TMO], 1u); break; } } } } while (0)

struct XcdBarrier {
    unsigned* bar; unsigned x;
    volatile LAS unsigned* st;
};

__device__ __forceinline__ XcdBarrier xcd_barrier_post(unsigned* bar, volatile LAS unsigned* st) {
    XcdBarrier b; b.bar = bar; b.x = xb_xcc_id(); b.st = st;
    if (threadIdx.x == 0) (void)xb_add(&bar[XB_XCNT(b.x)], 1u);
    return b;
}
__device__ __forceinline__ void xcd_barrier_complete(unsigned* bar, unsigned x, unsigned& nloc, unsigned& nx) {
    const unsigned G = gridDim.x * gridDim.y * gridDim.z;
    unsigned sum, cnt, mine, sp = 0u;
    for (;;) {
        sum = 0u; cnt = 0u; mine = 0u;
#pragma unroll
        for (unsigned j = 0; j < 16; ++j) { const unsigned c = xb_ld(&bar[XB_XCNT(j)]); sum += c; cnt += (c > 0u) ? 1u : 0u; mine = (j == x) ? c : mine; }
        if (sum == G) break;
        __builtin_amdgcn_s_sleep(1);
        if ((++sp & 255u) == 0u) { if (xb_ld(&bar[XB_TMO])) break; if (sp > XB_SPIN_CAP) { atomicAdd(&bar[XB_TMO], 1u); break; } }
    }
    nloc = mine > 0u ? mine : 1u; nx = cnt > 0u ? cnt : 1u;
}

__device__ __forceinline__ void xcd_barrier(const XcdBarrier& b) {
    asm volatile("s_waitcnt vmcnt(0)" ::: "memory");
    __syncthreads();
    if (threadIdx.x == 0) {
        unsigned* bar = b.bar;
        __builtin_amdgcn_s_waitcnt(0);
        unsigned nloc = b.st[0], nx = b.st[1];
        if (nloc == 0u) { xcd_barrier_complete(bar, b.x, nloc, nx); b.st[0] = nloc; b.st[1] = nx; }
        const unsigned old = xb_add(&bar[XB_XSUB(b.x)], 1u);
        const unsigned gen = old / nloc;
        if (old + 1u == (gen + 1u) * nloc) {
            __builtin_amdgcn_fence(__ATOMIC_RELEASE, "agent");
            asm volatile("s_waitcnt vmcnt(0)" ::: "memory");
            const unsigned og = xb_add(&bar[XB_TOP], 1u);
            const unsigned tg = og / nx;
            if (og + 1u == (tg + 1u) * nx) xb_add(&bar[XB_TOPGEN], 1u);
            else XB_SPIN(xb_ld(&bar[XB_TOPGEN]) == tg, bar);
            __builtin_amdgcn_fence(__ATOMIC_ACQUIRE, "agent");
            xb_add(&bar[XB_XGEN(b.x)], 1u);
            asm volatile("s_waitcnt vmcnt(0)" ::: "memory");
        } else {
            XB_SPIN(xb_ld(&bar[XB_XGEN(b.x)]) == gen, bar);
            __builtin_amdgcn_fence(__ATOMIC_ACQUIRE, "agent");
            asm volatile("s_waitcnt vmcnt(0)" ::: "memory");
        }
    }
    __syncthreads();
}

struct Params { const float* in[15]; float* out; unsigned char* ws; int mask; int pad; };

__device__ __forceinline__ unsigned f2bf_u(float f) { unsigned u = __builtin_bit_cast(unsigned, f); return (u + 0x7fffu + ((u >> 16) & 1u)) >> 16; }
__device__ __forceinline__ unsigned pk2(float lo, float hi) { return f2bf_u(lo) | (f2bf_u(hi) << 16); }
__device__ __forceinline__ float wave_sum(float v) {
#pragma unroll
    for (int o = 1; o < 64; o <<= 1) v += __shfl_xor(v, o);
    return v;
}
__device__ __forceinline__ void transpose_item(const float* W, int K, int N, bf16* WT, LAS float* scr, int item, int lane) {
    const int nblk = N / 32, kb = item / nblk, nb = item % nblk, k0 = 64 * kb, n0 = 32 * nb;
#pragma unroll 8
    for (int i = 0; i < 32; ++i) { const int kk = 2 * i + (lane >> 5); scr[kk * 33 + (lane & 31)] = W[(size_t)(k0 + kk) * N + n0 + (lane & 31)]; }
    asm volatile("s_waitcnt lgkmcnt(0)" ::: "memory");
    const int c = lane & 7;
#pragma unroll
    for (int j = 0; j < 4; ++j) { const int n = (lane >> 3) + 8 * j; const LAS float* s = scr + (8 * c) * 33 + n;
        v4u o; o.x = pk2(s[0 * 33], s[1 * 33]); o.y = pk2(s[2 * 33], s[3 * 33]); o.z = pk2(s[4 * 33], s[5 * 33]); o.w = pk2(s[6 * 33], s[7 * 33]);
        *(v4u*)(WT + (size_t)(n0 + n) * K + k0 + 8 * c) = o; }
    asm volatile("s_waitcnt lgkmcnt(0)" ::: "memory");
}
__device__ __forceinline__ const float* xrow_ptr(const Params& p, int row) { return row < NPROMPT_ROWS ? p.in[0] + (size_t)row * DMODEL : p.in[1] + (size_t)(row - NPROMPT_ROWS) * DMODEL; }
__device__ __forceinline__ int row_batch(int row) { return row < NPROMPT_ROWS ? (row >> 13) : 4 + ((row - NPROMPT_ROWS) >> 11); }

__global__ void __launch_bounds__(512, 2) mega_fwd(Params p) {
    extern __shared__ __attribute__((aligned(16))) unsigned char lds_raw[];
    LAS unsigned char* lds = (LAS unsigned char*)lds_raw;
    cg::grid_group grid = cg::this_grid();
    const int tid = threadIdx.x, lane = tid & 63, wave = __builtin_amdgcn_readfirstlane(tid >> 6);
    const int G = gridDim.x, bx = blockIdx.x;
    const int vcu = (G % 8 == 0) ? (bx % 8) * (G / 8) + bx / 8 : bx;
    unsigned char* dob = (unsigned char*)p.out;
    bf16* H = (bf16*)(dob + DO_H); bf16* WIN = (bf16*)(dob + DO_WIN); bf16* WOUT = (bf16*)(dob + DO_WOUT);
    float* MOD = (float*)(dob + DO_MOD); float* ROPE = (float*)(dob + DO_ROPE); float* MISC = (float*)(dob + DO_MISC);
    bf16* PROJ = (bf16*)(p.ws + WS_PROJ); bf16* YB = (bf16*)(p.ws + WS_Y); float* SSQ = (float*)(p.ws + WS_SSQ); float* GATE = (float*)(p.ws + WS_GATE);
    const int gw = vcu * 8 + wave, NGW = G * 8;
    { unsigned* bw = (unsigned*)(dob + DO_BAR); for (int i = bx * 512 + tid; i < XCD_BAR_WORDS; i += G * 512) bw[i] = 0u; }
    if (tid < 2) ((volatile LAS unsigned*)(lds + LDS_XB))[tid] = 0u;

    asm volatile(".p2align 8\n\t.rept " PAD_STR(PAD_P0A) "\n\ts_nop 0\n\t.endr");
    if (p.mask & 1) {
        for (int e = bx * 512 + tid; e < 8192 * 8; e += G * 512) {
            const int pos = e >> 3, i = e & 7;
            const float inv = exp2f(-(float)i * (1.0f / 8.0f) * 18.931568569324174f);
            const float ang = (float)pos * inv;
            const double ad = (double)ang; const double n = rint(ad * 0.15915494309189535); const float red = (float)(ad - n * 6.283185307179586);
            ROPE[2 * e] = cosf(red); ROPE[2 * e + 1] = sinf(red);
        }
        __syncthreads();
        if (bx < 192) {
            LAS float* sc = (LAS float*)lds;
            LAS float* red = (LAS float*)(lds + 81920);
            { float cvv[NBATCH * 2];
#pragma unroll
              for (int q = 0; q < NBATCH * 2; ++q) { const int i = tid + 512 * q; const int b = i >> 10, k = i & 1023; cvv[q] = b < 4 ? p.in[2][b * DMODEL + k] : p.in[3][(b - 4) * DMODEL + k]; }
#pragma unroll
              for (int q = 0; q < NBATCH * 2; ++q) sc[tid + 512 * q] = cvv[q] / (1.f + __expf(-cvv[q])); }
            __syncthreads();
            const int col = tid & 15, ks = tid >> 4, j = bx * 16 + col;
            float acc[NBATCH];
#pragma unroll
            for (int b = 0; b < NBATCH; ++b) acc[b] = 0.f;
            float wv[32];
#pragma unroll
            for (int i = 0; i < 32; ++i) wv[i] = p.in[8][(size_t)(ks + 32 * i) * 3072 + j];
#pragma unroll
            for (int i = 0; i < 32; ++i) {
#pragma unroll
                for (int b = 0; b < NBATCH; ++b) acc[b] += sc[b * DMODEL + ks + 32 * i] * wv[i]; }
#pragma unroll
            for (int b = 0; b < NBATCH; ++b) red[(ks * NBATCH + b) * 16 + col] = acc[b];
            __syncthreads();
            if (tid < NBATCH * 16) { const int b = tid >> 4, cc = tid & 15; float s = 0.f;
                for (int k2 = 0; k2 < 32; ++k2) s += red[(k2 * NBATCH + b) * 16 + cc];
                MOD[b * 3072 + bx * 16 + cc] = s + p.in[9][bx * 16 + cc]; }
        }
        if (bx == G - 1 && wave == 0) {
            const float a = wave_sum(p.in[10][lane] * p.in[11][lane]), b2 = wave_sum(p.in[12][lane] * p.in[13][lane]);
            if (lane == 0) MISC[0] = expf(a) - expf(b2) + 0.2f;
        }
    }
    asm volatile("s_waitcnt vmcnt(0)\n\ts_nop 0" ::: "memory");
    grid.sync();
    const XcdBarrier xbar = xcd_barrier_post((unsigned*)(dob + DO_BAR), (volatile LAS unsigned*)(lds + LDS_XB));
    asm volatile(".p2align 8\n\t.rept " PAD_STR(PAD_P0B) "\n\ts_nop 0\n\t.endr");
    if (p.mask & 2) { const int lane = att::fresh_tid() & 63;
    f32x4g gpre[4];
#pragma unroll
    for (int j = 0; j < 4; ++j) gpre[j] = ((const f32x4g*)p.in[6])[lane + 64 * j];
    for (int rb = gw; rb < NTOK; rb += 4 * NGW) {
        f32x4g v[4][4];
#pragma unroll
        for (int q = 0; q < 4; ++q) { const int row = rb + q * NGW; if (row < NTOK) { const f32x4g* xr = (const f32x4g*)xrow_ptr(p, row) + lane;
#pragma unroll
            for (int j = 0; j < 4; ++j) v[q][j] = __builtin_nontemporal_load(&xr[64 * j]); } }
#pragma unroll
        for (int q = 0; q < 4; ++q) { const int row = rb + q * NGW; if (row < NTOK) {
            const int b = row_batch(row); float s = 0.f;
#pragma unroll
            for (int j = 0; j < 4; ++j) s += (v[q][j].x * v[q][j].x + v[q][j].y * v[q][j].y) + (v[q][j].z * v[q][j].z + v[q][j].w * v[q][j].w);
            const float rstd = rsqrtf(wave_sum(s) * (1.f / DMODEL) + 1e-6f);
            unsigned long long* o8 = (unsigned long long*)(H + (size_t)row * DMODEL) + lane;
#pragma unroll
            for (int j = 0; j < 4; ++j) {
                const f32x4g sh = ((const f32x4g*)(MOD + b * 3072))[lane + 64 * j], sl = ((const f32x4g*)(MOD + b * 3072 + 1024))[lane + 64 * j];
                const f32x4g hv = v[q][j] * rstd * gpre[j] * (sl + 1.f) + sh;
                o8[64 * j] = (unsigned long long)pk2(hv.x, hv.y) | ((unsigned long long)pk2(hv.z, hv.w) << 32);
            } } }
    }
    {
        LAS float* scr = (LAS float*)(lds + wave * 16384);
        constexpr int I_IN = (DMODEL / 64) * (DPROJ / 32), I_OUT = (DMODEL / 64) * (DMODEL / 32);
        for (int it = gw; it < I_IN + I_OUT; it += NGW) {
            if (it < I_IN) transpose_item(p.in[4], DMODEL, DPROJ, WIN, scr, it, lane);
            else transpose_item(p.in[5], DMODEL, DMODEL, WOUT, scr, it - I_IN, lane);
        }
    } }
    xcd_barrier(xbar);
#ifndef NO_P1
    asm volatile(".p2align 8\n\t.rept " PAD_STR(PAD_P1) "\n\ts_nop 0\n\t.endr");
    if (p.mask & 4) {
        pg8::Gemm g{H, WIN, NTOK, DPROJ, DMODEL}; pg8::StaticOrder S; S.init(NTOK, DPROJ, G, bx);
        pg8::EpiProj E{PROJ, 256, ROPE};
        pg8::gemm_phase<pg8::EpiProj, pg8::StaticOrder, true, true>(lds, g, S, E);
    }
#endif
    xcd_barrier(xbar);
    {
        bf16* YM = H;
        const float lam = MISC[0];
#ifndef NO_DIFF
    asm volatile(".p2align 8\n\t.rept " PAD_STR(PAD_DIFF) "\n\ts_nop 0\n\t.endr");
        if (p.mask & 8)
        for (int u = vcu; u < 2048; u += G) {
            int bh, qt, S; long rowbase;
            if (u < 1024) { bh = (u & 255) >> 4; qt = (u & 15) * 4 + (u >> 8); S = 8192; rowbase = (long)(bh >> 2) * 8192; }
            else { const int u2 = u - 1024; bh = (u2 & 255) >> 2; qt = (u2 & 3) * 4 + (u2 >> 8); S = 2048; rowbase = NPROMPT_ROWS + (long)(bh >> 2) * 2048; }
            att::diff_unit(PROJ, YM, rowbase, S, bh & 3, qt, (LAS char*)lds, lam, p.in[14]);
        }
#endif
#ifndef NO_DIL
        LAS char* vl = (LAS char*)lds + wave * 8448; LAS float* wsf = (LAS float*)(lds + wave * 8448 + 8192);
        LAS att::bf16* OA = (LAS att::bf16*)(lds + 67584); LAS float* ML = (LAS float*)(lds + 67584 + 65536);
    asm volatile(".p2align 8\n\t.rept " PAD_STR(PAD_DIL) "\n\ts_nop 0\n\t.endr");
        if (p.mask & 16)
        for (int u = vcu; u < 1024; u += G) {
            int b, h, c, S; long rowbase;
            if (u < 512) { const int id = (u & 255) * 2 + (u >> 8); c = id & 15; h = (id >> 4) & 7; b = id >> 7; S = 8192; rowbase = (long)b * 8192; }
            else { const int u2 = u - 512; const int id = (u2 & 255) * 2 + (u2 >> 8); c = id & 3; h = (id >> 2) & 7; b = id >> 5; S = 2048; rowbase = NPROMPT_ROWS + (long)b * 2048; }
            {
                const int ln = att::fresh_tid() & 63, r32 = ln & 31, hi = ln >> 5;
                const att::bf16* Qb = PROJ + att::pc(h * 64) + rowbase * att::PITCH;
                const long t0 = 512L * c;
                att::bf16x8 q0[4], q1[4];
                att::dil_q(q0, Qb, t0 + wave + 16 * r32, hi); att::dil_q(q1, Qb, t0 + wave + 8 + 16 * r32, hi);
                att::dil_item_a(PROJ, rowbase, S, h, c, wave, vl, wsf, OA, ML, q0);
                att::dil_item_a(PROJ, rowbase, S, h, c, wave + 8, vl, wsf, OA, ML, q1);
                { const int g0 = wave, g1 = wave + 8;
                  att::dil_q(q0, Qb, t0 + (g0 & 3) + 128 * (g0 >> 2) + 4 * r32, hi); att::dil_q(q1, Qb, t0 + (g1 & 3) + 128 * (g1 >> 2) + 4 * r32, hi); }
                __syncthreads();
                att::dil_item_m(PROJ, rowbase, S, h, c, wave, vl, wsf, OA, ML, q0);
                att::dil_item_m(PROJ, rowbase, S, h, c, wave + 8, vl, wsf, OA, ML, q1);
                att::dil_q(q0, Qb, t0 + 32 * wave + r32, hi); att::dil_q(q1, Qb, t0 + 32 * (wave + 8) + r32, hi);
                __syncthreads();
                att::dil_item_b(PROJ, YM, rowbase, S, h, c, wave, vl, wsf, OA, ML, q0);
                att::dil_item_b(PROJ, YM, rowbase, S, h, c, wave + 8, vl, wsf, OA, ML, q1);
            }
            __syncthreads();
        }
#endif
    }
    xcd_barrier(xbar);
    asm volatile(".p2align 8\n\t.rept " PAD_STR(PAD_P3) "\n\ts_nop 0\n\t.endr");
    if (p.mask & 32) {
        for (int i = bx * 512 + tid; i < NBATCH * DMODEL; i += G * 512) GATE[i] = MOD[(i >> 10) * 3072 + 2048 + (i & 1023)];
#ifndef NO_P3
        pg8::Gemm g{H, WOUT, NTOK, DMODEL, DMODEL}; pg8::StaticOrder S; S.init(NTOK, DMODEL, G, bx);
        pg8::EpiY E{YB, DMODEL, SSQ};
        pg8::gemm_phase<pg8::EpiY, pg8::StaticOrder, true, true>(lds, g, S, E);
#endif
    }
    asm volatile("s_waitcnt vmcnt(0)\n\ts_nop 0" ::: "memory");
    grid.sync();
    asm volatile(".p2align 8\n\t.rept " PAD_STR(PAD_P4) "\n\ts_nop 0\n\t.endr");
    if (p.mask & 64) { const int lane = att::fresh_tid() & 63;
    f32x4g gpo[4];
#pragma unroll
    for (int j = 0; j < 4; ++j) gpo[j] = ((const f32x4g*)p.in[7])[lane + 64 * j];
    for (int rb = gw; rb < NTOK; rb += 2 * NGW) {
        f32x4g xv[2][4]; unsigned long long yv[2][4]; float sq[2];
#pragma unroll
        for (int q = 0; q < 2; ++q) { const int row = rb + q * NGW; if (row < NTOK) { const f32x4g* xr = (const f32x4g*)xrow_ptr(p, row) + lane;
            const unsigned long long* y8 = (const unsigned long long*)(YB + (size_t)row * DMODEL) + lane;
            sq[q] = lane < 16 ? SSQ[(size_t)row * 16 + lane] : 0.f;
#pragma unroll
            for (int j = 0; j < 4; ++j) { xv[q][j] = __builtin_nontemporal_load(&xr[64 * j]); yv[q][j] = __builtin_nontemporal_load(&y8[64 * j]); } } }
#pragma unroll
        for (int q = 0; q < 2; ++q) { const int row = rb + q * NGW; if (row < NTOK) {
            const int b = row_batch(row);
            const float rstd = rsqrtf(wave_sum(sq[q]) * (1.f / DMODEL) + 1e-6f);
            f32x4g* orow = (f32x4g*)(p.out + (size_t)row * DMODEL) + lane;
#pragma unroll
            for (int j = 0; j < 4; ++j) {
                const unsigned long long w = yv[q][j];
                f32x4g y; y.x = __uint_as_float(((unsigned)w) << 16); y.y = __uint_as_float(((unsigned)w) & 0xffff0000u);
                y.z = __uint_as_float(((unsigned)(w >> 32)) << 16); y.w = __uint_as_float(((unsigned)(w >> 32)) & 0xffff0000u);
                const f32x4g gt = ((const f32x4g*)(GATE + b * DMODEL))[lane + 64 * j];
                __builtin_nontemporal_store(xv[q][j] + gt * (y * rstd) * gpo[j], &orow[64 * j]);
            } } }
    } }
}

extern "C" void kernel_launch(void* const* d_in, const int* in_sizes, int n_in, void* d_out, int out_size, void* d_ws, size_t ws_size, hipStream_t stream) {
    static int grid = 0;
    if (grid == 0) {
        if (n_in != 15 || ws_size < WS_NEED || out_size != NTOK * DMODEL) { fprintf(stderr, "kernel_launch: unexpected shapes (n_in %d, ws %zu, out %d)\n", n_in, ws_size, out_size); grid = -1; return; }
        int dev = 0, cus = 0, per_cu = 0;
        hipGetDevice(&dev); hipDeviceGetAttribute(&cus, hipDeviceAttributeMultiprocessorCount, dev);
        hipFuncSetAttribute((const void*)mega_fwd, hipFuncAttributeMaxDynamicSharedMemorySize, LDS_BYTES);
        hipOccupancyMaxActiveBlocksPerMultiprocessor(&per_cu, (const void*)mega_fwd, 512, LDS_BYTES);
        (void)hipGetLastError();
        if (per_cu < 1) per_cu = 1;
        grid = cus;
    }
    if (grid < 0) return;
    Params p{};
    for (int i = 0; i < 15; ++i) p.in[i] = (const float*)d_in[i];
    p.out = (float*)d_out; p.ws = (unsigned char*)d_ws; p.mask = 127;
#ifdef PROBE_MASK
    { Params p2 = p; p2.mask = PROBE_MASK; void* args2[] = {&p2}; (void)hipLaunchCooperativeKernel((const void*)mega_fwd, dim3(grid), dim3(512), args2, LDS_BYTES, stream); }
#endif
    void* args[] = {&p};
    hipError_t e = hipLaunchCooperativeKernel((const void*)mega_fwd, dim3(grid), dim3(512), args, LDS_BYTES, stream);
    if (e != hipSuccess) fprintf(stderr, "cooperative launch failed: %s (grid %d)\n", hipGetErrorString(e), grid);
}
```

```cpp
#include <hip/hip_runtime.h>
#include <hip/hip_cooperative_groups.h>
#include <cstdio>
#include <cstdint>
namespace cg = cooperative_groups;
#define PAD_STR2(x) #x
#define PAD_STR(x) PAD_STR2(x)
#define PAD_P0A 0
#define PAD_P0B 0
#define PAD_P1 0
#define PAD_DIFF 0
#define PAD_DIL 0
#define PAD_P3 0
#define PAD_P4 0
constexpr float QK_C2 = 0.125f * 1.4426950408889634f;
namespace pg8 {
#define PG8_LAS __attribute__((address_space(3)))
typedef unsigned short bf16_t;
typedef short bf16x8 __attribute__((ext_vector_type(8)));
typedef float f32x4 __attribute__((ext_vector_type(4)));
typedef unsigned u32x4 __attribute__((ext_vector_type(4)));
constexpr int BM = 256, BK = 64, HALF = 128, HTB = HALF * BK * 2  , STAGE_BYTES = 8 * HTB, NXCD = 8, WGM = 8;

__host__ __device__ __forceinline__ int lds_byte(int r, int c) { const int st = (r >> 4) * 2 + (c >> 5), rr = r & 15, cc = c & 31, ob = rr * 64 + cc * 2; return st * 1024 + (ob ^ (((ob >> 9) & 1) << 5)); }
__host__ __device__ __forceinline__ void stage_rc(int b, int& R, int& C) { const int st = b / 1024, sb = b % 1024, swz = sb ^ (((sb >> 9) & 1) << 5); R = (st >> 1) * 16 + swz / 64; C = (st & 1) * 32 + (swz % 64) / 2; }
__host__ __device__ __forceinline__ int perm32(int rho) { const int n = rho >> 4, i = rho & 15; return 8 * (i >> 2) + 4 * n + (i & 3); }

struct Unit { int pm, pn; };
struct Gemm { const bf16_t* A; const bf16_t* Bt; int M, N, K; };

struct StaticOrder {
    int nM, nN, nwg, G, c;
    __host__ __device__ void init(int M, int N, int G_, int c_) { nM = M / BM; nN = N / BM; nwg = nM * nN; G = G_; c = c_; }
    __host__ __device__ bool next(int i, Unit& u) const {
        const long L = (long)i * G + c; if (L >= nwg) return false;
        int wgid = (int)L; { const int q = nwg / NXCD, r = nwg % NXCD, xcd = wgid % NXCD, off = wgid / NXCD; wgid = (xcd < r ? xcd * (q + 1) : r * (q + 1) + (xcd - r) * q) + off; }
        const int nig = WGM * nN, gid = wgid / nig, fm = gid * WGM, gsz = (nM - fm) < WGM ? (nM - fm) : WGM;
        u.pm = fm + ((wgid % nig) % gsz); u.pn = (wgid % nig) / gsz; return true;
    }
    __device__ __forceinline__ void a_ready(const Unit&) const {}
    __device__ __forceinline__ void done(const Unit&) const {}
};

__device__ __forceinline__ unsigned cvt_pk_bf16(float lo, float hi) { unsigned r; asm volatile("v_cvt_pk_bf16_f32 %0, %1, %2" : "=v"(r) : "v"(lo), "v"(hi)); return r; }
struct EpiProj {
    static constexpr bool PERM = true, AFTER_DRAIN = false;
    bf16_t* O; int ldc; const float* rope; bf16_t* O15;
    __device__ __forceinline__ void operator()(const f32x4 (&acc)[2][2][4][2], const Unit& u, int wr, int wc, int fr, int fq) const {
        const int row0 = u.pm * BM + wr * 64 + fr;
        const bool tile_rope = (u.pn & 4) == 0;
        const bool lane_rope = tile_rope && ((wc & 1) == 0) && (fq < 2);
        const float sc = ((u.pn & 6) == 0) ? QK_C2 : 1.f;
        const float sgn = (fq == 0) ? -1.f : 1.f;
        const int col0 = wc * 32 + 8 * fq;
        bf16_t* const Op = (u.pn == 15) ? O15 : O + (size_t)u.pn * ((size_t)65536 * 256);
#pragma unroll
        for (int ai = 0; ai < 2; ++ai)
#pragma unroll
            for (int m = 0; m < 4; ++m) {
                const int row = row0 + ai * HALF + m * 16;
                const int pos = row < 32768 ? (row & 8191) : (row & 2047);
                f32x4 cs[4];
                if (tile_rope) {
#pragma unroll
                    for (int q = 0; q < 4; ++q) cs[q] = *(const f32x4*)(rope + (size_t)pos * 16 + q * 4);
                }
                bf16_t* rowp = Op + (size_t)row * ldc + col0;
#pragma unroll
                for (int bj = 0; bj < 2; ++bj) {
                    f32x4 v0 = acc[ai][bj][m][0], v1 = acc[ai][bj][m][1];
                    if (tile_rope) {
                        f32x4 p0, p1;
#pragma unroll
                        for (int j = 0; j < 4; ++j) { p0[j] = __shfl_xor(v0[j], 16); p1[j] = __shfl_xor(v1[j], 16); }
                        if (lane_rope) {
                            v0[0] = v0[0] * cs[0][0] + sgn * p0[0] * cs[0][1]; v0[1] = v0[1] * cs[0][2] + sgn * p0[1] * cs[0][3];
                            v0[2] = v0[2] * cs[1][0] + sgn * p0[2] * cs[1][1]; v0[3] = v0[3] * cs[1][2] + sgn * p0[3] * cs[1][3];
                            v1[0] = v1[0] * cs[2][0] + sgn * p1[0] * cs[2][1]; v1[1] = v1[1] * cs[2][2] + sgn * p1[1] * cs[2][3];
                            v1[2] = v1[2] * cs[3][0] + sgn * p1[2] * cs[3][1]; v1[3] = v1[3] * cs[3][2] + sgn * p1[3] * cs[3][3];
                        }
                    }
                    v0 = v0 * sc; v1 = v1 * sc;
                    u32x4 w; w.x = cvt_pk_bf16(v0[0], v0[1]); w.y = cvt_pk_bf16(v0[2], v0[3]); w.z = cvt_pk_bf16(v1[0], v1[1]); w.w = cvt_pk_bf16(v1[2], v1[3]);
                    __builtin_nontemporal_store(w, (u32x4*)(rowp + bj * HALF));
                }
            }
    }
};
struct EpiY {
    static constexpr bool PERM = true, AFTER_DRAIN = false;
    bf16_t* O; int ldc; float* ssq;
    __device__ __forceinline__ void operator()(const f32x4 (&acc)[2][2][4][2], const Unit& u, int wr, int wc, int fr, int fq) const {
        const int row0 = u.pm * BM + wr * 64 + fr;
        const int col0 = u.pn * BM + wc * 32 + 8 * fq;
#pragma unroll
        for (int ai = 0; ai < 2; ++ai)
#pragma unroll
            for (int m = 0; m < 4; ++m) {
                const int row = row0 + ai * HALF + m * 16;
                bf16_t* rowp = O + (size_t)row * ldc + col0;
                float s = 0.f;
#pragma unroll
                for (int bj = 0; bj < 2; ++bj) {
                    const f32x4 v0 = acc[ai][bj][m][0], v1 = acc[ai][bj][m][1];
                    s += (v0[0] * v0[0] + v0[1] * v0[1]) + (v0[2] * v0[2] + v0[3] * v0[3]) + (v1[0] * v1[0] + v1[1] * v1[1]) + (v1[2] * v1[2] + v1[3] * v1[3]);
                    u32x4 w; w.x = cvt_pk_bf16(v0[0], v0[1]); w.y = cvt_pk_bf16(v0[2], v0[3]); w.z = cvt_pk_bf16(v1[0], v1[1]); w.w = cvt_pk_bf16(v1[2], v1[3]);
                    *(u32x4*)(rowp + bj * HALF) = w;
                }
                s += __shfl_xor(s, 16); s += __shfl_xor(s, 32);
                if (fq == 0) ssq[(size_t)row * 16 + u.pn * 4 + wc] = s;
            }
    }
};
template <class Epi, class Sched, bool ALIGN_EPI = false, bool SP2 = false>
__device__ __forceinline__ void gemm_phase(PG8_LAS unsigned char* lds, const Gemm g, const Sched& S, const Epi& E) {
    const int tid = threadIdx.x, wid = __builtin_amdgcn_readfirstlane(tid >> 6), lane = tid & 63, wr = wid >> 2, wc = wid & 3, fr = lane & 15, fq = lane >> 4;
    const int K = g.K, nt = K / BK;
    unsigned voffA[2], voffB[2];
#pragma unroll
    for (int i = 0; i < 2; ++i) { int R, C; stage_rc(tid * 16 + i * 8192, R, C); const int Rb = Epi::PERM ? ((R & ~31) + perm32(R & 31)) : R;
        voffA[i] = (unsigned)(R * K + C) * 2u; voffB[i] = (unsigned)(Rb * K + C) * 2u; }
    const size_t kstep = (size_t)(BK * 2);
    const size_t hstep = (size_t)HALF * K * 2;
    const size_t tstep = 2 * hstep;
    const unsigned ldsw = (unsigned)wid * 1024u;
    const int aoff = lds_byte(wr * 64 + fr, fq * 8), boff = lds_byte(wc * 32 + fr, fq * 8);
#define PG8_SA(b, h) (((b) * 2 + (h)) * HTB)
#define PG8_SB(b, h) ((4 + (b) * 2 + (h)) * HTB)
#define PG8_STAGE(bufoff, gbase, voff) do { _Pragma("unroll") for (int _i = 0; _i < 2; ++_i) \
        __builtin_amdgcn_global_load_lds((const unsigned*)((const char*)(gbase) + (voff)[_i]), (PG8_LAS unsigned*)(lds + (bufoff) + ldsw + _i * 8192), 16, 0, 0); } while (0)
#define PG8_LDA(dst, b, h) do { _Pragma("unroll") for (int m = 0; m < 4; ++m) _Pragma("unroll") for (int k = 0; k < 2; ++k) dst[m][k] = *(const PG8_LAS bf16x8*)(lds + PG8_SA(b, h) + aoff + m * 2048 + k * 1024); } while (0)
#define PG8_LDB(dst, b, h) do { _Pragma("unroll") for (int n = 0; n < 2; ++n) _Pragma("unroll") for (int k = 0; k < 2; ++k) dst[n][k] = *(const PG8_LAS bf16x8*)(lds + PG8_SB(b, h) + boff + n * 2048 + k * 1024); } while (0)
#define PG8_MMA(ai, bj, At, Bt) do { __builtin_amdgcn_s_setprio(1); _Pragma("unroll") for (int m = 0; m < 4; ++m) _Pragma("unroll") for (int n = 0; n < 2; ++n) _Pragma("unroll") for (int k = 0; k < 2; ++k) \
        acc[ai][bj][m][n] = __builtin_amdgcn_mfma_f32_16x16x32_bf16(Bt[n][k], At[m][k], acc[ai][bj][m][n], 0, 0, 0); __builtin_amdgcn_s_setprio(0); } while (0)
#define PG8_WAIT_V(n) asm volatile("s_waitcnt vmcnt(" #n ")" ::: "memory")
#define PG8_WAIT_L(n) asm volatile("s_waitcnt lgkmcnt(" #n ")" ::: "memory")
#define PG8_BAR __builtin_amdgcn_s_barrier()
#define PG8_SCHED __builtin_amdgcn_sched_barrier(0)
    Unit cur, nxt; int ui = 0;
    if (!S.next(0, cur)) return;
    f32x4 acc[2][2][4][2];
#pragma unroll
    for (int a = 0; a < 2; ++a)
#pragma unroll
        for (int b = 0; b < 2; ++b)
#pragma unroll
            for (int m = 0; m < 4; ++m)
#pragma unroll
                for (int n = 0; n < 2; ++n) acc[a][b][m][n] = (f32x4){0.f, 0.f, 0.f, 0.f};
    bf16x8 At[4][2], B0[2][2], B1[2][2];
    const char* cA = (const char*)g.A + (size_t)cur.pm * tstep; const char* cB = (const char*)g.Bt + (size_t)cur.pn * tstep;
    S.a_ready(cur);
    if constexpr (SP2) {
        PG8_STAGE(PG8_SB(0, 0), cB, voffB); PG8_STAGE(PG8_SB(0, 1), cB + hstep, voffB); PG8_STAGE(PG8_SA(0, 0), cA, voffA); PG8_STAGE(PG8_SA(0, 1), cA + hstep, voffA);
        if (wr == 1) PG8_BAR;
        PG8_WAIT_V(2); PG8_BAR;
        PG8_STAGE(PG8_SB(1, 0), cB + kstep, voffB); PG8_STAGE(PG8_SA(1, 0), cA + kstep, voffA); PG8_STAGE(PG8_SB(1, 1), cB + hstep + kstep, voffB);
        PG8_WAIT_V(6); PG8_BAR;
    } else {
        PG8_STAGE(PG8_SB(0, 0), cB, voffB); PG8_STAGE(PG8_SA(0, 0), cA, voffA); PG8_STAGE(PG8_SB(0, 1), cB + hstep, voffB); PG8_STAGE(PG8_SA(0, 1), cA + hstep, voffA);
        if (wr == 1) PG8_BAR;
        PG8_WAIT_V(4); PG8_BAR;
        PG8_STAGE(PG8_SB(1, 0), cB + kstep, voffB); PG8_STAGE(PG8_SA(1, 0), cA + kstep, voffA); PG8_STAGE(PG8_SB(1, 1), cB + hstep + kstep, voffB);
        PG8_WAIT_V(6); PG8_BAR;
    }
    for (;;) {
        const bool has_next = S.next(ui + 1, nxt);
        const char* nA = has_next ? (const char*)g.A + (size_t)nxt.pm * tstep : cA; const char* nB = has_next ? (const char*)g.Bt + (size_t)nxt.pn * tstep : cB;
        for (int t = 0; t < nt; t += 2) {
            const bool last = (t == nt - 2);
            const char* a1 = cA + (size_t)(t + 1) * kstep;
            const char* a2 = last ? nA : cA + (size_t)(t + 2) * kstep; const char* b2 = last ? nB : cB + (size_t)(t + 2) * kstep;
            const char* a3 = a2 + kstep; const char* b3 = b2 + kstep;
            if (last && has_next) S.a_ready(nxt);
            if constexpr (SP2) {
            PG8_LDB(B0, 0, 0); PG8_LDB(B1, 0, 1); PG8_SCHED; PG8_LDA(At, 0, 0); PG8_STAGE(PG8_SA(1, 1), a1 + hstep, voffA);
            PG8_WAIT_V(8); PG8_WAIT_L(0); PG8_BAR; PG8_MMA(0, 0, At, B0); PG8_MMA(0, 1, At, B1); PG8_BAR; PG8_SCHED;
            PG8_LDA(At, 0, 1); PG8_STAGE(PG8_SB(0, 0), b2, voffB); PG8_STAGE(PG8_SB(0, 1), b2 + hstep, voffB); PG8_STAGE(PG8_SA(0, 0), a2, voffA);
            PG8_WAIT_V(8); PG8_WAIT_L(0); PG8_BAR; PG8_MMA(1, 0, At, B0); PG8_MMA(1, 1, At, B1); PG8_BAR; PG8_SCHED;
            PG8_LDB(B0, 1, 0); PG8_LDB(B1, 1, 1); PG8_SCHED; PG8_LDA(At, 1, 0); PG8_STAGE(PG8_SA(0, 1), a2 + hstep, voffA);
            PG8_WAIT_V(8); PG8_WAIT_L(0); PG8_BAR; PG8_MMA(0, 0, At, B0); PG8_MMA(0, 1, At, B1); PG8_BAR; PG8_SCHED;
            PG8_LDA(At, 1, 1); PG8_STAGE(PG8_SB(1, 0), b3, voffB); PG8_STAGE(PG8_SB(1, 1), b3 + hstep, voffB); PG8_STAGE(PG8_SA(1, 0), a3, voffA);
            PG8_WAIT_V(8); PG8_WAIT_L(0); PG8_BAR; PG8_MMA(1, 0, At, B0); PG8_MMA(1, 1, At, B1); PG8_BAR; PG8_SCHED;
            } else {
            PG8_LDB(B0, 0, 0); PG8_SCHED; PG8_LDA(At, 0, 0); PG8_STAGE(PG8_SA(1, 1), a1 + hstep, voffA);
            PG8_WAIT_L(8); PG8_BAR; PG8_WAIT_L(0); PG8_MMA(0, 0, At, B0); PG8_BAR; PG8_SCHED;
            PG8_LDB(B1, 0, 1); PG8_STAGE(PG8_SB(0, 0), b2, voffB);
            PG8_BAR; PG8_WAIT_L(0); PG8_MMA(0, 1, At, B1); PG8_BAR;
            PG8_LDA(At, 0, 1); PG8_STAGE(PG8_SA(0, 0), a2, voffA);
            PG8_BAR; PG8_WAIT_L(0); PG8_MMA(1, 0, At, B0); PG8_BAR; PG8_SCHED;
            PG8_STAGE(PG8_SB(0, 1), b2 + hstep, voffB);
            PG8_WAIT_V(6); PG8_BAR; PG8_MMA(1, 1, At, B1); PG8_BAR;
            PG8_LDB(B0, 1, 0); PG8_SCHED; PG8_LDA(At, 1, 0); PG8_STAGE(PG8_SA(0, 1), a2 + hstep, voffA);
            PG8_WAIT_L(8); PG8_BAR; PG8_WAIT_L(0); PG8_MMA(0, 0, At, B0); PG8_BAR; PG8_SCHED;
            PG8_LDB(B1, 1, 1); PG8_STAGE(PG8_SB(1, 0), b3, voffB);
            PG8_BAR; PG8_WAIT_L(0); PG8_MMA(0, 1, At, B1); PG8_BAR;
            PG8_LDA(At, 1, 1); PG8_STAGE(PG8_SA(1, 0), a3, voffA);
            PG8_BAR; PG8_WAIT_L(0); PG8_MMA(1, 0, At, B0); PG8_BAR; PG8_SCHED;
            PG8_STAGE(PG8_SB(1, 1), b3 + hstep, voffB);
            PG8_WAIT_V(6); PG8_BAR; PG8_MMA(1, 1, At, B1); PG8_BAR;
            }
        }
        if constexpr (ALIGN_EPI) { if (wr == 0) PG8_BAR; }
        if constexpr (!Epi::AFTER_DRAIN) { E(acc, cur, wr, wc, fr, fq); S.done(cur); }
        if (!has_next) break;
#pragma unroll
        for (int a = 0; a < 2; ++a)
#pragma unroll
            for (int b = 0; b < 2; ++b)
#pragma unroll
                for (int m = 0; m < 4; ++m)
#pragma unroll
                    for (int n = 0; n < 2; ++n) acc[a][b][m][n] = (f32x4){0.f, 0.f, 0.f, 0.f};
        cur = nxt; cA = nA; cB = nB; ++ui;
        if constexpr (ALIGN_EPI) { if (wr == 1) PG8_BAR; }
    }
    PG8_WAIT_V(0);
    if constexpr (!ALIGN_EPI) { if (wr == 0) PG8_BAR; }
    PG8_BAR;
    if constexpr (Epi::AFTER_DRAIN) { E.fused(acc, cur, wr, wc, fr, fq, lds, wid, lane); S.done(cur); }
#undef PG8_SA
#undef PG8_SB
#undef PG8_STAGE
#undef PG8_LDA
#undef PG8_LDB
#undef PG8_MMA
#undef PG8_WAIT_V
#undef PG8_WAIT_L
#undef PG8_BAR
#undef PG8_SCHED
}
}
#define LAS __attribute__((address_space(3)))
namespace att {
typedef unsigned short bf16;
typedef short bf16x8 __attribute__((ext_vector_type(8)));
typedef short s16x4 __attribute__((ext_vector_type(4)));
typedef short v4i16_t __attribute__((ext_vector_type(4)));
typedef float f32x16 __attribute__((ext_vector_type(16)));
typedef unsigned u32x4 __attribute__((ext_vector_type(4)));
typedef float f32x2_t __attribute__((ext_vector_type(2)));
typedef __bf16 bf16x2_t __attribute__((ext_vector_type(2)));
typedef LAS const char* lds_cptr;
constexpr int PITCH = 256;
constexpr long PANEL = 65536L * 256;
__device__ __forceinline__ long pc(int col) { return (long)(col >> 8) * PANEL + (col & 255); }
constexpr int YP = 1024;
__device__ __forceinline__ int fresh_tid() { int t = threadIdx.x; asm volatile("" : "+v"(t)); return t; }
__device__ __forceinline__ int crow(int r, int hi) { return (r & 3) + 8 * (r >> 2) + 4 * hi; }
__device__ __forceinline__ void glds16(const void* gsrc, unsigned lds_dst) { unsigned keep;
  asm volatile("s_mov_b32 %0, m0\n\ts_mov_b32 m0, %2\n\ts_nop 0\n\tglobal_load_lds_dwordx4 %1, off\n\ts_mov_b32 m0, %0" : "=&s"(keep) : "v"(gsrc), "s"(lds_dst) : "memory"); }
__device__ __forceinline__ unsigned cvtpk_s(float lo, float hi) { f32x2_t v = {lo, hi}; bf16x2_t b = __builtin_convertvector(v, bf16x2_t); return __builtin_bit_cast(unsigned, b); }
__device__ __forceinline__ s16x4 vtr(lds_cptr p) { return __builtin_bit_cast(s16x4, __builtin_amdgcn_ds_read_tr16_b64_v4i16((LAS v4i16_t*)p)); }
__device__ __forceinline__ float bf2f(bf16 v) { return __uint_as_float(((unsigned)v) << 16); }
__device__ __forceinline__ bf16 f2bf(float f) { unsigned u = __float_as_uint(f); return (bf16)((u + 0x7fffu + ((u >> 16) & 1u)) >> 16); }
__device__ __forceinline__ float swap_max(float m) { auto rr = __builtin_amdgcn_permlane32_swap(__float_as_uint(m), __float_as_uint(m), false, false); return fmaxf(__uint_as_float(rr[0]), __uint_as_float(rr[1])); }
__device__ __forceinline__ float swap_sum(float m) { auto rr = __builtin_amdgcn_permlane32_swap(__float_as_uint(m), __float_as_uint(m), false, false); return __uint_as_float(rr[0]) + __uint_as_float(rr[1]); }
#define ATT_EXP2(A, B) asm("v_exp_f32_e32 %0, %0\n\tv_exp_f32_e32 %1, %1\n\ts_nop 0" : "+v"(A), "+v"(B))
#define ATT_EXP2_ADD2(A, B, SA, SB, PA, PB) asm("v_exp_f32_e32 %0, %0\n\tv_exp_f32_e32 %1, %1\n\tv_add_f32_e32 %2, %2, %4\n\tv_add_f32_e32 %3, %3, %5" : "+v"(A), "+v"(B), "+v"(SA), "+v"(SB) : "v"(PA), "v"(PB))
#define ATT_ADD2(SA, SB, PA, PB) asm("s_nop 0\n\tv_add_f32_e32 %0, %0, %2\n\tv_add_f32_e32 %1, %1, %3" : "+v"(SA), "+v"(SB) : "v"(PA), "v"(PB))
__device__ __forceinline__ float silu(float g) { return g / (1.f + __expf(-g)); }
#define ATT_WAIT_BAR(N) asm volatile("s_waitcnt vmcnt(" #N ") lgkmcnt(0)\n\ts_barrier" ::: "memory")
#define ATT_PACK(P, B) (u32x4){cvtpk_s(P[B], P[B + 1]), cvtpk_s(P[B + 2], P[B + 3]), cvtpk_s(P[B + 4], P[B + 5]), cvtpk_s(P[B + 6], P[B + 7])}
#define ATT_VFR(lo, hi) (bf16x8){lo[0], lo[1], lo[2], lo[3], hi[0], hi[1], hi[2], hi[3]}

constexpr int D_SLOT = 32768, D_NSLOT = 4, D_WSF = D_SLOT * D_NSLOT;
#define ATT_MX3(a, b, c) __builtin_fmaxf(__builtin_fmaxf((a), (b)), (c))
__device__ __forceinline__ void diff_unit(const bf16* __restrict__ P, bf16* __restrict__ Y, long rowbase, int S, int h, int qt, LAS char* shm, float lam, const float* __restrict__ g_sub, const bf16* __restrict__ P15) {
  const int tid = fresh_tid(), lane = tid & 63, r32 = lane & 31, hi = lane >> 5; const int wid = __builtin_amdgcn_readfirstlane(tid >> 6);
  const int map = wid >> 2, wq = wid & 3;
  const long qrow0 = rowbase + (long)qt * 128 + wq * 32;
  const bf16* Qw = P + pc(2048 + (2 * h + map) * 64) + qrow0 * PITCH;
  const bf16* Kb = P + pc(2560 + (2 * h + map) * 64) + rowbase * PITCH;
  const bf16* Vb = P + pc(3072 + h * 128) + rowbase * PITCH;
  const unsigned lds0 = (unsigned)(uintptr_t)shm;
  LAS float* wsf = (LAS float*)(shm + D_WSF) + wid * 64;
  const bf16* ksrc0 = Kb + (long)lane * PITCH + (2 * wq) * 8;
  const bf16* ksrc1 = ksrc0 + 8;
  const unsigned kdst0 = map * 8192 + (2 * wq) * 1024, kdst1 = kdst0 + 1024;
  const int vp0 = 2 * wid, vp1 = 2 * wid + 1;
  const bf16* vsrc0 = Vb + (long)(16 * (vp0 & 3) + (lane >> 2)) * PITCH + 32 * (vp0 >> 2) + 8 * (lane & 3);
  const bf16* vsrc1 = Vb + (long)(16 * (vp1 & 3) + (lane >> 2)) * PITCH + 32 * (vp1 >> 2) + 8 * (lane & 3);
  const unsigned vdst0 = 16384 + vp0 * 1024, vdst1 = 16384 + vp1 * 1024;
#define D_DMA(t, slot) do { const long toff_ = (long)(t) * 64 * PITCH; const unsigned sb_ = lds0 + (slot); \
    glds16(ksrc0 + toff_, (unsigned)__builtin_amdgcn_readfirstlane(sb_ + kdst0)); glds16(ksrc1 + toff_, (unsigned)__builtin_amdgcn_readfirstlane(sb_ + kdst1)); \
    glds16(vsrc0 + toff_, (unsigned)__builtin_amdgcn_readfirstlane(sb_ + vdst0)); glds16(vsrc1 + toff_, (unsigned)__builtin_amdgcn_readfirstlane(sb_ + vdst1)); } while (0)
  const int NT = S / 64;
  asm volatile("s_waitcnt vmcnt(0)" ::: "memory");
  bf16x8 qr[4];
#pragma unroll
  for (int d0 = 0; d0 < 4; ++d0) qr[d0] = *reinterpret_cast<const bf16x8*>(&Qw[(long)r32 * PITCH + d0 * 16 + hi * 8]);
  asm volatile("" ::: "memory");
  D_DMA(0, 0); D_DMA(1, D_SLOT); D_DMA(2, 2 * D_SLOT);
  float m = 0.f, l = 0.f;
  f32x16 o[4];
#pragma unroll
  for (int d0 = 0; d0 < 4; ++d0) o[d0] = f32x16{};
  f32x16 negm = f32x16{}; asm volatile("" : "+v"(negm));
  const lds_cptr shm3 = (lds_cptr)shm;
  const lds_cptr kp0 = shm3 + map * 8192 + hi * 1024 + r32 * 16;
  const lds_cptr vp = shm3 + 16384 + ((lane >> 4) & 1) * 32 + (lane & 3) * 8 + (4 * hi + ((lane & 15) >> 2)) * 64;
  bf16x8 pa0, pa1, pa2, pa3;
  pa0 = pa1 = pa2 = pa3 = bf16x8{};
#define D_KLD(SL_) do { const lds_cptr kp = kp0 + (SL_); \
    _Pragma("unroll") for (int d0 = 0; d0 < 4; ++d0) { kf[2 * d0] = *(const LAS bf16x8*)(kp + d0 * 2048); kf[2 * d0 + 1] = *(const LAS bf16x8*)(kp + d0 * 2048 + 512); } } while (0)
#define D_QKSM(T_, SL_) do { \
    f32x16 p0, p1; \
    p0 = __builtin_amdgcn_mfma_f32_32x32x16_bf16(kf[0], qr[0], negm, 0, 0, 0); p1 = __builtin_amdgcn_mfma_f32_32x32x16_bf16(kf[1], qr[0], negm, 0, 0, 0); \
    _Pragma("unroll") for (int d0 = 1; d0 < 4; ++d0) { \
      p0 = __builtin_amdgcn_mfma_f32_32x32x16_bf16(kf[2 * d0], qr[d0], p0, 0, 0, 0); p1 = __builtin_amdgcn_mfma_f32_32x32x16_bf16(kf[2 * d0 + 1], qr[d0], p1, 0, 0, 0); } \
    float ra = ATT_MX3(p0[0], p0[1], p1[0]), rb = ATT_MX3(p0[2], p0[3], p1[1]); ra = ATT_MX3(ra, p1[2], p1[3]); \
    _Pragma("unroll") for (int r = 4; r < 16; r += 4) { ra = ATT_MX3(ra, p0[r], p0[r + 1]); rb = ATT_MX3(rb, p0[r + 2], p0[r + 3]); ra = ATT_MX3(ra, p1[r], p1[r + 1]); rb = ATT_MX3(rb, p1[r + 2], p1[r + 3]); } \
    const float rm = swap_max(fmaxf(ra, rb)); \
    if ((T_) == 0 || __any(rm > 6.f)) { \
      const float dl = ((T_) == 0) ? rm : fmaxf(rm, 0.f); m += dl; \
      _Pragma("unroll") for (int r = 0; r < 16; ++r) { p0[r] -= dl; p1[r] -= dl; } \
      _Pragma("unroll") for (int r = 0; r < 16; ++r) negm[r] = -m; \
      asm volatile("" : "+v"(negm)); \
      const float f = __builtin_amdgcn_exp2f(-dl); l *= f; \
      if (hi == 0) wsf[r32] = f; \
      _Pragma("unroll") for (int r = 0; r < 16; ++r) { const float fr_ = wsf[crow(r, hi)]; \
        _Pragma("unroll") for (int d0 = 0; d0 < 4; ++d0) o[d0][r] *= fr_; } \
    } \
    float sacc = 0.f, sacd = 0.f; \
    ATT_EXP2(p0[0], p1[0]); \
    _Pragma("unroll") for (int r = 1; r < 16; ++r) ATT_EXP2_ADD2(p0[r], p1[r], sacc, sacd, p0[r - 1], p1[r - 1]); \
    ATT_ADD2(sacc, sacd, p0[15], p1[15]); \
    l += sacc + sacd; \
    pa0 = __builtin_bit_cast(bf16x8, ATT_PACK(p0, 0)); pa1 = __builtin_bit_cast(bf16x8, ATT_PACK(p0, 8)); \
    pa2 = __builtin_bit_cast(bf16x8, ATT_PACK(p1, 0)); pa3 = __builtin_bit_cast(bf16x8, ATT_PACK(p1, 8)); } while (0)
#define D_PV(SL_) do { const lds_cptr vq = vp + (SL_); \
    _Pragma("unroll") for (int d0 = 0; d0 < 4; ++d0) { s16x4 lo[4], hh[4]; \
      _Pragma("unroll") for (int ks = 0; ks < 4; ++ks) { lo[ks] = vtr(vq + d0 * 4096 + ks * 1024); hh[ks] = vtr(vq + d0 * 4096 + ks * 1024 + 512); } \
      o[d0] = __builtin_amdgcn_mfma_f32_32x32x16_bf16(pa0, ATT_VFR(lo[0], hh[0]), o[d0], 0, 0, 0); \
      o[d0] = __builtin_amdgcn_mfma_f32_32x32x16_bf16(pa1, ATT_VFR(lo[1], hh[1]), o[d0], 0, 0, 0); \
      o[d0] = __builtin_amdgcn_mfma_f32_32x32x16_bf16(pa2, ATT_VFR(lo[2], hh[2]), o[d0], 0, 0, 0); \
      o[d0] = __builtin_amdgcn_mfma_f32_32x32x16_bf16(pa3, ATT_VFR(lo[3], hh[3]), o[d0], 0, 0, 0); } } while (0)
  ATT_WAIT_BAR(8);
  bf16x8 kf[8];
  if (map == 1) asm volatile("s_barrier" ::: "memory");
  for (int t = 0; t < NT; ++t) {
    const int cur = (t & 3) * D_SLOT;
    D_KLD(cur);
    D_QKSM(t, cur);
    __builtin_amdgcn_sched_barrier(0);
    if (t + 2 < NT) { ATT_WAIT_BAR(4); } else { ATT_WAIT_BAR(0); }
    __builtin_amdgcn_sched_barrier(0);
    if (t + 3 < NT) D_DMA(t + 3, ((t + 3) & 3) * D_SLOT);
    D_PV(cur);
    __builtin_amdgcn_sched_barrier(0);
    asm volatile("s_waitcnt lgkmcnt(0)\n\ts_barrier" ::: "memory");
    __builtin_amdgcn_sched_barrier(0);
  }
  if (map == 0) asm volatile("s_barrier" ::: "memory");
#undef D_DMA
#undef D_KLD
#undef D_QKSM
#undef D_PV
  l = swap_sum(l);
  { const int te = fresh_tid(); const int lane = te & 63, r32 = lane & 31, hi = lane >> 5;
  LAS float* wsf = (LAS float*)(shm + D_WSF) + wid * 64;
  if (hi == 0) wsf[32 + r32] = (map == 1 ? lam : 1.f) / l;
  float inv[16];
#pragma unroll
  for (int r = 0; r < 16; ++r) inv[r] = wsf[32 + crow(r, hi)];
  ATT_WAIT_BAR(0);
  LAS float* X = (LAS float*)shm + wq * 4096;
  if (map == 1) {
#pragma unroll
    for (int d0 = 0; d0 < 4; ++d0)
#pragma unroll
      for (int r = 0; r < 16; ++r) X[(d0 * 16 + r) * 64 + lane] = o[d0][r] * inv[r];
  }
  ATT_WAIT_BAR(0);
  if (map == 0) {
    const bf16* Gw = (h >= 2 ? P15 + (h - 2) * 128 : P + pc(3584 + h * 128)) + qrow0 * PITCH;
    bf16* Yw = Y + qrow0 * YP + 512 + h * 128;
    float gs[4];
#pragma unroll
    for (int d0 = 0; d0 < 4; ++d0) gs[d0] = g_sub[d0 * 32 + r32] * 0.8f;
#pragma unroll
    for (int r = 0; r < 16; ++r) {
      float v[4]; float ss = 0.f;
#pragma unroll
      for (int d0 = 0; d0 < 4; ++d0) { v[d0] = o[d0][r] * inv[r] - X[(d0 * 16 + r) * 64 + lane]; ss += v[d0] * v[d0]; }
      ss += __shfl_xor(ss, 1); ss += __shfl_xor(ss, 2); ss += __shfl_xor(ss, 4); ss += __shfl_xor(ss, 8); ss += __shfl_xor(ss, 16);
      const float rstd = rsqrtf(ss * (1.f / 128.f) + 1e-6f);
      const int q = crow(r, hi);
#pragma unroll
      for (int d0 = 0; d0 < 4; ++d0) { const float g = bf2f(Gw[(long)q * PITCH + d0 * 32 + r32]);
        Yw[(long)q * YP + d0 * 32 + r32] = f2bf(v[d0] * rstd * gs[d0] * silu(g)); }
    }
  }
  }
  ATT_WAIT_BAR(0);
}

template <int DIL, int NBLK, int QSTEP>
__device__ __forceinline__ void dil_pattern(const bf16* __restrict__ Kb, const bf16* __restrict__ Vb, int S, int i0, int resid, const bf16x8 (&qr)[4], float& m, float& l, f32x16 (&o)[2],
                                            LAS char* vl, LAS float* wsf, int lane, int r32, int hi) {
  const int L = S / DIL;
  const int qidx = i0 + QSTEP * r32;
  const int lo_q = qidx - 64 < 0 ? 0 : qidx - 64, w_q = (qidx + 64 > L - 1 ? L - 1 : qidx + 64) - lo_q;
  const lds_cptr vq = (lds_cptr)vl + ((lane >> 4) & 1) * 32 + (lane & 3) * 8 + (4 * hi + ((lane & 15) >> 2)) * 64;
  const int lrow = lane >> 3, lch = lane & 7;
  LAS char* kw = vl + 4096 + lch * 512 + ((lrow ^ lch) * 16);
  LAS char* vw = vl + (lch >> 2) * 2048 + (lrow & 7) * 64 + (lch & 3) * 16;
  const lds_cptr kr_ = (lds_cptr)vl + 4096;
  int kb_lo = (64 - i0) >> 5; kb_lo = kb_lo < 0 ? 0 : kb_lo;
  int kb_hi = (L + 64 - i0 + 31) >> 5; kb_hi = kb_hi > NBLK ? NBLK : kb_hi;
  u32x4 kr[4], vr[4];
  f32x16 negm;
#pragma unroll
  for (int rr = 0; rr < 16; ++rr) negm[rr] = -m;
  asm volatile("" : "+v"(negm));
#define DIL_LOAD(KB_) do { const int kbase_ = i0 - 64 + 32 * (KB_); \
    _Pragma("unroll") for (int i = 0; i < 4; ++i) { int kx_ = kbase_ + 8 * i + lrow; kx_ = kx_ < 0 ? 0 : (kx_ >= L ? L - 1 : kx_); \
      const long ro_ = (long)(resid + DIL * kx_) * PITCH + lch * 8; \
      kr[i] = *reinterpret_cast<const u32x4*>(Kb + ro_); vr[i] = *reinterpret_cast<const u32x4*>(Vb + ro_); } } while (0)
  DIL_LOAD(kb_lo);
  for (int kb = kb_lo; kb < kb_hi; ++kb) {
    const int kbase = i0 - 64 + 32 * kb;
#pragma unroll
    for (int i = 0; i < 4; ++i) { *(LAS u32x4*)(kw + i * 128) = kr[i]; *(LAS u32x4*)(vw + (i >> 1) * 1024 + (i & 1) * 512) = vr[i]; }
    { const int kn = (kb + 1 < kb_hi) ? kb + 1 : kb; DIL_LOAD(kn); }
    f32x16 p0;
#pragma unroll
    for (int d0 = 0; d0 < 4; ++d0) { const int ch = 2 * d0 + hi;
      const bf16x8 kfr = *(const LAS bf16x8*)(kr_ + ch * 512 + ((r32 ^ ch) * 16));
      p0 = __builtin_amdgcn_mfma_f32_32x32x16_bf16(kfr, qr[d0], d0 == 0 ? negm : p0, 0, 0, 0); }
    float rm = -1e30f;
    { const int a0 = lo_q - kbase;
      if (!__all(a0 <= 0 && a0 + w_q >= 31)) { const int a1 = a0 - 4 * hi;
#pragma unroll
        for (int rr = 0; rr < 16; ++rr) { const bool ok = (unsigned)(((rr & 3) + 8 * (rr >> 2)) - a1) <= (unsigned)w_q; p0[rr] = ok ? p0[rr] : -1e30f; } }
      const float r0 = ATT_MX3(p0[0], p0[1], p0[2]), r1 = ATT_MX3(p0[3], p0[4], p0[5]), r2 = ATT_MX3(p0[6], p0[7], p0[8]), r3 = ATT_MX3(p0[9], p0[10], p0[11]), r4 = ATT_MX3(p0[12], p0[13], p0[14]);
      rm = fmaxf(ATT_MX3(r0, r1, r2), ATT_MX3(r3, r4, p0[15])); }
    rm = swap_max(rm);
    const bool first = (kb == kb_lo);
    if (first || __any(rm > 6.f)) {
      const float dl = first ? rm : fmaxf(rm, 0.f); m += dl;
#pragma unroll
      for (int rr = 0; rr < 16; ++rr) p0[rr] -= dl;
#pragma unroll
      for (int rr = 0; rr < 16; ++rr) negm[rr] = -m;
      asm volatile("" : "+v"(negm));
      if (!first) {
        const float f = __builtin_amdgcn_exp2f(-dl); l *= f;
        if (hi == 0) wsf[r32] = f;
#pragma unroll
        for (int rr = 0; rr < 16; ++rr) { const float fr_ = wsf[crow(rr, hi)]; o[0][rr] *= fr_; o[1][rr] *= fr_; }
      }
    }
    { float s0 = 0.f, s1 = 0.f;
      ATT_EXP2(p0[0], p0[1]);
#pragma unroll
      for (int rr = 2; rr < 16; rr += 2) ATT_EXP2_ADD2(p0[rr], p0[rr + 1], s0, s1, p0[rr - 2], p0[rr - 1]);
      ATT_ADD2(s0, s1, p0[14], p0[15]);
      l += s0 + s1; }
    const bf16x8 pa0 = __builtin_bit_cast(bf16x8, ATT_PACK(p0, 0)), pa1 = __builtin_bit_cast(bf16x8, ATT_PACK(p0, 8));
#pragma unroll
    for (int d0 = 0; d0 < 2; ++d0) {
      const s16x4 lo0 = vtr(vq + d0 * 2048), hi0 = vtr(vq + d0 * 2048 + 512), lo1 = vtr(vq + d0 * 2048 + 1024), hi1 = vtr(vq + d0 * 2048 + 1536);
      o[d0] = __builtin_amdgcn_mfma_f32_32x32x16_bf16(pa0, ATT_VFR(lo0, hi0), o[d0], 0, 0, 0);
      o[d0] = __builtin_amdgcn_mfma_f32_32x32x16_bf16(pa1, ATT_VFR(lo1, hi1), o[d0], 0, 0, 0);
    }
  }
#undef DIL_LOAD
}
__device__ __forceinline__ void dil_q(bf16x8 (&qr)[4], const bf16* __restrict__ Qb, long tok, int hi) {
#pragma unroll
  for (int d0 = 0; d0 < 4; ++d0) qr[d0] = *reinterpret_cast<const bf16x8*>(Qb + tok * PITCH + d0 * 16 + hi * 8);
}
__device__ __forceinline__ void dil_item_a(const bf16* __restrict__ P, long rowbase, int S, int h, int c, int r, LAS char* vl, LAS float* wsf, LAS bf16* OA, LAS float* ML, const bf16x8 (&qr)[4]) {
  const int lane = fresh_tid() & 63, r32 = lane & 31, hi = lane >> 5;
  const bf16* Kb = P + pc(512 + h * 64) + rowbase * PITCH; const bf16* Vb = P + pc(1024 + h * 64) + rowbase * PITCH;
  float m = 0.f, l = 0.f; f32x16 o[2]; o[0] = f32x16{}; o[1] = f32x16{};
  dil_pattern<16, 5, 1>(Kb, Vb, S, 32 * c, r, qr, m, l, o, vl, wsf, lane, r32, hi);
  l = swap_sum(l);
  if (hi == 0) { wsf[32 + r32] = 1.f / l; ML[(r + 16 * r32) * 2] = m; ML[(r + 16 * r32) * 2 + 1] = l; }
#pragma unroll
  for (int rr = 0; rr < 16; ++rr) { const float iv = wsf[32 + crow(rr, hi)]; const int tl = r + 16 * crow(rr, hi);
#pragma unroll
    for (int d0 = 0; d0 < 2; ++d0) OA[tl * 64 + d0 * 32 + r32] = f2bf(o[d0][rr] * iv); }
}
__device__ __forceinline__ void dil_item_m(const bf16* __restrict__ P, long rowbase, int S, int h, int c, int g, LAS char* vl, LAS float* wsf, LAS bf16* OA, LAS float* ML, const bf16x8 (&qr)[4]) {
  const int lane = fresh_tid() & 63, r32 = lane & 31, hi = lane >> 5;
  const int r4 = g & 3, jb = g >> 2;
  const bf16* Kb = P + pc(512 + h * 64) + rowbase * PITCH; const bf16* Vb = P + pc(1024 + h * 64) + rowbase * PITCH;
  const int tl0 = r4 + 128 * jb;
  float m = 0.f, l = 0.f; f32x16 o[2]; o[0] = f32x16{}; o[1] = f32x16{};
  dil_pattern<4, 5, 1>(Kb, Vb, S, 128 * c + 32 * jb, r4, qr, m, l, o, vl, wsf, lane, r32, hi);
  l = swap_sum(l);
  if (hi == 0) {
    const int tl = tl0 + 4 * r32;
    const float ma = ML[tl * 2], la = ML[tl * 2 + 1];
    const float mm = fmaxf(ma, m), wa = la * __builtin_amdgcn_exp2f(ma - mm), wb = __builtin_amdgcn_exp2f(m - mm);
    const float den = wa + l * wb, rden = 1.f / den;
    wsf[r32] = wa * rden; wsf[32 + r32] = wb * rden; ML[tl * 2] = mm; ML[tl * 2 + 1] = den; }
#pragma unroll
  for (int rr = 0; rr < 16; ++rr) { const int q = crow(rr, hi); const float fa = wsf[q], fb = wsf[32 + q]; const int tl = tl0 + 4 * q;
#pragma unroll
    for (int d0 = 0; d0 < 2; ++d0) { const float oa = bf2f(OA[tl * 64 + d0 * 32 + r32]); OA[tl * 64 + d0 * 32 + r32] = f2bf(oa * fa + o[d0][rr] * fb); } }
}
__device__ __forceinline__ void dil_item_b(const bf16* __restrict__ P, bf16* __restrict__ Y, long rowbase, int S, int h, int c, int j, LAS char* vl, LAS float* wsf, const LAS bf16* OA, const LAS float* ML, const bf16x8 (&qr)[4]) {
  const int lane = fresh_tid() & 63, r32 = lane & 31, hi = lane >> 5;
  const bf16* Kb = P + pc(512 + h * 64) + rowbase * PITCH; const bf16* Vb = P + pc(1024 + h * 64) + rowbase * PITCH; const bf16* Gb = P + pc(1536 + h * 64) + rowbase * PITCH;
  const int tq0 = 512 * c + 32 * j;
  float m = 0.f, l = 0.f; f32x16 o[2]; o[0] = f32x16{}; o[1] = f32x16{};
  dil_pattern<1, 5, 1>(Kb, Vb, S, tq0, 0, qr, m, l, o, vl, wsf, lane, r32, hi);
  l = swap_sum(l);
  if (hi == 0) {
    const float ma = ML[(32 * j + r32) * 2], la = ML[(32 * j + r32) * 2 + 1];
    const float mm = fmaxf(ma, m), wa = la * __builtin_amdgcn_exp2f(ma - mm), wb = __builtin_amdgcn_exp2f(m - mm);
    const float rden = 1.f / (wa + l * wb);
    wsf[r32] = wa * rden; wsf[32 + r32] = wb * rden; }
  bf16* Yb = Y + rowbase * YP + h * 64;
#pragma unroll
  for (int rr = 0; rr < 16; ++rr) { const int q = crow(rr, hi); const float fa = wsf[q], fb = wsf[32 + q]; const long tok = tq0 + q;
#pragma unroll
    for (int d0 = 0; d0 < 2; ++d0) { const float g = bf2f(Gb[tok * PITCH + d0 * 32 + r32]); const float oa = bf2f(OA[(32 * j + q) * 64 + d0 * 32 + r32]);
      Yb[tok * YP + d0 * 32 + r32] = f2bf((oa * fa + o[d0][rr] * fb) * silu(g)); } }
}
}
typedef unsigned short bf16;
typedef float f32x4g __attribute__((ext_vector_type(4)));
typedef unsigned v4u __attribute__((ext_vector_type(4)));
constexpr int NTOK = 65536, DMODEL = 1024, DPROJ = 4096, NBATCH = 20, NPROMPT_ROWS = 32768;
constexpr size_t MiB = 1u << 20;
constexpr size_t WS_PROJ = 0, WS_Y = 0, WS_SSQ = 128 * MiB, WS_GATE = 132 * MiB, WS_NEED = 512 * MiB;
constexpr size_t DO_H = 0, DO_WIN = 128 * MiB, DO_WOUT = 136 * MiB, DO_MOD = 138 * MiB, DO_ROPE = 139 * MiB, DO_MISC = 140 * MiB;
constexpr size_t DO_P15 = 142 * MiB;
constexpr size_t WS_BAR = 480 * MiB;
constexpr int LDS_XB = 147392;
constexpr int LDS_BYTES = 147456;
#define XB_TMO      128
#define XB_XCNT(j)  (256  + 64 * (j))
#define XB_XSUB(j)  (1280 + 64 * (j))
#define XB_XGEN(j)  (2304 + 64 * (j))
#define XB_TOP      3328
#define XB_TOPGEN   3392
#define XCD_BAR_WORDS 3456
#define XB_SPIN_CAP (1u << 18)

__device__ __forceinline__ unsigned xb_ld(unsigned* p)              { return __hip_atomic_load(p, __ATOMIC_RELAXED, __HIP_MEMORY_SCOPE_AGENT); }
__device__ __forceinline__ unsigned xb_add(unsigned* p, unsigned v) { return __hip_atomic_fetch_add(p, v, __ATOMIC_RELAXED, __HIP_MEMORY_SCOPE_AGENT); }
__device__ __forceinline__ unsigned xb_xcc_id() { return (unsigned)__builtin_amdgcn_s_getreg((3 << 11) | 20) & 0xFu; }
#define XB_SPIN(cond, bar) do { unsigned _sp = 0; while (cond) { __builtin_amdgcn_s_sleep(1); \
    if ((++_sp & 255u) == 0u) { if (xb_ld(&(bar)[XB_TMO])) break; if (_sp > XB_SPIN_CAP) { atomicAdd(&(bar)[XB_TMO], 1u); break; } } } } while (0)

struct XcdBarrier {
    unsigned* bar; unsigned x;
    volatile LAS unsigned* st;
};

__device__ __forceinline__ XcdBarrier xcd_barrier_post(unsigned* bar, volatile LAS unsigned* st) {
    XcdBarrier b; b.bar = bar; b.x = xb_xcc_id(); b.st = st;
    if (threadIdx.x == 0) (void)xb_add(&bar[XB_XCNT(b.x)], 1u);
    return b;
}
__device__ __forceinline__ void xcd_barrier_complete(unsigned* bar, unsigned x, unsigned& nloc, unsigned& nx) {
    const unsigned G = gridDim.x * gridDim.y * gridDim.z;
    unsigned sum, cnt, mine, sp = 0u;
    for (;;) {
        sum = 0u; cnt = 0u; mine = 0u;
#pragma unroll
        for (unsigned j = 0; j < 16; ++j) { const unsigned c = xb_ld(&bar[XB_XCNT(j)]); sum += c; cnt += (c > 0u) ? 1u : 0u; mine = (j == x) ? c : mine; }
        if (sum == G) break;
        __builtin_amdgcn_s_sleep(1);
        if ((++sp & 255u) == 0u) { if (xb_ld(&bar[XB_TMO])) break; if (sp > XB_SPIN_CAP) { atomicAdd(&bar[XB_TMO], 1u); break; } }
    }
    nloc = mine > 0u ? mine : 1u; nx = cnt > 0u ? cnt : 1u;
}

__device__ __forceinline__ void xcd_barrier(const XcdBarrier& b) {
    asm volatile("s_waitcnt vmcnt(0)" ::: "memory");
    __syncthreads();
    if (threadIdx.x == 0) {
        unsigned* bar = b.bar;
        __builtin_amdgcn_s_waitcnt(0);
        unsigned nloc = b.st[0], nx = b.st[1];
        if (nloc == 0u) { xcd_barrier_complete(bar, b.x, nloc, nx); b.st[0] = nloc; b.st[1] = nx; }
        const unsigned old = xb_add(&bar[XB_XSUB(b.x)], 1u);
        const unsigned gen = old / nloc;
        if (old + 1u == (gen + 1u) * nloc) {
            __builtin_amdgcn_fence(__ATOMIC_RELEASE, "agent");
            asm volatile("s_waitcnt vmcnt(0)" ::: "memory");
            const unsigned og = xb_add(&bar[XB_TOP], 1u);
            const unsigned tg = og / nx;
            if (og + 1u == (tg + 1u) * nx) xb_add(&bar[XB_TOPGEN], 1u);
            else XB_SPIN(xb_ld(&bar[XB_TOPGEN]) == tg, bar);
            __builtin_amdgcn_fence(__ATOMIC_ACQUIRE, "agent");
            xb_add(&bar[XB_XGEN(b.x)], 1u);
            asm volatile("s_waitcnt vmcnt(0)" ::: "memory");
        } else {
            XB_SPIN(xb_ld(&bar[XB_XGEN(b.x)]) == gen, bar);
            __builtin_amdgcn_fence(__ATOMIC_ACQUIRE, "agent");
            asm volatile("s_waitcnt vmcnt(0)" ::: "memory");
        }
    }
    __syncthreads();
}

struct Params { const float* in[15]; float* out; unsigned char* ws; int mask; int pad; };

__device__ __forceinline__ unsigned f2bf_u(float f) { unsigned u = __builtin_bit_cast(unsigned, f); return (u + 0x7fffu + ((u >> 16) & 1u)) >> 16; }
__device__ __forceinline__ unsigned pk2(float lo, float hi) { return f2bf_u(lo) | (f2bf_u(hi) << 16); }
__device__ __forceinline__ float wave_sum(float v) {
#pragma unroll
    for (int o = 1; o < 64; o <<= 1) v += __shfl_xor(v, o);
    return v;
}
__device__ __forceinline__ void transpose_item(const float* W, int K, int N, bf16* WT, LAS float* scr, int item, int lane) {
    const int nblk = N / 32, kb = item / nblk, nb = item % nblk, k0 = 64 * kb, n0 = 32 * nb;
#pragma unroll 8
    for (int i = 0; i < 32; ++i) { const int kk = 2 * i + (lane >> 5); scr[kk * 33 + (lane & 31)] = W[(size_t)(k0 + kk) * N + n0 + (lane & 31)]; }
    asm volatile("s_waitcnt lgkmcnt(0)" ::: "memory");
    const int c = lane & 7;
#pragma unroll
    for (int j = 0; j < 4; ++j) { const int n = (lane >> 3) + 8 * j; const LAS float* s = scr + (8 * c) * 33 + n;
        v4u o; o.x = pk2(s[0 * 33], s[1 * 33]); o.y = pk2(s[2 * 33], s[3 * 33]); o.z = pk2(s[4 * 33], s[5 * 33]); o.w = pk2(s[6 * 33], s[7 * 33]);
        *(v4u*)(WT + (size_t)(n0 + n) * K + k0 + 8 * c) = o; }
    asm volatile("s_waitcnt lgkmcnt(0)" ::: "memory");
}
__device__ __forceinline__ const float* xrow_ptr(const Params& p, int row) { return row < NPROMPT_ROWS ? p.in[0] + (size_t)row * DMODEL : p.in[1] + (size_t)(row - NPROMPT_ROWS) * DMODEL; }
__device__ __forceinline__ int row_batch(int row) { return row < NPROMPT_ROWS ? (row >> 13) : 4 + ((row - NPROMPT_ROWS) >> 11); }

__global__ void __launch_bounds__(512, 2) mega_fwd(Params p) {
    extern __shared__ __attribute__((aligned(16))) unsigned char lds_raw[];
    LAS unsigned char* lds = (LAS unsigned char*)lds_raw;
    cg::grid_group grid = cg::this_grid();
    const int tid = threadIdx.x, lane = tid & 63, wave = __builtin_amdgcn_readfirstlane(tid >> 6);
    const int G = gridDim.x, bx = blockIdx.x;
    const int vcu = (G % 8 == 0) ? (bx % 8) * (G / 8) + bx / 8 : bx;
    unsigned char* dob = (unsigned char*)p.out;
    bf16* H = (bf16*)(dob + DO_H); bf16* WIN = (bf16*)(dob + DO_WIN); bf16* WOUT = (bf16*)(dob + DO_WOUT);
    float* MOD = (float*)(dob + DO_MOD); float* ROPE = (float*)(dob + DO_ROPE); float* MISC = (float*)(dob + DO_MISC);
    bf16* PROJ = (bf16*)(p.ws + WS_PROJ); bf16* P15 = (bf16*)(dob + DO_P15); bf16* YB = (bf16*)(p.ws + WS_Y); float* SSQ = (float*)(p.ws + WS_SSQ); float* GATE = (float*)(p.ws + WS_GATE);
    const int gw = vcu * 8 + wave, NGW = G * 8;
    { unsigned* bw = (unsigned*)(p.ws + WS_BAR); for (int i = bx * 512 + tid; i < XCD_BAR_WORDS; i += G * 512) bw[i] = 0u; }
    if (tid < 2) ((volatile LAS unsigned*)(lds + LDS_XB))[tid] = 0u;

    asm volatile(".p2align 8\n\t.rept " PAD_STR(PAD_P0A) "\n\ts_nop 0\n\t.endr");
    if (p.mask & 1) {
        for (int e = bx * 512 + tid; e < 8192 * 8; e += G * 512) {
            const int pos = e >> 3, i = e & 7;
            const float inv = exp2f(-(float)i * (1.0f / 8.0f) * 18.931568569324174f);
            const float ang = (float)pos * inv;
            const double ad = (double)ang; const double n = rint(ad * 0.15915494309189535); const float red = (float)(ad - n * 6.283185307179586);
            ROPE[2 * e] = cosf(red); ROPE[2 * e + 1] = sinf(red);
        }
        __syncthreads();
        if (bx < 192) {
            LAS float* sc = (LAS float*)lds;
            LAS float* red = (LAS float*)(lds + 81920);
            { float cvv[NBATCH * 2];
#pragma unroll
              for (int q = 0; q < NBATCH * 2; ++q) { const int i = tid + 512 * q; const int b = i >> 10, k = i & 1023; cvv[q] = b < 4 ? p.in[2][b * DMODEL + k] : p.in[3][(b - 4) * DMODEL + k]; }
#pragma unroll
              for (int q = 0; q < NBATCH * 2; ++q) sc[tid + 512 * q] = cvv[q] / (1.f + __expf(-cvv[q])); }
            __syncthreads();
            const int col = tid & 15, ks = tid >> 4, j = bx * 16 + col;
            float acc[NBATCH];
#pragma unroll
            for (int b = 0; b < NBATCH; ++b) acc[b] = 0.f;
            float wv[32];
#pragma unroll
            for (int i = 0; i < 32; ++i) wv[i] = p.in[8][(size_t)(ks + 32 * i) * 3072 + j];
#pragma unroll
            for (int i = 0; i < 32; ++i) {
#pragma unroll
                for (int b = 0; b < NBATCH; ++b) acc[b] += sc[b * DMODEL + ks + 32 * i] * wv[i]; }
#pragma unroll
            for (int b = 0; b < NBATCH; ++b) red[(ks * NBATCH + b) * 16 + col] = acc[b];
            __syncthreads();
            if (tid < NBATCH * 16) { const int b = tid >> 4, cc = tid & 15; float s = 0.f;
                for (int k2 = 0; k2 < 32; ++k2) s += red[(k2 * NBATCH + b) * 16 + cc];
                MOD[b * 3072 + bx * 16 + cc] = s + p.in[9][bx * 16 + cc]; }
        }
        if (bx == G - 1 && wave == 0) {
            const float a = wave_sum(p.in[10][lane] * p.in[11][lane]), b2 = wave_sum(p.in[12][lane] * p.in[13][lane]);
            if (lane == 0) MISC[0] = expf(a) - expf(b2) + 0.2f;
        }
    }
    asm volatile("s_waitcnt vmcnt(0)\n\ts_nop 0" ::: "memory");
    grid.sync();
    const XcdBarrier xbar = xcd_barrier_post((unsigned*)(p.ws + WS_BAR), (volatile LAS unsigned*)(lds + LDS_XB));
    asm volatile(".p2align 8\n\t.rept " PAD_STR(PAD_P0B) "\n\ts_nop 0\n\t.endr");
    if (p.mask & 2) { const int lane = att::fresh_tid() & 63;
    f32x4g gpre[4];
#pragma unroll
    for (int j = 0; j < 4; ++j) gpre[j] = ((const f32x4g*)p.in[6])[lane + 64 * j];
    for (int rb = gw; rb < NTOK; rb += 4 * NGW) {
        f32x4g v[4][4];
#pragma unroll
        for (int q = 0; q < 4; ++q) { const int row = rb + q * NGW; if (row < NTOK) { const f32x4g* xr = (const f32x4g*)xrow_ptr(p, row) + lane;
#pragma unroll
            for (int j = 0; j < 4; ++j) v[q][j] = __builtin_nontemporal_load(&xr[64 * j]); } }
#pragma unroll
        for (int q = 0; q < 4; ++q) { const int row = rb + q * NGW; if (row < NTOK) {
            const int b = row_batch(row); float s = 0.f;
#pragma unroll
            for (int j = 0; j < 4; ++j) s += (v[q][j].x * v[q][j].x + v[q][j].y * v[q][j].y) + (v[q][j].z * v[q][j].z + v[q][j].w * v[q][j].w);
            const float rstd = rsqrtf(wave_sum(s) * (1.f / DMODEL) + 1e-6f);
            unsigned long long* o8 = (unsigned long long*)(H + (size_t)row * DMODEL) + lane;
#pragma unroll
            for (int j = 0; j < 4; ++j) {
                const f32x4g sh = ((const f32x4g*)(MOD + b * 3072))[lane + 64 * j], sl = ((const f32x4g*)(MOD + b * 3072 + 1024))[lane + 64 * j];
                const f32x4g hv = v[q][j] * rstd * gpre[j] * (sl + 1.f) + sh;
                o8[64 * j] = (unsigned long long)pk2(hv.x, hv.y) | ((unsigned long long)pk2(hv.z, hv.w) << 32);
            } } }
    }
    {
        LAS float* scr = (LAS float*)(lds + wave * 16384);
        constexpr int I_IN = (DMODEL / 64) * (DPROJ / 32), I_OUT = (DMODEL / 64) * (DMODEL / 32);
        for (int it = gw; it < I_IN + I_OUT; it += NGW) {
            if (it < I_IN) transpose_item(p.in[4], DMODEL, DPROJ, WIN, scr, it, lane);
            else transpose_item(p.in[5], DMODEL, DMODEL, WOUT, scr, it - I_IN, lane);
        }
    } }
    xcd_barrier(xbar);
#ifndef NO_P1
    asm volatile(".p2align 8\n\t.rept " PAD_STR(PAD_P1) "\n\ts_nop 0\n\t.endr");
    if (p.mask & 4) {
        pg8::Gemm g{H, WIN, NTOK, DPROJ, DMODEL}; pg8::StaticOrder S; S.init(NTOK, DPROJ, G, bx);
        pg8::EpiProj E{PROJ, 256, ROPE, P15};
        pg8::gemm_phase<pg8::EpiProj, pg8::StaticOrder, true, true>(lds, g, S, E);
    }
#endif
    xcd_barrier(xbar);
    {
        bf16* YM = H;
        const float lam = MISC[0];
#ifndef NO_DIFF
    asm volatile(".p2align 8\n\t.rept " PAD_STR(PAD_DIFF) "\n\ts_nop 0\n\t.endr");
        if (p.mask & 8)
        for (int u = vcu; u < 2048; u += G) {
            int bh, qt, S; long rowbase;
            if (u < 1024) { bh = (u & 255) >> 4; qt = (u & 15) * 4 + (u >> 8); S = 8192; rowbase = (long)(bh >> 2) * 8192; }
            else { const int u2 = u - 1024; bh = (u2 & 255) >> 2; qt = (u2 & 3) * 4 + (u2 >> 8); S = 2048; rowbase = NPROMPT_ROWS + (long)(bh >> 2) * 2048; }
            att::diff_unit(PROJ, YM, rowbase, S, bh & 3, qt, (LAS char*)lds, lam, p.in[14], P15);
        }
#endif
#ifndef NO_DIL
        LAS char* vl = (LAS char*)lds + wave * 8448; LAS float* wsf = (LAS float*)(lds + wave * 8448 + 8192);
        LAS att::bf16* OA = (LAS att::bf16*)(lds + 67584); LAS float* ML = (LAS float*)(lds + 67584 + 65536);
    asm volatile(".p2align 8\n\t.rept " PAD_STR(PAD_DIL) "\n\ts_nop 0\n\t.endr");
        if (p.mask & 16)
        for (int u = vcu; u < 1024; u += G) {
            int b, h, c, S; long rowbase;
            if (u < 512) { const int id = (u & 255) * 2 + (u >> 8); c = id & 15; h = (id >> 4) & 7; b = id >> 7; S = 8192; rowbase = (long)b * 8192; }
            else { const int u2 = u - 512; const int id = (u2 & 255) * 2 + (u2 >> 8); c = id & 3; h = (id >> 2) & 7; b = id >> 5; S = 2048; rowbase = NPROMPT_ROWS + (long)b * 2048; }
            {
                const int ln = att::fresh_tid() & 63, r32 = ln & 31, hi = ln >> 5;
                const att::bf16* Qb = PROJ + att::pc(h * 64) + rowbase * att::PITCH;
                const long t0 = 512L * c;
                att::bf16x8 q0[4], q1[4];
                att::dil_q(q0, Qb, t0 + wave + 16 * r32, hi); att::dil_q(q1, Qb, t0 + wave + 8 + 16 * r32, hi);
                att::dil_item_a(PROJ, rowbase, S, h, c, wave, vl, wsf, OA, ML, q0);
                att::dil_item_a(PROJ, rowbase, S, h, c, wave + 8, vl, wsf, OA, ML, q1);
                { const int g0 = wave, g1 = wave + 8;
                  att::dil_q(q0, Qb, t0 + (g0 & 3) + 128 * (g0 >> 2) + 4 * r32, hi); att::dil_q(q1, Qb, t0 + (g1 & 3) + 128 * (g1 >> 2) + 4 * r32, hi); }
                __syncthreads();
                att::dil_item_m(PROJ, rowbase, S, h, c, wave, vl, wsf, OA, ML, q0);
                att::dil_item_m(PROJ, rowbase, S, h, c, wave + 8, vl, wsf, OA, ML, q1);
                att::dil_q(q0, Qb, t0 + 32 * wave + r32, hi); att::dil_q(q1, Qb, t0 + 32 * (wave + 8) + r32, hi);
                __syncthreads();
                att::dil_item_b(PROJ, YM, rowbase, S, h, c, wave, vl, wsf, OA, ML, q0);
                att::dil_item_b(PROJ, YM, rowbase, S, h, c, wave + 8, vl, wsf, OA, ML, q1);
            }
            __syncthreads();
        }
#endif
    }
    xcd_barrier(xbar);
    asm volatile(".p2align 8\n\t.rept " PAD_STR(PAD_P3) "\n\ts_nop 0\n\t.endr");
    if (p.mask & 32) {
        for (int i = bx * 512 + tid; i < NBATCH * DMODEL; i += G * 512) GATE[i] = MOD[(i >> 10) * 3072 + 2048 + (i & 1023)];
#ifndef NO_P3
        pg8::Gemm g{H, WOUT, NTOK, DMODEL, DMODEL}; pg8::StaticOrder S; S.init(NTOK, DMODEL, G, bx);
        pg8::EpiY E{YB, DMODEL, SSQ};
        pg8::gemm_phase<pg8::EpiY, pg8::StaticOrder, true, true>(lds, g, S, E);
#endif
    }
    xcd_barrier(xbar);
    asm volatile(".p2align 8\n\t.rept " PAD_STR(PAD_P4) "\n\ts_nop 0\n\t.endr");
    if (p.mask & 64) { const int lane = att::fresh_tid() & 63;
    f32x4g gpo[4];
#pragma unroll
    for (int j = 0; j < 4; ++j) gpo[j] = ((const f32x4g*)p.in[7])[lane + 64 * j];
    for (int rb = gw; rb < NTOK; rb += 2 * NGW) {
        f32x4g xv[2][4]; unsigned long long yv[2][4]; float sq[2];
#pragma unroll
        for (int q = 0; q < 2; ++q) { const int row = rb + q * NGW; if (row < NTOK) { const f32x4g* xr = (const f32x4g*)xrow_ptr(p, row) + lane;
            const unsigned long long* y8 = (const unsigned long long*)(YB + (size_t)row * DMODEL) + lane;
            sq[q] = lane < 16 ? SSQ[(size_t)row * 16 + lane] : 0.f;
#pragma unroll
            for (int j = 0; j < 4; ++j) { xv[q][j] = __builtin_nontemporal_load(&xr[64 * j]); yv[q][j] = __builtin_nontemporal_load(&y8[64 * j]); } } }
#pragma unroll
        for (int q = 0; q < 2; ++q) { const int row = rb + q * NGW; if (row < NTOK) {
            const int b = row_batch(row);
            const float rstd = rsqrtf(wave_sum(sq[q]) * (1.f / DMODEL) + 1e-6f);
            f32x4g* orow = (f32x4g*)(p.out + (size_t)row * DMODEL) + lane;
#pragma unroll
            for (int j = 0; j < 4; ++j) {
                const unsigned long long w = yv[q][j];
                f32x4g y; y.x = __uint_as_float(((unsigned)w) << 16); y.y = __uint_as_float(((unsigned)w) & 0xffff0000u);
                y.z = __uint_as_float(((unsigned)(w >> 32)) << 16); y.w = __uint_as_float(((unsigned)(w >> 32)) & 0xffff0000u);
                const f32x4g gt = ((const f32x4g*)(GATE + b * DMODEL))[lane + 64 * j];
                __builtin_nontemporal_store(xv[q][j] + gt * (y * rstd) * gpo[j], &orow[64 * j]);
            } } }
    } }
}

extern "C" void kernel_launch(void* const* d_in, const int* in_sizes, int n_in, void* d_out, int out_size, void* d_ws, size_t ws_size, hipStream_t stream) {
    static int grid = 0;
    if (grid == 0) {
        if (n_in != 15 || ws_size < WS_NEED || out_size != NTOK * DMODEL) { fprintf(stderr, "kernel_launch: unexpected shapes (n_in %d, ws %zu, out %d)\n", n_in, ws_size, out_size); grid = -1; return; }
        int dev = 0, cus = 0, per_cu = 0;
        hipGetDevice(&dev); hipDeviceGetAttribute(&cus, hipDeviceAttributeMultiprocessorCount, dev);
        hipFuncSetAttribute((const void*)mega_fwd, hipFuncAttributeMaxDynamicSharedMemorySize, LDS_BYTES);
        hipOccupancyMaxActiveBlocksPerMultiprocessor(&per_cu, (const void*)mega_fwd, 512, LDS_BYTES);
        (void)hipGetLastError();
        if (per_cu < 1) per_cu = 1;
        grid = cus;
    }
    if (grid < 0) return;
    Params p{};
    for (int i = 0; i < 15; ++i) p.in[i] = (const float*)d_in[i];
    p.out = (float*)d_out; p.ws = (unsigned char*)d_ws; p.mask = 127;
#ifdef PROBE_MASK
    { Params p2 = p; p2.mask = PROBE_MASK; void* args2[] = {&p2}; (void)hipLaunchCooperativeKernel((const void*)mega_fwd, dim3(grid), dim3(512), args2, LDS_BYTES, stream); }
#endif
    void* args[] = {&p};
    hipError_t e = hipLaunchCooperativeKernel((const void*)mega_fwd, dim3(grid), dim3(512), args, LDS_BYTES, stream);
    if (e != hipSuccess) fprintf(stderr, "cooperative launch failed: %s (grid %d)\n", hipGetErrorString(e), grid);
}
```

```cpp
#include <hip/hip_runtime.h>
#include <hip/hip_cooperative_groups.h>
#include <cstdio>
#include <cstdint>
namespace cg = cooperative_groups;
#define PAD_STR2(x) #x
#define PAD_STR(x) PAD_STR2(x)
#define PAD_P0A 0
#define PAD_P0B 0
#define PAD_P1 0
#define PAD_DIFF 0
#define PAD_DIL 0
#define PAD_P3 0
#define PAD_P4 0
constexpr float QK_C2 = 0.125f * 1.4426950408889634f;
namespace pg8 {
#define PG8_LAS __attribute__((address_space(3)))
typedef unsigned short bf16_t;
typedef short bf16x8 __attribute__((ext_vector_type(8)));
typedef float f32x4 __attribute__((ext_vector_type(4)));
typedef unsigned u32x4 __attribute__((ext_vector_type(4)));
constexpr int BM = 256, BK = 64, HALF = 128, HTB = HALF * BK * 2  , STAGE_BYTES = 8 * HTB, NXCD = 8, WGM = 8;

__host__ __device__ __forceinline__ int lds_byte(int r, int c) { const int st = (r >> 4) * 2 + (c >> 5), rr = r & 15, cc = c & 31, ob = rr * 64 + cc * 2; return st * 1024 + (ob ^ (((ob >> 9) & 1) << 5)); }
__host__ __device__ __forceinline__ void stage_rc(int b, int& R, int& C) { const int st = b / 1024, sb = b % 1024, swz = sb ^ (((sb >> 9) & 1) << 5); R = (st >> 1) * 16 + swz / 64; C = (st & 1) * 32 + (swz % 64) / 2; }
__host__ __device__ __forceinline__ int perm32(int rho) { const int n = rho >> 4, i = rho & 15; return 8 * (i >> 2) + 4 * n + (i & 3); }

struct Unit { int pm, pn; };
struct Gemm { const bf16_t* A; const bf16_t* Bt; int M, N, K; };

struct StaticOrder {
    int nM, nN, nwg, G, c;
    __host__ __device__ void init(int M, int N, int G_, int c_) { nM = M / BM; nN = N / BM; nwg = nM * nN; G = G_; c = c_; }
    __host__ __device__ bool next(int i, Unit& u) const {
        const long L = (long)i * G + c; if (L >= nwg) return false;
        int wgid = (int)L; { const int q = nwg / NXCD, r = nwg % NXCD, xcd = wgid % NXCD, off = wgid / NXCD; wgid = (xcd < r ? xcd * (q + 1) : r * (q + 1) + (xcd - r) * q) + off; }
        const int nig = WGM * nN, gid = wgid / nig, fm = gid * WGM, gsz = (nM - fm) < WGM ? (nM - fm) : WGM;
        u.pm = fm + ((wgid % nig) % gsz); u.pn = (wgid % nig) / gsz; return true;
    }
    __device__ __forceinline__ void a_ready(const Unit&) const {}
    __device__ __forceinline__ void done(const Unit&) const {}
};

__device__ __forceinline__ unsigned cvt_pk_bf16(float lo, float hi) { unsigned r; asm volatile("v_cvt_pk_bf16_f32 %0, %1, %2" : "=v"(r) : "v"(lo), "v"(hi)); return r; }
struct EpiProj {
    static constexpr bool PERM = true, AFTER_DRAIN = false;
    bf16_t* O; int ldc; const float* rope; bf16_t* O15;
    __device__ __forceinline__ void operator()(const f32x4 (&acc)[2][2][4][2], const Unit& u, int wr, int wc, int fr, int fq) const {
        const int row0 = u.pm * BM + wr * 64 + fr;
        const bool tile_rope = (u.pn & 4) == 0;
        const bool lane_rope = tile_rope && ((wc & 1) == 0) && (fq < 2);
        const float sc = ((u.pn & 6) == 0) ? QK_C2 : 1.f;
        const float sgn = (fq == 0) ? -1.f : 1.f;
        const int col0 = wc * 32 + 8 * fq;
        bf16_t* const Op = (u.pn == 15) ? O15 : O + (size_t)u.pn * ((size_t)65536 * 256);
#pragma unroll
        for (int ai = 0; ai < 2; ++ai)
#pragma unroll
            for (int m = 0; m < 4; ++m) {
                const int row = row0 + ai * HALF + m * 16;
                const int pos = row < 32768 ? (row & 8191) : (row & 2047);
                f32x4 cs[4];
                if (tile_rope) {
#pragma unroll
                    for (int q = 0; q < 4; ++q) cs[q] = *(const f32x4*)(rope + (size_t)pos * 16 + q * 4);
                }
                bf16_t* rowp = Op + (size_t)row * ldc + col0;
#pragma unroll
                for (int bj = 0; bj < 2; ++bj) {
                    f32x4 v0 = acc[ai][bj][m][0], v1 = acc[ai][bj][m][1];
                    if (tile_rope) {
                        f32x4 p0, p1;
#pragma unroll
                        for (int j = 0; j < 4; ++j) { p0[j] = __shfl_xor(v0[j], 16); p1[j] = __shfl_xor(v1[j], 16); }
                        if (lane_rope) {
                            v0[0] = v0[0] * cs[0][0] + sgn * p0[0] * cs[0][1]; v0[1] = v0[1] * cs[0][2] + sgn * p0[1] * cs[0][3];
                            v0[2] = v0[2] * cs[1][0] + sgn * p0[2] * cs[1][1]; v0[3] = v0[3] * cs[1][2] + sgn * p0[3] * cs[1][3];
                            v1[0] = v1[0] * cs[2][0] + sgn * p1[0] * cs[2][1]; v1[1] = v1[1] * cs[2][2] + sgn * p1[1] * cs[2][3];
                            v1[2] = v1[2] * cs[3][0] + sgn * p1[2] * cs[3][1]; v1[3] = v1[3] * cs[3][2] + sgn * p1[3] * cs[3][3];
                        }
                    }
                    v0 = v0 * sc; v1 = v1 * sc;
                    u32x4 w; w.x = cvt_pk_bf16(v0[0], v0[1]); w.y = cvt_pk_bf16(v0[2], v0[3]); w.z = cvt_pk_bf16(v1[0], v1[1]); w.w = cvt_pk_bf16(v1[2], v1[3]);
                    __builtin_nontemporal_store(w, (u32x4*)(rowp + bj * HALF));
                }
            }
    }
};
struct EpiY {
    static constexpr bool PERM = true, AFTER_DRAIN = false;
    bf16_t* O; int ldc; float* ssq;
    __device__ __forceinline__ void operator()(const f32x4 (&acc)[2][2][4][2], const Unit& u, int wr, int wc, int fr, int fq) const {
        const int row0 = u.pm * BM + wr * 64 + fr;
        const int col0 = u.pn * BM + wc * 32 + 8 * fq;
#pragma unroll
        for (int ai = 0; ai < 2; ++ai)
#pragma unroll
            for (int m = 0; m < 4; ++m) {
                const int row = row0 + ai * HALF + m * 16;
                bf16_t* rowp = O + (size_t)row * ldc + col0;
                float s = 0.f;
#pragma unroll
                for (int bj = 0; bj < 2; ++bj) {
                    const f32x4 v0 = acc[ai][bj][m][0], v1 = acc[ai][bj][m][1];
                    s += (v0[0] * v0[0] + v0[1] * v0[1]) + (v0[2] * v0[2] + v0[3] * v0[3]) + (v1[0] * v1[0] + v1[1] * v1[1]) + (v1[2] * v1[2] + v1[3] * v1[3]);
                    u32x4 w; w.x = cvt_pk_bf16(v0[0], v0[1]); w.y = cvt_pk_bf16(v0[2], v0[3]); w.z = cvt_pk_bf16(v1[0], v1[1]); w.w = cvt_pk_bf16(v1[2], v1[3]);
                    *(u32x4*)(rowp + bj * HALF) = w;
                }
                s += __shfl_xor(s, 16); s += __shfl_xor(s, 32);
                if (fq == 0) ssq[(size_t)row * 16 + u.pn * 4 + wc] = s;
            }
    }
};
template <class Epi, class Sched, bool ALIGN_EPI = false, bool SP2 = false>
__device__ __forceinline__ void gemm_phase(PG8_LAS unsigned char* lds, const Gemm g, const Sched& S, const Epi& E) {
    const int tid = threadIdx.x, wid = __builtin_amdgcn_readfirstlane(tid >> 6), lane = tid & 63, wr = wid >> 2, wc = wid & 3, fr = lane & 15, fq = lane >> 4;
    const int K = g.K, nt = K / BK;
    unsigned voffA[2], voffB[2];
#pragma unroll
    for (int i = 0; i < 2; ++i) { int R, C; stage_rc(tid * 16 + i * 8192, R, C); const int Rb = Epi::PERM ? ((R & ~31) + perm32(R & 31)) : R;
        voffA[i] = (unsigned)(R * K + C) * 2u; voffB[i] = (unsigned)(Rb * K + C) * 2u; }
    const size_t kstep = (size_t)(BK * 2);
    const size_t hstep = (size_t)HALF * K * 2;
    const size_t tstep = 2 * hstep;
    const unsigned ldsw = (unsigned)wid * 1024u;
    const int aoff = lds_byte(wr * 64 + fr, fq * 8), boff = lds_byte(wc * 32 + fr, fq * 8);
#define PG8_SA(b, h) (((b) * 2 + (h)) * HTB)
#define PG8_SB(b, h) ((4 + (b) * 2 + (h)) * HTB)
#define PG8_STAGE(bufoff, gbase, voff) do { _Pragma("unroll") for (int _i = 0; _i < 2; ++_i) \
        __builtin_amdgcn_global_load_lds((const unsigned*)((const char*)(gbase) + (voff)[_i]), (PG8_LAS unsigned*)(lds + (bufoff) + ldsw + _i * 8192), 16, 0, 0); } while (0)
#define PG8_LDA(dst, b, h) do { _Pragma("unroll") for (int m = 0; m < 4; ++m) _Pragma("unroll") for (int k = 0; k < 2; ++k) dst[m][k] = *(const PG8_LAS bf16x8*)(lds + PG8_SA(b, h) + aoff + m * 2048 + k * 1024); } while (0)
#define PG8_LDB(dst, b, h) do { _Pragma("unroll") for (int n = 0; n < 2; ++n) _Pragma("unroll") for (int k = 0; k < 2; ++k) dst[n][k] = *(const PG8_LAS bf16x8*)(lds + PG8_SB(b, h) + boff + n * 2048 + k * 1024); } while (0)
#define PG8_MMA(ai, bj, At, Bt) do { __builtin_amdgcn_s_setprio(1); _Pragma("unroll") for (int m = 0; m < 4; ++m) _Pragma("unroll") for (int n = 0; n < 2; ++n) _Pragma("unroll") for (int k = 0; k < 2; ++k) \
        acc[ai][bj][m][n] = __builtin_amdgcn_mfma_f32_16x16x32_bf16(Bt[n][k], At[m][k], acc[ai][bj][m][n], 0, 0, 0); __builtin_amdgcn_s_setprio(0); } while (0)
#define PG8_WAIT_V(n) asm volatile("s_waitcnt vmcnt(" #n ")" ::: "memory")
#define PG8_WAIT_L(n) asm volatile("s_waitcnt lgkmcnt(" #n ")" ::: "memory")
#define PG8_BAR __builtin_amdgcn_s_barrier()
#define PG8_SCHED __builtin_amdgcn_sched_barrier(0)
    Unit cur, nxt; int ui = 0;
    if (!S.next(0, cur)) return;
    f32x4 acc[2][2][4][2];
#pragma unroll
    for (int a = 0; a < 2; ++a)
#pragma unroll
        for (int b = 0; b < 2; ++b)
#pragma unroll
            for (int m = 0; m < 4; ++m)
#pragma unroll
                for (int n = 0; n < 2; ++n) acc[a][b][m][n] = (f32x4){0.f, 0.f, 0.f, 0.f};
    bf16x8 At[4][2], B0[2][2], B1[2][2];
    const char* cA = (const char*)g.A + (size_t)cur.pm * tstep; const char* cB = (const char*)g.Bt + (size_t)cur.pn * tstep;
    S.a_ready(cur);
    if constexpr (SP2) {
        PG8_STAGE(PG8_SB(0, 0), cB, voffB); PG8_STAGE(PG8_SB(0, 1), cB + hstep, voffB); PG8_STAGE(PG8_SA(0, 0), cA, voffA); PG8_STAGE(PG8_SA(0, 1), cA + hstep, voffA);
        if (wr == 1) PG8_BAR;
        PG8_WAIT_V(2); PG8_BAR;
        PG8_STAGE(PG8_SB(1, 0), cB + kstep, voffB); PG8_STAGE(PG8_SA(1, 0), cA + kstep, voffA); PG8_STAGE(PG8_SB(1, 1), cB + hstep + kstep, voffB);
        PG8_WAIT_V(6); PG8_BAR;
    } else {
        PG8_STAGE(PG8_SB(0, 0), cB, voffB); PG8_STAGE(PG8_SA(0, 0), cA, voffA); PG8_STAGE(PG8_SB(0, 1), cB + hstep, voffB); PG8_STAGE(PG8_SA(0, 1), cA + hstep, voffA);
        if (wr == 1) PG8_BAR;
        PG8_WAIT_V(4); PG8_BAR;
        PG8_STAGE(PG8_SB(1, 0), cB + kstep, voffB); PG8_STAGE(PG8_SA(1, 0), cA + kstep, voffA); PG8_STAGE(PG8_SB(1, 1), cB + hstep + kstep, voffB);
        PG8_WAIT_V(6); PG8_BAR;
    }
    for (;;) {
        const bool has_next = S.next(ui + 1, nxt);
        const char* nA = has_next ? (const char*)g.A + (size_t)nxt.pm * tstep : cA; const char* nB = has_next ? (const char*)g.Bt + (size_t)nxt.pn * tstep : cB;
        for (int t = 0; t < nt; t += 2) {
            const bool last = (t == nt - 2);
            const char* a1 = cA + (size_t)(t + 1) * kstep;
            const char* a2 = last ? nA : cA + (size_t)(t + 2) * kstep; const char* b2 = last ? nB : cB + (size_t)(t + 2) * kstep;
            const char* a3 = a2 + kstep; const char* b3 = b2 + kstep;
            if (last && has_next) S.a_ready(nxt);
            if constexpr (SP2) {
            PG8_LDB(B0, 0, 0); PG8_LDB(B1, 0, 1); PG8_SCHED; PG8_LDA(At, 0, 0); PG8_STAGE(PG8_SA(1, 1), a1 + hstep, voffA);
            PG8_WAIT_V(8); PG8_WAIT_L(0); PG8_BAR; PG8_MMA(0, 0, At, B0); PG8_MMA(0, 1, At, B1); PG8_BAR; PG8_SCHED;
            PG8_LDA(At, 0, 1); PG8_STAGE(PG8_SB(0, 0), b2, voffB); PG8_STAGE(PG8_SB(0, 1), b2 + hstep, voffB); PG8_STAGE(PG8_SA(0, 0), a2, voffA);
            PG8_WAIT_V(8); PG8_WAIT_L(0); PG8_BAR; PG8_MMA(1, 0, At, B0); PG8_MMA(1, 1, At, B1); PG8_BAR; PG8_SCHED;
            PG8_LDB(B0, 1, 0); PG8_LDB(B1, 1, 1); PG8_SCHED; PG8_LDA(At, 1, 0); PG8_STAGE(PG8_SA(0, 1), a2 + hstep, voffA);
            PG8_WAIT_V(8); PG8_WAIT_L(0); PG8_BAR; PG8_MMA(0, 0, At, B0); PG8_MMA(0, 1, At, B1); PG8_BAR; PG8_SCHED;
            PG8_LDA(At, 1, 1); PG8_STAGE(PG8_SB(1, 0), b3, voffB); PG8_STAGE(PG8_SB(1, 1), b3 + hstep, voffB); PG8_STAGE(PG8_SA(1, 0), a3, voffA);
            PG8_WAIT_V(8); PG8_WAIT_L(0); PG8_BAR; PG8_MMA(1, 0, At, B0); PG8_MMA(1, 1, At, B1); PG8_BAR; PG8_SCHED;
            } else {
            PG8_LDB(B0, 0, 0); PG8_SCHED; PG8_LDA(At, 0, 0); PG8_STAGE(PG8_SA(1, 1), a1 + hstep, voffA);
            PG8_WAIT_L(8); PG8_BAR; PG8_WAIT_L(0); PG8_MMA(0, 0, At, B0); PG8_BAR; PG8_SCHED;
            PG8_LDB(B1, 0, 1); PG8_STAGE(PG8_SB(0, 0), b2, voffB);
            PG8_BAR; PG8_WAIT_L(0); PG8_MMA(0, 1, At, B1); PG8_BAR;
            PG8_LDA(At, 0, 1); PG8_STAGE(PG8_SA(0, 0), a2, voffA);
            PG8_BAR; PG8_WAIT_L(0); PG8_MMA(1, 0, At, B0); PG8_BAR; PG8_SCHED;
            PG8_STAGE(PG8_SB(0, 1), b2 + hstep, voffB);
            PG8_WAIT_V(6); PG8_BAR; PG8_MMA(1, 1, At, B1); PG8_BAR;
            PG8_LDB(B0, 1, 0); PG8_SCHED; PG8_LDA(At, 1, 0); PG8_STAGE(PG8_SA(0, 1), a2 + hstep, voffA);
            PG8_WAIT_L(8); PG8_BAR; PG8_WAIT_L(0); PG8_MMA(0, 0, At, B0); PG8_BAR; PG8_SCHED;
            PG8_LDB(B1, 1, 1); PG8_STAGE(PG8_SB(1, 0), b3, voffB);
            PG8_BAR; PG8_WAIT_L(0); PG8_MMA(0, 1, At, B1); PG8_BAR;
            PG8_LDA(At, 1, 1); PG8_STAGE(PG8_SA(1, 0), a3, voffA);
            PG8_BAR; PG8_WAIT_L(0); PG8_MMA(1, 0, At, B0); PG8_BAR; PG8_SCHED;
            PG8_STAGE(PG8_SB(1, 1), b3 + hstep, voffB);
            PG8_WAIT_V(6); PG8_BAR; PG8_MMA(1, 1, At, B1); PG8_BAR;
            }
        }
        if constexpr (ALIGN_EPI) { if (wr == 0) PG8_BAR; }
        if constexpr (!Epi::AFTER_DRAIN) { E(acc, cur, wr, wc, fr, fq); S.done(cur); }
        if (!has_next) break;
#pragma unroll
        for (int a = 0; a < 2; ++a)
#pragma unroll
            for (int b = 0; b < 2; ++b)
#pragma unroll
                for (int m = 0; m < 4; ++m)
#pragma unroll
                    for (int n = 0; n < 2; ++n) acc[a][b][m][n] = (f32x4){0.f, 0.f, 0.f, 0.f};
        cur = nxt; cA = nA; cB = nB; ++ui;
        if constexpr (ALIGN_EPI) { if (wr == 1) PG8_BAR; }
    }
    PG8_WAIT_V(0);
    if constexpr (!ALIGN_EPI) { if (wr == 0) PG8_BAR; }
    PG8_BAR;
    if constexpr (Epi::AFTER_DRAIN) { E.fused(acc, cur, wr, wc, fr, fq, lds, wid, lane); S.done(cur); }
#undef PG8_SA
#undef PG8_SB
#undef PG8_STAGE
#undef PG8_LDA
#undef PG8_LDB
#undef PG8_MMA
#undef PG8_WAIT_V
#undef PG8_WAIT_L
#undef PG8_BAR
#undef PG8_SCHED
}
}
#define LAS __attribute__((address_space(3)))
namespace att {
typedef unsigned short bf16;
typedef short bf16x8 __attribute__((ext_vector_type(8)));
typedef short s16x4 __attribute__((ext_vector_type(4)));
typedef short v4i16_t __attribute__((ext_vector_type(4)));
typedef float f32x16 __attribute__((ext_vector_type(16)));
typedef unsigned u32x4 __attribute__((ext_vector_type(4)));
typedef float f32x2_t __attribute__((ext_vector_type(2)));
typedef __bf16 bf16x2_t __attribute__((ext_vector_type(2)));
typedef LAS const char* lds_cptr;
constexpr int PITCH = 256;
constexpr long PANEL = 65536L * 256;
__device__ __forceinline__ long pc(int col) { return (long)(col >> 8) * PANEL + (col & 255); }
constexpr int YP = 1024;
__device__ __forceinline__ int fresh_tid() { int t = threadIdx.x; asm volatile("" : "+v"(t)); return t; }
__device__ __forceinline__ int crow(int r, int hi) { return (r & 3) + 8 * (r >> 2) + 4 * hi; }
__device__ __forceinline__ void glds16(const void* gsrc, unsigned lds_dst) { unsigned keep;
  asm volatile("s_mov_b32 %0, m0\n\ts_mov_b32 m0, %2\n\ts_nop 0\n\tglobal_load_lds_dwordx4 %1, off\n\ts_mov_b32 m0, %0" : "=&s"(keep) : "v"(gsrc), "s"(lds_dst) : "memory"); }
__device__ __forceinline__ unsigned cvtpk_s(float lo, float hi) { f32x2_t v = {lo, hi}; bf16x2_t b = __builtin_convertvector(v, bf16x2_t); return __builtin_bit_cast(unsigned, b); }
__device__ __forceinline__ s16x4 vtr(lds_cptr p) { return __builtin_bit_cast(s16x4, __builtin_amdgcn_ds_read_tr16_b64_v4i16((LAS v4i16_t*)p)); }
__device__ __forceinline__ float bf2f(bf16 v) { return __uint_as_float(((unsigned)v) << 16); }
__device__ __forceinline__ bf16 f2bf(float f) { unsigned u = __float_as_uint(f); return (bf16)((u + 0x7fffu + ((u >> 16) & 1u)) >> 16); }
__device__ __forceinline__ float swap_max(float m) { auto rr = __builtin_amdgcn_permlane32_swap(__float_as_uint(m), __float_as_uint(m), false, false); return fmaxf(__uint_as_float(rr[0]), __uint_as_float(rr[1])); }
__device__ __forceinline__ float swap_sum(float m) { auto rr = __builtin_amdgcn_permlane32_swap(__float_as_uint(m), __float_as_uint(m), false, false); return __uint_as_float(rr[0]) + __uint_as_float(rr[1]); }
#define ATT_EXP2(A, B) asm("v_exp_f32_e32 %0, %0\n\tv_exp_f32_e32 %1, %1\n\ts_nop 0" : "+v"(A), "+v"(B))
#define ATT_EXP2_ADD2(A, B, SA, SB, PA, PB) asm("v_exp_f32_e32 %0, %0\n\tv_exp_f32_e32 %1, %1\n\tv_add_f32_e32 %2, %2, %4\n\tv_add_f32_e32 %3, %3, %5" : "+v"(A), "+v"(B), "+v"(SA), "+v"(SB) : "v"(PA), "v"(PB))
#define ATT_ADD2(SA, SB, PA, PB) asm("s_nop 0\n\tv_add_f32_e32 %0, %0, %2\n\tv_add_f32_e32 %1, %1, %3" : "+v"(SA), "+v"(SB) : "v"(PA), "v"(PB))
__device__ __forceinline__ float silu(float g) { return g / (1.f + __expf(-g)); }
#define ATT_WAIT_BAR(N) asm volatile("s_waitcnt vmcnt(" #N ") lgkmcnt(0)\n\ts_barrier" ::: "memory")
#define ATT_PACK(P, B) (u32x4){cvtpk_s(P[B], P[B + 1]), cvtpk_s(P[B + 2], P[B + 3]), cvtpk_s(P[B + 4], P[B + 5]), cvtpk_s(P[B + 6], P[B + 7])}
#define ATT_VFR(lo, hi) (bf16x8){lo[0], lo[1], lo[2], lo[3], hi[0], hi[1], hi[2], hi[3]}

constexpr int D_SLOT = 32768, D_NSLOT = 4, D_WSF = D_SLOT * D_NSLOT;
#define ATT_MX3(a, b, c) __builtin_fmaxf(__builtin_fmaxf((a), (b)), (c))
__device__ __forceinline__ void diff_unit(const bf16* __restrict__ P, bf16* __restrict__ Y, long rowbase, int S, int h, int qt, LAS char* shm, float lam, const float* __restrict__ g_sub, const bf16* __restrict__ P15) {
  const int tid = fresh_tid(), lane = tid & 63, r32 = lane & 31, hi = lane >> 5; const int wid = __builtin_amdgcn_readfirstlane(tid >> 6);
  const int map = wid >> 2, wq = wid & 3;
  const long qrow0 = rowbase + (long)qt * 128 + wq * 32;
  const bf16* Qw = P + pc(2048 + (2 * h + map) * 64) + qrow0 * PITCH;
  const bf16* Kb = P + pc(2560 + (2 * h + map) * 64) + rowbase * PITCH;
  const bf16* Vb = P + pc(3072 + h * 128) + rowbase * PITCH;
  const unsigned lds0 = (unsigned)(uintptr_t)shm;
  LAS float* wsf = (LAS float*)(shm + D_WSF) + wid * 64;
  const bf16* ksrc0 = Kb + (long)lane * PITCH + (2 * wq) * 8;
  const bf16* ksrc1 = ksrc0 + 8;
  const unsigned kdst0 = map * 8192 + (2 * wq) * 1024, kdst1 = kdst0 + 1024;
  const int vp0 = 2 * wid, vp1 = 2 * wid + 1;
  const bf16* vsrc0 = Vb + (long)(16 * (vp0 & 3) + (lane >> 2)) * PITCH + 32 * (vp0 >> 2) + 8 * (lane & 3);
  const bf16* vsrc1 = Vb + (long)(16 * (vp1 & 3) + (lane >> 2)) * PITCH + 32 * (vp1 >> 2) + 8 * (lane & 3);
  const unsigned vdst0 = 16384 + vp0 * 1024, vdst1 = 16384 + vp1 * 1024;
#define D_DMA(t, slot) do { const long toff_ = (long)(t) * 64 * PITCH; const unsigned sb_ = lds0 + (slot); \
    glds16(ksrc0 + toff_, (unsigned)__builtin_amdgcn_readfirstlane(sb_ + kdst0)); glds16(ksrc1 + toff_, (unsigned)__builtin_amdgcn_readfirstlane(sb_ + kdst1)); \
    glds16(vsrc0 + toff_, (unsigned)__builtin_amdgcn_readfirstlane(sb_ + vdst0)); glds16(vsrc1 + toff_, (unsigned)__builtin_amdgcn_readfirstlane(sb_ + vdst1)); } while (0)
  const int NT = S / 64;
  asm volatile("s_waitcnt vmcnt(0)" ::: "memory");
  bf16x8 qr[4];
#pragma unroll
  for (int d0 = 0; d0 < 4; ++d0) qr[d0] = *reinterpret_cast<const bf16x8*>(&Qw[(long)r32 * PITCH + d0 * 16 + hi * 8]);
  asm volatile("" ::: "memory");
  D_DMA(0, 0); D_DMA(1, D_SLOT); D_DMA(2, 2 * D_SLOT);
  float m = 0.f, l = 0.f;
  f32x16 o[4];
#pragma unroll
  for (int d0 = 0; d0 < 4; ++d0) o[d0] = f32x16{};
  f32x16 negm = f32x16{}; asm volatile("" : "+v"(negm));
  const lds_cptr shm3 = (lds_cptr)shm;
  const lds_cptr kp0 = shm3 + map * 8192 + hi * 1024 + r32 * 16;
  const lds_cptr vp = shm3 + 16384 + ((lane >> 4) & 1) * 32 + (lane & 3) * 8 + (4 * hi + ((lane & 15) >> 2)) * 64;
  bf16x8 pa0, pa1, pa2, pa3;
  pa0 = pa1 = pa2 = pa3 = bf16x8{};
#define D_KLD(SL_) do { const lds_cptr kp = kp0 + (SL_); \
    _Pragma("unroll") for (int d0 = 0; d0 < 4; ++d0) { kf[2 * d0] = *(const LAS bf16x8*)(kp + d0 * 2048); kf[2 * d0 + 1] = *(const LAS bf16x8*)(kp + d0 * 2048 + 512); } } while (0)
#define D_QKSM(T_, SL_) do { \
    f32x16 p0, p1; \
    p0 = __builtin_amdgcn_mfma_f32_32x32x16_bf16(kf[0], qr[0], negm, 0, 0, 0); p1 = __builtin_amdgcn_mfma_f32_32x32x16_bf16(kf[1], qr[0], negm, 0, 0, 0); \
    _Pragma("unroll") for (int d0 = 1; d0 < 4; ++d0) { \
      p0 = __builtin_amdgcn_mfma_f32_32x32x16_bf16(kf[2 * d0], qr[d0], p0, 0, 0, 0); p1 = __builtin_amdgcn_mfma_f32_32x32x16_bf16(kf[2 * d0 + 1], qr[d0], p1, 0, 0, 0); } \
    float ra = ATT_MX3(p0[0], p0[1], p1[0]), rb = ATT_MX3(p0[2], p0[3], p1[1]); ra = ATT_MX3(ra, p1[2], p1[3]); \
    _Pragma("unroll") for (int r = 4; r < 16; r += 4) { ra = ATT_MX3(ra, p0[r], p0[r + 1]); rb = ATT_MX3(rb, p0[r + 2], p0[r + 3]); ra = ATT_MX3(ra, p1[r], p1[r + 1]); rb = ATT_MX3(rb, p1[r + 2], p1[r + 3]); } \
    const float rm = swap_max(fmaxf(ra, rb)); \
    if ((T_) == 0 || __any(rm > 6.f)) { \
      const float dl = ((T_) == 0) ? rm : fmaxf(rm, 0.f); m += dl; \
      _Pragma("unroll") for (int r = 0; r < 16; ++r) { p0[r] -= dl; p1[r] -= dl; } \
      _Pragma("unroll") for (int r = 0; r < 16; ++r) negm[r] = -m; \
      asm volatile("" : "+v"(negm)); \
      const float f = __builtin_amdgcn_exp2f(-dl); l *= f; \
      if (hi == 0) wsf[r32] = f; \
      _Pragma("unroll") for (int r = 0; r < 16; ++r) { const float fr_ = wsf[crow(r, hi)]; \
        _Pragma("unroll") for (int d0 = 0; d0 < 4; ++d0) o[d0][r] *= fr_; } \
    } \
    float sacc = 0.f, sacd = 0.f; \
    ATT_EXP2(p0[0], p1[0]); \
    _Pragma("unroll") for (int r = 1; r < 16; ++r) ATT_EXP2_ADD2(p0[r], p1[r], sacc, sacd, p0[r - 1], p1[r - 1]); \
    ATT_ADD2(sacc, sacd, p0[15], p1[15]); \
    l += sacc + sacd; \
    pa0 = __builtin_bit_cast(bf16x8, ATT_PACK(p0, 0)); pa1 = __builtin_bit_cast(bf16x8, ATT_PACK(p0, 8)); \
    pa2 = __builtin_bit_cast(bf16x8, ATT_PACK(p1, 0)); pa3 = __builtin_bit_cast(bf16x8, ATT_PACK(p1, 8)); } while (0)
#define D_PV(SL_) do { const lds_cptr vq = vp + (SL_); \
    _Pragma("unroll") for (int d0 = 0; d0 < 4; ++d0) { s16x4 lo[4], hh[4]; \
      _Pragma("unroll") for (int ks = 0; ks < 4; ++ks) { lo[ks] = vtr(vq + d0 * 4096 + ks * 1024); hh[ks] = vtr(vq + d0 * 4096 + ks * 1024 + 512); } \
      o[d0] = __builtin_amdgcn_mfma_f32_32x32x16_bf16(pa0, ATT_VFR(lo[0], hh[0]), o[d0], 0, 0, 0); \
      o[d0] = __builtin_amdgcn_mfma_f32_32x32x16_bf16(pa1, ATT_VFR(lo[1], hh[1]), o[d0], 0, 0, 0); \
      o[d0] = __builtin_amdgcn_mfma_f32_32x32x16_bf16(pa2, ATT_VFR(lo[2], hh[2]), o[d0], 0, 0, 0); \
      o[d0] = __builtin_amdgcn_mfma_f32_32x32x16_bf16(pa3, ATT_VFR(lo[3], hh[3]), o[d0], 0, 0, 0); } } while (0)
  ATT_WAIT_BAR(8);
  bf16x8 kf[8];
  if (map == 1) asm volatile("s_barrier" ::: "memory");
  for (int t = 0; t < NT; ++t) {
    const int cur = (t & 3) * D_SLOT;
    D_KLD(cur);
    D_QKSM(t, cur);
    __builtin_amdgcn_sched_barrier(0);
    if (t + 2 < NT) { ATT_WAIT_BAR(4); } else { ATT_WAIT_BAR(0); }
    __builtin_amdgcn_sched_barrier(0);
    if (t + 3 < NT) D_DMA(t + 3, ((t + 3) & 3) * D_SLOT);
    D_PV(cur);
    __builtin_amdgcn_sched_barrier(0);
    asm volatile("s_waitcnt lgkmcnt(0)\n\ts_barrier" ::: "memory");
    __builtin_amdgcn_sched_barrier(0);
  }
  if (map == 0) asm volatile("s_barrier" ::: "memory");
#undef D_DMA
#undef D_KLD
#undef D_QKSM
#undef D_PV
  l = swap_sum(l);
  { const int te = fresh_tid(); const int lane = te & 63, r32 = lane & 31, hi = lane >> 5;
  LAS float* wsf = (LAS float*)(shm + D_WSF) + wid * 64;
  if (hi == 0) wsf[32 + r32] = (map == 1 ? lam : 1.f) / l;
  float inv[16];
#pragma unroll
  for (int r = 0; r < 16; ++r) inv[r] = wsf[32 + crow(r, hi)];
  ATT_WAIT_BAR(0);
  LAS float* X = (LAS float*)shm + wq * 4096;
  if (map == 1) {
#pragma unroll
    for (int d0 = 0; d0 < 4; ++d0)
#pragma unroll
      for (int r = 0; r < 16; ++r) X[(d0 * 16 + r) * 64 + lane] = o[d0][r] * inv[r];
  }
  ATT_WAIT_BAR(0);
  if (map == 0) {
    const bf16* Gw = (h >= 2 ? P15 + (h - 2) * 128 : P + pc(3584 + h * 128)) + qrow0 * PITCH;
    bf16* Yw = Y + qrow0 * YP + 512 + h * 128;
    float gs[4];
#pragma unroll
    for (int d0 = 0; d0 < 4; ++d0) gs[d0] = g_sub[d0 * 32 + r32] * 0.8f;
#pragma unroll
    for (int r = 0; r < 16; ++r) {
      float v[4]; float ss = 0.f;
#pragma unroll
      for (int d0 = 0; d0 < 4; ++d0) { v[d0] = o[d0][r] * inv[r] - X[(d0 * 16 + r) * 64 + lane]; ss += v[d0] * v[d0]; }
      ss += __shfl_xor(ss, 1); ss += __shfl_xor(ss, 2); ss += __shfl_xor(ss, 4); ss += __shfl_xor(ss, 8); ss += __shfl_xor(ss, 16);
      const float rstd = rsqrtf(ss * (1.f / 128.f) + 1e-6f);
      const int q = crow(r, hi);
#pragma unroll
      for (int d0 = 0; d0 < 4; ++d0) { const float g = bf2f(Gw[(long)q * PITCH + d0 * 32 + r32]);
        Yw[(long)q * YP + d0 * 32 + r32] = f2bf(v[d0] * rstd * gs[d0] * silu(g)); }
    }
  }
  }
  ATT_WAIT_BAR(0);
}

template <int DIL, int NBLK, int QSTEP>
__device__ __forceinline__ void dil_pattern(const bf16* __restrict__ Kb, const bf16* __restrict__ Vb, int S, int i0, int resid, const bf16x8 (&qr)[4], float& m, float& l, f32x16 (&o)[2],
                                            LAS char* vl, LAS float* wsf, int lane, int r32, int hi) {
  const int L = S / DIL;
  const int qidx = i0 + QSTEP * r32;
  const int lo_q = qidx - 64 < 0 ? 0 : qidx - 64, w_q = (qidx + 64 > L - 1 ? L - 1 : qidx + 64) - lo_q;
  const lds_cptr vq = (lds_cptr)vl + ((lane >> 4) & 1) * 32 + (lane & 3) * 8 + (4 * hi + ((lane & 15) >> 2)) * 64;
  const int lrow = lane >> 3, lch = lane & 7;
  LAS char* kw = vl + 4096 + lch * 512 + ((lrow ^ lch) * 16);
  LAS char* vw = vl + (lch >> 2) * 2048 + (lrow & 7) * 64 + (lch & 3) * 16;
  const lds_cptr kr_ = (lds_cptr)vl + 4096;
  int kb_lo = (64 - i0) >> 5; kb_lo = kb_lo < 0 ? 0 : kb_lo;
  int kb_hi = (L + 64 - i0 + 31) >> 5; kb_hi = kb_hi > NBLK ? NBLK : kb_hi;
  u32x4 kr[4], vr[4];
  f32x16 negm;
#pragma unroll
  for (int rr = 0; rr < 16; ++rr) negm[rr] = -m;
  asm volatile("" : "+v"(negm));
#define DIL_LOAD(KB_) do { const int kbase_ = i0 - 64 + 32 * (KB_); \
    _Pragma("unroll") for (int i = 0; i < 4; ++i) { int kx_ = kbase_ + 8 * i + lrow; kx_ = kx_ < 0 ? 0 : (kx_ >= L ? L - 1 : kx_); \
      const long ro_ = (long)(resid + DIL * kx_) * PITCH + lch * 8; \
      kr[i] = *reinterpret_cast<const u32x4*>(Kb + ro_); vr[i] = *reinterpret_cast<const u32x4*>(Vb + ro_); } } while (0)
  DIL_LOAD(kb_lo);
  for (int kb = kb_lo; kb < kb_hi; ++kb) {
    const int kbase = i0 - 64 + 32 * kb;
#pragma unroll
    for (int i = 0; i < 4; ++i) { *(LAS u32x4*)(kw + i * 128) = kr[i]; *(LAS u32x4*)(vw + (i >> 1) * 1024 + (i & 1) * 512) = vr[i]; }
    { const int kn = (kb + 1 < kb_hi) ? kb + 1 : kb; DIL_LOAD(kn); }
    f32x16 p0;
#pragma unroll
    for (int d0 = 0; d0 < 4; ++d0) { const int ch = 2 * d0 + hi;
      const bf16x8 kfr = *(const LAS bf16x8*)(kr_ + ch * 512 + ((r32 ^ ch) * 16));
      p0 = __builtin_amdgcn_mfma_f32_32x32x16_bf16(kfr, qr[d0], d0 == 0 ? negm : p0, 0, 0, 0); }
    float rm = -1e30f;
    { const int a0 = lo_q - kbase;
      if (!__all(a0 <= 0 && a0 + w_q >= 31)) { const int a1 = a0 - 4 * hi;
#pragma unroll
        for (int rr = 0; rr < 16; ++rr) { const bool ok = (unsigned)(((rr & 3) + 8 * (rr >> 2)) - a1) <= (unsigned)w_q; p0[rr] = ok ? p0[rr] : -1e30f; } }
      const float r0 = ATT_MX3(p0[0], p0[1], p0[2]), r1 = ATT_MX3(p0[3], p0[4], p0[5]), r2 = ATT_MX3(p0[6], p0[7], p0[8]), r3 = ATT_MX3(p0[9], p0[10], p0[11]), r4 = ATT_MX3(p0[12], p0[13], p0[14]);
      rm = fmaxf(ATT_MX3(r0, r1, r2), ATT_MX3(r3, r4, p0[15])); }
    rm = swap_max(rm);
    const bool first = (kb == kb_lo);
    if (first || __any(rm > 6.f)) {
      const float dl = first ? rm : fmaxf(rm, 0.f); m += dl;
#pragma unroll
      for (int rr = 0; rr < 16; ++rr) p0[rr] -= dl;
#pragma unroll
      for (int rr = 0; rr < 16; ++rr) negm[rr] = -m;
      asm volatile("" : "+v"(negm));
      if (!first) {
        const float f = __builtin_amdgcn_exp2f(-dl); l *= f;
        if (hi == 0) wsf[r32] = f;
#pragma unroll
        for (int rr = 0; rr < 16; ++rr) { const float fr_ = wsf[crow(rr, hi)]; o[0][rr] *= fr_; o[1][rr] *= fr_; }
      }
    }
    { float s0 = 0.f, s1 = 0.f;
      ATT_EXP2(p0[0], p0[1]);
#pragma unroll
      for (int rr = 2; rr < 16; rr += 2) ATT_EXP2_ADD2(p0[rr], p0[rr + 1], s0, s1, p0[rr - 2], p0[rr - 1]);
      ATT_ADD2(s0, s1, p0[14], p0[15]);
      l += s0 + s1; }
    const bf16x8 pa0 = __builtin_bit_cast(bf16x8, ATT_PACK(p0, 0)), pa1 = __builtin_bit_cast(bf16x8, ATT_PACK(p0, 8));
#pragma unroll
    for (int d0 = 0; d0 < 2; ++d0) {
      const s16x4 lo0 = vtr(vq + d0 * 2048), hi0 = vtr(vq + d0 * 2048 + 512), lo1 = vtr(vq + d0 * 2048 + 1024), hi1 = vtr(vq + d0 * 2048 + 1536);
      o[d0] = __builtin_amdgcn_mfma_f32_32x32x16_bf16(pa0, ATT_VFR(lo0, hi0), o[d0], 0, 0, 0);
      o[d0] = __builtin_amdgcn_mfma_f32_32x32x16_bf16(pa1, ATT_VFR(lo1, hi1), o[d0], 0, 0, 0);
    }
  }
#undef DIL_LOAD
}
__device__ __forceinline__ void dil_q(bf16x8 (&qr)[4], const bf16* __restrict__ Qb, long tok, int hi) {
#pragma unroll
  for (int d0 = 0; d0 < 4; ++d0) qr[d0] = *reinterpret_cast<const bf16x8*>(Qb + tok * PITCH + d0 * 16 + hi * 8);
}
__device__ __forceinline__ void dil_item_a(const bf16* __restrict__ P, long rowbase, int S, int h, int c, int r, LAS char* vl, LAS float* wsf, LAS bf16* OA, LAS float* ML, const bf16x8 (&qr)[4]) {
  const int lane = fresh_tid() & 63, r32 = lane & 31, hi = lane >> 5;
  const bf16* Kb = P + pc(512 + h * 64) + rowbase * PITCH; const bf16* Vb = P + pc(1024 + h * 64) + rowbase * PITCH;
  float m = 0.f, l = 0.f; f32x16 o[2]; o[0] = f32x16{}; o[1] = f32x16{};
  dil_pattern<16, 5, 1>(Kb, Vb, S, 32 * c, r, qr, m, l, o, vl, wsf, lane, r32, hi);
  l = swap_sum(l);
  if (hi == 0) { wsf[32 + r32] = 1.f / l; ML[(r + 16 * r32) * 2] = m; ML[(r + 16 * r32) * 2 + 1] = l; }
#pragma unroll
  for (int rr = 0; rr < 16; ++rr) { const float iv = wsf[32 + crow(rr, hi)]; const int tl = r + 16 * crow(rr, hi);
#pragma unroll
    for (int d0 = 0; d0 < 2; ++d0) OA[tl * 64 + d0 * 32 + r32] = f2bf(o[d0][rr] * iv); }
}
__device__ __forceinline__ void dil_item_m(const bf16* __restrict__ P, long rowbase, int S, int h, int c, int g, LAS char* vl, LAS float* wsf, LAS bf16* OA, LAS float* ML, const bf16x8 (&qr)[4]) {
  const int lane = fresh_tid() & 63, r32 = lane & 31, hi = lane >> 5;
  const int r4 = g & 3, jb = g >> 2;
  const bf16* Kb = P + pc(512 + h * 64) + rowbase * PITCH; const bf16* Vb = P + pc(1024 + h * 64) + rowbase * PITCH;
  const int tl0 = r4 + 128 * jb;
  float m = 0.f, l = 0.f; f32x16 o[2]; o[0] = f32x16{}; o[1] = f32x16{};
  dil_pattern<4, 5, 1>(Kb, Vb, S, 128 * c + 32 * jb, r4, qr, m, l, o, vl, wsf, lane, r32, hi);
  l = swap_sum(l);
  if (hi == 0) {
    const int tl = tl0 + 4 * r32;
    const float ma = ML[tl * 2], la = ML[tl * 2 + 1];
    const float mm = fmaxf(ma, m), wa = la * __builtin_amdgcn_exp2f(ma - mm), wb = __builtin_amdgcn_exp2f(m - mm);
    const float den = wa + l * wb, rden = 1.f / den;
    wsf[r32] = wa * rden; wsf[32 + r32] = wb * rden; ML[tl * 2] = mm; ML[tl * 2 + 1] = den; }
#pragma unroll
  for (int rr = 0; rr < 16; ++rr) { const int q = crow(rr, hi); const float fa = wsf[q], fb = wsf[32 + q]; const int tl = tl0 + 4 * q;
#pragma unroll
    for (int d0 = 0; d0 < 2; ++d0) { const float oa = bf2f(OA[tl * 64 + d0 * 32 + r32]); OA[tl * 64 + d0 * 32 + r32] = f2bf(oa * fa + o[d0][rr] * fb); } }
}
__device__ __forceinline__ void dil_item_b(const bf16* __restrict__ P, bf16* __restrict__ Y, long rowbase, int S, int h, int c, int j, LAS char* vl, LAS float* wsf, const LAS bf16* OA, const LAS float* ML, const bf16x8 (&qr)[4]) {
  const int lane = fresh_tid() & 63, r32 = lane & 31, hi = lane >> 5;
  const bf16* Kb = P + pc(512 + h * 64) + rowbase * PITCH; const bf16* Vb = P + pc(1024 + h * 64) + rowbase * PITCH; const bf16* Gb = P + pc(1536 + h * 64) + rowbase * PITCH;
  const int tq0 = 512 * c + 32 * j;
  float m = 0.f, l = 0.f; f32x16 o[2]; o[0] = f32x16{}; o[1] = f32x16{};
  dil_pattern<1, 5, 1>(Kb, Vb, S, tq0, 0, qr, m, l, o, vl, wsf, lane, r32, hi);
  l = swap_sum(l);
  if (hi == 0) {
    const float ma = ML[(32 * j + r32) * 2], la = ML[(32 * j + r32) * 2 + 1];
    const float mm = fmaxf(ma, m), wa = la * __builtin_amdgcn_exp2f(ma - mm), wb = __builtin_amdgcn_exp2f(m - mm);
    const float rden = 1.f / (wa + l * wb);
    wsf[r32] = wa * rden; wsf[32 + r32] = wb * rden; }
  bf16* Yb = Y + rowbase * YP + h * 64;
#pragma unroll
  for (int rr = 0; rr < 16; ++rr) { const int q = crow(rr, hi); const float fa = wsf[q], fb = wsf[32 + q]; const long tok = tq0 + q;
#pragma unroll
    for (int d0 = 0; d0 < 2; ++d0) { const float g = bf2f(Gb[tok * PITCH + d0 * 32 + r32]); const float oa = bf2f(OA[(32 * j + q) * 64 + d0 * 32 + r32]);
      Yb[tok * YP + d0 * 32 + r32] = f2bf((oa * fa + o[d0][rr] * fb) * silu(g)); } }
}
}
typedef unsigned short bf16;
typedef float f32x4g __attribute__((ext_vector_type(4)));
typedef unsigned v4u __attribute__((ext_vector_type(4)));
constexpr int NTOK = 65536, DMODEL = 1024, DPROJ = 4096, NBATCH = 20, NPROMPT_ROWS = 32768;
constexpr size_t MiB = 1u << 20;
constexpr size_t WS_PROJ = 0, WS_Y = 0, WS_SSQ = 128 * MiB, WS_GATE = 132 * MiB, WS_NEED = 512 * MiB;
constexpr size_t DO_H = 0, DO_WIN = 128 * MiB, DO_WOUT = 136 * MiB, DO_MOD = 138 * MiB, DO_ROPE = 139 * MiB, DO_MISC = 140 * MiB;
constexpr size_t DO_P15 = 142 * MiB;
constexpr size_t WS_BAR = 480 * MiB;
constexpr int LDS_XB = 147392;
constexpr int LDS_BYTES = 147456;
#define XB_TMO      128
#define XB_XCNT(j)  (256  + 64 * (j))
#define XB_XSUB(j)  (1280 + 64 * (j))
#define XB_XGEN(j)  (2304 + 64 * (j))
#define XB_TOP      3328
#define XB_TOPGEN   3392
#define XCD_BAR_WORDS 3456
#define XB_SPIN_CAP (1u << 18)

__device__ __forceinline__ unsigned xb_ld(unsigned* p)              { return __hip_atomic_load(p, __ATOMIC_RELAXED, __HIP_MEMORY_SCOPE_AGENT); }
__device__ __forceinline__ unsigned xb_add(unsigned* p, unsigned v) { return __hip_atomic_fetch_add(p, v, __ATOMIC_RELAXED, __HIP_MEMORY_SCOPE_AGENT); }
__device__ __forceinline__ unsigned xb_xcc_id() { return (unsigned)__builtin_amdgcn_s_getreg((3 << 11) | 20) & 0xFu; }
#define XB_SPIN(cond, bar) do { unsigned _sp = 0; while (cond) { __builtin_amdgcn_s_sleep(1); \
    if ((++_sp & 255u) == 0u) { if (xb_ld(&(bar)[XB_TMO])) break; if (_sp > XB_SPIN_CAP) { atomicAdd(&(bar)[XB_TMO], 1u); break; } } } } while (0)

struct XcdBarrier {
    unsigned* bar; unsigned x;
    volatile LAS unsigned* st;
};

__device__ __forceinline__ XcdBarrier xcd_barrier_post(unsigned* bar, volatile LAS unsigned* st) {
    XcdBarrier b; b.bar = bar; b.x = xb_xcc_id(); b.st = st;
    if (threadIdx.x == 0) (void)xb_add(&bar[XB_XCNT(b.x)], 1u);
    return b;
}
__device__ __forceinline__ void xcd_barrier_complete(unsigned* bar, unsigned x, unsigned& nloc, unsigned& nx) {
    const unsigned G = gridDim.x * gridDim.y * gridDim.z;
    unsigned sum, cnt, mine, sp = 0u;
    for (;;) {
        sum = 0u; cnt = 0u; mine = 0u;
#pragma unroll
        for (unsigned j = 0; j < 16; ++j) { const unsigned c = xb_ld(&bar[XB_XCNT(j)]); sum += c; cnt += (c > 0u) ? 1u : 0u; mine = (j == x) ? c : mine; }
        if (sum == G) break;
        __builtin_amdgcn_s_sleep(1);
        if ((++sp & 255u) == 0u) { if (xb_ld(&bar[XB_TMO])) break; if (sp > XB_SPIN_CAP) { atomicAdd(&bar[XB_TMO], 1u); break; } }
    }
    nloc = mine > 0u ? mine : 1u; nx = cnt > 0u ? cnt : 1u;
}

__device__ __forceinline__ void xcd_barrier(const XcdBarrier& b) {
    asm volatile("s_waitcnt vmcnt(0)" ::: "memory");
    __syncthreads();
    if (threadIdx.x == 0) {
        unsigned* bar = b.bar;
        __builtin_amdgcn_s_waitcnt(0);
        unsigned nloc = b.st[0], nx = b.st[1];
        if (nloc == 0u) { xcd_barrier_complete(bar, b.x, nloc, nx); b.st[0] = nloc; b.st[1] = nx; }
        const unsigned old = xb_add(&bar[XB_XSUB(b.x)], 1u);
        const unsigned gen = old / nloc;
        if (old + 1u == (gen + 1u) * nloc) {
            __builtin_amdgcn_fence(__ATOMIC_RELEASE, "agent");
            asm volatile("s_waitcnt vmcnt(0)" ::: "memory");
            const unsigned og = xb_add(&bar[XB_TOP], 1u);
            const unsigned tg = og / nx;
            if (og + 1u == (tg + 1u) * nx) xb_add(&bar[XB_TOPGEN], 1u);
            else XB_SPIN(xb_ld(&bar[XB_TOPGEN]) == tg, bar);
            __builtin_amdgcn_fence(__ATOMIC_ACQUIRE, "agent");
            xb_add(&bar[XB_XGEN(b.x)], 1u);
            asm volatile("s_waitcnt vmcnt(0)" ::: "memory");
        } else {
            XB_SPIN(xb_ld(&bar[XB_XGEN(b.x)]) == gen, bar);
            __builtin_amdgcn_fence(__ATOMIC_ACQUIRE, "agent");
            asm volatile("s_waitcnt vmcnt(0)" ::: "memory");
        }
    }
    __syncthreads();
}

struct Params { const float* in[15]; float* out; unsigned char* ws; int mask; int pad; };

__device__ __forceinline__ unsigned f2bf_u(float f) { unsigned u = __builtin_bit_cast(unsigned, f); return (u + 0x7fffu + ((u >> 16) & 1u)) >> 16; }
__device__ __forceinline__ unsigned pk2(float lo, float hi) { return f2bf_u(lo) | (f2bf_u(hi) << 16); }
__device__ __forceinline__ float wave_sum(float v) {
#pragma unroll
    for (int o = 1; o < 64; o <<= 1) v += __shfl_xor(v, o);
    return v;
}
__device__ __forceinline__ void transpose_item(const float* W, int K, int N, bf16* WT, LAS float* scr, int item, int lane) {
    const int nblk = N / 32, kb = item / nblk, nb = item % nblk, k0 = 64 * kb, n0 = 32 * nb;
#pragma unroll 8
    for (int i = 0; i < 32; ++i) { const int kk = 2 * i + (lane >> 5); scr[kk * 33 + (lane & 31)] = W[(size_t)(k0 + kk) * N + n0 + (lane & 31)]; }
    asm volatile("s_waitcnt lgkmcnt(0)" ::: "memory");
    const int c = lane & 7;
#pragma unroll
    for (int j = 0; j < 4; ++j) { const int n = (lane >> 3) + 8 * j; const LAS float* s = scr + (8 * c) * 33 + n;
        v4u o; o.x = pk2(s[0 * 33], s[1 * 33]); o.y = pk2(s[2 * 33], s[3 * 33]); o.z = pk2(s[4 * 33], s[5 * 33]); o.w = pk2(s[6 * 33], s[7 * 33]);
        *(v4u*)(WT + (size_t)(n0 + n) * K + k0 + 8 * c) = o; }
    asm volatile("s_waitcnt lgkmcnt(0)" ::: "memory");
}
__device__ __forceinline__ const float* xrow_ptr(const Params& p, int row) { return row < NPROMPT_ROWS ? p.in[0] + (size_t)row * DMODEL : p.in[1] + (size_t)(row - NPROMPT_ROWS) * DMODEL; }
__device__ __forceinline__ int row_batch(int row) { return row < NPROMPT_ROWS ? (row >> 13) : 4 + ((row - NPROMPT_ROWS) >> 11); }

__global__ void __launch_bounds__(512, 2) mega_fwd(Params p) {
    extern __shared__ __attribute__((aligned(16))) unsigned char lds_raw[];
    LAS unsigned char* lds = (LAS unsigned char*)lds_raw;
    cg::grid_group grid = cg::this_grid();
    const int tid = threadIdx.x, lane = tid & 63, wave = __builtin_amdgcn_readfirstlane(tid >> 6);
    const int G = gridDim.x, bx = blockIdx.x;
    const int vcu = (G % 8 == 0) ? (bx % 8) * (G / 8) + bx / 8 : bx;
    unsigned char* dob = (unsigned char*)p.out;
    bf16* H = (bf16*)(dob + DO_H); bf16* WIN = (bf16*)(dob + DO_WIN); bf16* WOUT = (bf16*)(dob + DO_WOUT);
    float* MOD = (float*)(dob + DO_MOD); float* ROPE = (float*)(dob + DO_ROPE); float* MISC = (float*)(dob + DO_MISC);
    bf16* PROJ = (bf16*)(p.ws + WS_PROJ); bf16* P15 = (bf16*)(dob + DO_P15); bf16* YB = (bf16*)(p.ws + WS_Y); float* SSQ = (float*)(p.ws + WS_SSQ); float* GATE = (float*)(p.ws + WS_GATE);
    const int gw = vcu * 8 + wave, NGW = G * 8;
    { unsigned* bw = (unsigned*)(p.ws + WS_BAR); for (int i = bx * 512 + tid; i < XCD_BAR_WORDS; i += G * 512) bw[i] = 0u; }
    if (tid < 2) ((volatile LAS unsigned*)(lds + LDS_XB))[tid] = 0u;

    asm volatile(".p2align 8\n\t.rept " PAD_STR(PAD_P0A) "\n\ts_nop 0\n\t.endr");
    if (p.mask & 1) {
        for (int e = bx * 512 + tid; e < 8192 * 8; e += G * 512) {
            const int pos = e >> 3, i = e & 7;
            const float inv = exp2f(-(float)i * (1.0f / 8.0f) * 18.931568569324174f);
            const float ang = (float)pos * inv;
            const double ad = (double)ang; const double n = rint(ad * 0.15915494309189535); const float red = (float)(ad - n * 6.283185307179586);
            ROPE[2 * e] = cosf(red); ROPE[2 * e + 1] = sinf(red);
        }
        __syncthreads();
        if (bx >= 192) {
            LAS float* scr = (LAS float*)(lds + wave * 16384);
            for (int it = (bx - 192) * 8 + wave; it < (DMODEL / 64) * (DMODEL / 32); it += (G - 192) * 8) transpose_item(p.in[5], DMODEL, DMODEL, WOUT, scr, it, att::fresh_tid() & 63);
        }
        if (bx < 192) {
            LAS float* sc = (LAS float*)lds;
            LAS float* red = (LAS float*)(lds + 81920);
            { float cvv[NBATCH * 2];
#pragma unroll
              for (int q = 0; q < NBATCH * 2; ++q) { const int i = tid + 512 * q; const int b = i >> 10, k = i & 1023; cvv[q] = b < 4 ? p.in[2][b * DMODEL + k] : p.in[3][(b - 4) * DMODEL + k]; }
#pragma unroll
              for (int q = 0; q < NBATCH * 2; ++q) sc[tid + 512 * q] = cvv[q] / (1.f + __expf(-cvv[q])); }
            __syncthreads();
            const int col = tid & 15, ks = tid >> 4, j = bx * 16 + col;
            float acc[NBATCH];
#pragma unroll
            for (int b = 0; b < NBATCH; ++b) acc[b] = 0.f;
            float wv[32];
#pragma unroll
            for (int i = 0; i < 32; ++i) wv[i] = p.in[8][(size_t)(ks + 32 * i) * 3072 + j];
#pragma unroll
            for (int i = 0; i < 32; ++i) {
#pragma unroll
                for (int b = 0; b < NBATCH; ++b) acc[b] += sc[b * DMODEL + ks + 32 * i] * wv[i]; }
#pragma unroll
            for (int b = 0; b < NBATCH; ++b) red[(ks * NBATCH + b) * 16 + col] = acc[b];
            __syncthreads();
            if (tid < NBATCH * 16) { const int b = tid >> 4, cc = tid & 15; float s = 0.f;
                for (int k2 = 0; k2 < 32; ++k2) s += red[(k2 * NBATCH + b) * 16 + cc];
                MOD[b * 3072 + bx * 16 + cc] = s + p.in[9][bx * 16 + cc]; }
        }
        if (bx == G - 1 && wave == 0) {
            const float a = wave_sum(p.in[10][lane] * p.in[11][lane]), b2 = wave_sum(p.in[12][lane] * p.in[13][lane]);
            if (lane == 0) MISC[0] = expf(a) - expf(b2) + 0.2f;
        }
    }
    asm volatile("s_waitcnt vmcnt(0)\n\ts_nop 0" ::: "memory");
    grid.sync();
    const XcdBarrier xbar = xcd_barrier_post((unsigned*)(p.ws + WS_BAR), (volatile LAS unsigned*)(lds + LDS_XB));
    asm volatile(".p2align 8\n\t.rept " PAD_STR(PAD_P0B) "\n\ts_nop 0\n\t.endr");
    if (p.mask & 2) { const int lane = att::fresh_tid() & 63;
    f32x4g gpre[4];
#pragma unroll
    for (int j = 0; j < 4; ++j) gpre[j] = ((const f32x4g*)p.in[6])[lane + 64 * j];
    for (int rb = gw; rb < NTOK; rb += 4 * NGW) {
        f32x4g v[4][4];
#pragma unroll
        for (int q = 0; q < 4; ++q) { const int row = rb + q * NGW; if (row < NTOK) { const f32x4g* xr = (const f32x4g*)xrow_ptr(p, row) + lane;
#pragma unroll
            for (int j = 0; j < 4; ++j) v[q][j] = __builtin_nontemporal_load(&xr[64 * j]); } }
#pragma unroll
        for (int q = 0; q < 4; ++q) { const int row = rb + q * NGW; if (row < NTOK) {
            const int b = row_batch(row); float s = 0.f;
#pragma unroll
            for (int j = 0; j < 4; ++j) s += (v[q][j].x * v[q][j].x + v[q][j].y * v[q][j].y) + (v[q][j].z * v[q][j].z + v[q][j].w * v[q][j].w);
            const float rstd = rsqrtf(wave_sum(s) * (1.f / DMODEL) + 1e-6f);
            unsigned long long* o8 = (unsigned long long*)(H + (size_t)row * DMODEL) + lane;
#pragma unroll
            for (int j = 0; j < 4; ++j) {
                const f32x4g sh = ((const f32x4g*)(MOD + b * 3072))[lane + 64 * j], sl = ((const f32x4g*)(MOD + b * 3072 + 1024))[lane + 64 * j];
                const f32x4g hv = v[q][j] * rstd * gpre[j] * (sl + 1.f) + sh;
                o8[64 * j] = (unsigned long long)pk2(hv.x, hv.y) | ((unsigned long long)pk2(hv.z, hv.w) << 32);
            } } }
    }
    {
        LAS float* scr = (LAS float*)(lds + wave * 16384);
        constexpr int I_IN = (DMODEL / 64) * (DPROJ / 32), I_OUT = (DMODEL / 64) * (DMODEL / 32);
        for (int it = gw; it < I_IN; it += NGW) transpose_item(p.in[4], DMODEL, DPROJ, WIN, scr, it, lane);
        if (G <= 192) for (int it = gw; it < I_OUT; it += NGW) transpose_item(p.in[5], DMODEL, DMODEL, WOUT, scr, it, lane);
    } }
    xcd_barrier(xbar);
#ifndef NO_P1
    asm volatile(".p2align 8\n\t.rept " PAD_STR(PAD_P1) "\n\ts_nop 0\n\t.endr");
    if (p.mask & 4) {
        pg8::Gemm g{H, WIN, NTOK, DPROJ, DMODEL}; pg8::StaticOrder S; S.init(NTOK, DPROJ, G, bx);
        pg8::EpiProj E{PROJ, 256, ROPE, P15};
        pg8::gemm_phase<pg8::EpiProj, pg8::StaticOrder, true, true>(lds, g, S, E);
    }
#endif
    xcd_barrier(xbar);
    {
        bf16* YM = H;
        const float lam = MISC[0];
#ifndef NO_DIFF
    asm volatile(".p2align 8\n\t.rept " PAD_STR(PAD_DIFF) "\n\ts_nop 0\n\t.endr");
        if (p.mask & 8)
        for (int u = vcu; u < 2048; u += G) {
            int bh, qt, S; long rowbase;
            if (u < 1024) { bh = (u & 255) >> 4; qt = (u & 15) * 4 + (u >> 8); S = 8192; rowbase = (long)(bh >> 2) * 8192; }
            else { const int u2 = u - 1024; bh = (u2 & 255) >> 2; qt = (u2 & 3) * 4 + (u2 >> 8); S = 2048; rowbase = NPROMPT_ROWS + (long)(bh >> 2) * 2048; }
            att::diff_unit(PROJ, YM, rowbase, S, bh & 3, qt, (LAS char*)lds, lam, p.in[14], P15);
        }
#endif
#ifndef NO_DIL
        LAS char* vl = (LAS char*)lds + wave * 8448; LAS float* wsf = (LAS float*)(lds + wave * 8448 + 8192);
        LAS att::bf16* OA = (LAS att::bf16*)(lds + 67584); LAS float* ML = (LAS float*)(lds + 67584 + 65536);
    asm volatile(".p2align 8\n\t.rept " PAD_STR(PAD_DIL) "\n\ts_nop 0\n\t.endr");
        if (p.mask & 16)
        for (int u = vcu; u < 1024; u += G) {
            int b, h, c, S; long rowbase;
            if (u < 512) { const int id = (u & 255) * 2 + (u >> 8); c = id & 15; h = (id >> 4) & 7; b = id >> 7; S = 8192; rowbase = (long)b * 8192; }
            else { const int u2 = u - 512; const int id = (u2 & 255) * 2 + (u2 >> 8); c = id & 3; h = (id >> 2) & 7; b = id >> 5; S = 2048; rowbase = NPROMPT_ROWS + (long)b * 2048; }
            {
                const int ln = att::fresh_tid() & 63, r32 = ln & 31, hi = ln >> 5;
                const att::bf16* Qb = PROJ + att::pc(h * 64) + rowbase * att::PITCH;
                const long t0 = 512L * c;
                att::bf16x8 q0[4], q1[4];
                att::dil_q(q0, Qb, t0 + wave + 16 * r32, hi); att::dil_q(q1, Qb, t0 + wave + 8 + 16 * r32, hi);
                att::dil_item_a(PROJ, rowbase, S, h, c, wave, vl, wsf, OA, ML, q0);
                att::dil_item_a(PROJ, rowbase, S, h, c, wave + 8, vl, wsf, OA, ML, q1);
                { const int g0 = wave, g1 = wave + 8;
                  att::dil_q(q0, Qb, t0 + (g0 & 3) + 128 * (g0 >> 2) + 4 * r32, hi); att::dil_q(q1, Qb, t0 + (g1 & 3) + 128 * (g1 >> 2) + 4 * r32, hi); }
                __syncthreads();
                att::dil_item_m(PROJ, rowbase, S, h, c, wave, vl, wsf, OA, ML, q0);
                att::dil_item_m(PROJ, rowbase, S, h, c, wave + 8, vl, wsf, OA, ML, q1);
                att::dil_q(q0, Qb, t0 + 32 * wave + r32, hi); att::dil_q(q1, Qb, t0 + 32 * (wave + 8) + r32, hi);
                __syncthreads();
                att::dil_item_b(PROJ, YM, rowbase, S, h, c, wave, vl, wsf, OA, ML, q0);
                att::dil_item_b(PROJ, YM, rowbase, S, h, c, wave + 8, vl, wsf, OA, ML, q1);
            }
            __syncthreads();
        }
#endif
    }
    xcd_barrier(xbar);
    asm volatile(".p2align 8\n\t.rept " PAD_STR(PAD_P3) "\n\ts_nop 0\n\t.endr");
    if (p.mask & 32) {
        for (int i = bx * 512 + tid; i < NBATCH * DMODEL; i += G * 512) GATE[i] = MOD[(i >> 10) * 3072 + 2048 + (i & 1023)];
#ifndef NO_P3
        pg8::Gemm g{H, WOUT, NTOK, DMODEL, DMODEL}; pg8::StaticOrder S; S.init(NTOK, DMODEL, G, bx);
        pg8::EpiY E{YB, DMODEL, SSQ};
        pg8::gemm_phase<pg8::EpiY, pg8::StaticOrder, true, true>(lds, g, S, E);
#endif
    }
    xcd_barrier(xbar);
    asm volatile(".p2align 8\n\t.rept " PAD_STR(PAD_P4) "\n\ts_nop 0\n\t.endr");
    if (p.mask & 64) { const int lane = att::fresh_tid() & 63;
    f32x4g gpo[4];
#pragma unroll
    for (int j = 0; j < 4; ++j) gpo[j] = ((const f32x4g*)p.in[7])[lane + 64 * j];
    for (int rb = gw; rb < NTOK; rb += 2 * NGW) {
        f32x4g xv[2][4]; unsigned long long yv[2][4]; float sq[2];
#pragma unroll
        for (int q = 0; q < 2; ++q) { const int row = rb + q * NGW; if (row < NTOK) { const f32x4g* xr = (const f32x4g*)xrow_ptr(p, row) + lane;
            const unsigned long long* y8 = (const unsigned long long*)(YB + (size_t)row * DMODEL) + lane;
            sq[q] = lane < 16 ? SSQ[(size_t)row * 16 + lane] : 0.f;
#pragma unroll
            for (int j = 0; j < 4; ++j) { xv[q][j] = __builtin_nontemporal_load(&xr[64 * j]); yv[q][j] = __builtin_nontemporal_load(&y8[64 * j]); } } }
#pragma unroll
        for (int q = 0; q < 2; ++q) { const int row = rb + q * NGW; if (row < NTOK) {
            const int b = row_batch(row);
            const float rstd = rsqrtf(wave_sum(sq[q]) * (1.f / DMODEL) + 1e-6f);
            f32x4g* orow = (f32x4g*)(p.out + (size_t)row * DMODEL) + lane;
#pragma unroll
            for (int j = 0; j < 4; ++j) {
                const unsigned long long w = yv[q][j];
                f32x4g y; y.x = __uint_as_float(((unsigned)w) << 16); y.y = __uint_as_float(((unsigned)w) & 0xffff0000u);
                y.z = __uint_as_float(((unsigned)(w >> 32)) << 16); y.w = __uint_as_float(((unsigned)(w >> 32)) & 0xffff0000u);
                const f32x4g gt = ((const f32x4g*)(GATE + b * DMODEL))[lane + 64 * j];
                __builtin_nontemporal_store(xv[q][j] + gt * (y * rstd) * gpo[j], &orow[64 * j]);
            } } }
    } }
}

extern "C" void kernel_launch(void* const* d_in, const int* in_sizes, int n_in, void* d_out, int out_size, void* d_ws, size_t ws_size, hipStream_t stream) {
    static int grid = 0;
    if (grid == 0) {
        if (n_in != 15 || ws_size < WS_NEED || out_size != NTOK * DMODEL) { fprintf(stderr, "kernel_launch: unexpected shapes (n_in %d, ws %zu, out %d)\n", n_in, ws_size, out_size); grid = -1; return; }
        int dev = 0, cus = 0, per_cu = 0;
        hipGetDevice(&dev); hipDeviceGetAttribute(&cus, hipDeviceAttributeMultiprocessorCount, dev);
        hipFuncSetAttribute((const void*)mega_fwd, hipFuncAttributeMaxDynamicSharedMemorySize, LDS_BYTES);
        hipOccupancyMaxActiveBlocksPerMultiprocessor(&per_cu, (const void*)mega_fwd, 512, LDS_BYTES);
        (void)hipGetLastError();
        if (per_cu < 1) per_cu = 1;
        grid = cus;
    }
    if (grid < 0) return;
    Params p{};
    for (int i = 0; i < 15; ++i) p.in[i] = (const float*)d_in[i];
    p.out = (float*)d_out; p.ws = (unsigned char*)d_ws; p.mask = 127;
#ifdef PROBE_MASK
    { Params p2 = p; p2.mask = PROBE_MASK; void* args2[] = {&p2}; (void)hipLaunchCooperativeKernel((const void*)mega_fwd, dim3(grid), dim3(512), args2, LDS_BYTES, stream); }
#endif
    void* args[] = {&p};
    hipError_t e = hipLaunchCooperativeKernel((const void*)mega_fwd, dim3(grid), dim3(512), args, LDS_BYTES, stream);
    if (e != hipSuccess) fprintf(stderr, "cooperative launch failed: %s (grid %d)\n", hipGetErrorString(e), grid);
}
```
